# Optimizing an MI355X kernel written in HIP

```python
import jax, jax.numpy as jnp
from jax import lax
import numpy as np

D_MODEL = 4096
BATCH = 1
SEQ = 16384
DEPTH = 2
DEC_BATCH = 2
DEC_SEQ = 4096
PAST_LEN = 128

GRID_W = 64
HEAD_DIM = 128
N_Q_HEADS = 16
N_KV_HEADS = 4
Q_PER_KV = N_Q_HEADS // N_KV_HEADS
ATTN_WIDTH = N_Q_HEADS * HEAD_DIM
KV_WIDTH = N_KV_HEADS * HEAD_DIM
CONV_WIDTH = D_MODEL // 4
CONV_K = 3
POOL_WIDTH = D_MODEL // 4
POOL_WINDOWS = (2, 4, 8, 16)
POOL_GROUP = POOL_WIDTH // len(POOL_WINDOWS)
MIX_WIDTH = ATTN_WIDTH + CONV_WIDTH + POOL_WIDTH
IN_WIDTH = ATTN_WIDTH + 2 * KV_WIDTH + 3 * CONV_WIDTH + POOL_WIDTH
D_FF = -(-8 * D_MODEL // (3 * 256)) * 256
ROPE_HALF = HEAD_DIM // 2
ROPE_THETA = 10000.0
Q_BLOCK = 128
EPS = 1e-6

kernel_name = "hybrid_parallel_bidir_encoder"


def rms_norm(x, g):
    x32 = x.astype(jnp.float32)
    y = x32 * lax.rsqrt(jnp.mean(x32 * x32, axis=-1, keepdims=True) + EPS)
    return (y * g.astype(jnp.float32)).astype(x.dtype)


def axial_angles(n):
    rows = n // GRID_W
    r = jnp.repeat(jnp.arange(rows, dtype=jnp.float32), GRID_W)
    c = jnp.tile(jnp.arange(GRID_W, dtype=jnp.float32), rows)
    inv = 1.0 / (ROPE_THETA ** (jnp.arange(0, ROPE_HALF, 2, dtype=jnp.float32) / ROPE_HALF))
    return r[:, None] * inv, c[:, None] * inv


def rotate_half_block(x, ang):
    f = ang.shape[1]
    shape = (1, ang.shape[0]) + (1,) * (x.ndim - 3) + (f,)
    cos = jnp.cos(ang).reshape(shape).astype(x.dtype)
    sin = jnp.sin(ang).reshape(shape).astype(x.dtype)
    x1, x2 = x[..., :f], x[..., f:]
    return jnp.concatenate([x1 * cos - x2 * sin, x2 * cos + x1 * sin], axis=-1)


def axial_rope(x, ang_r, ang_c):
    return jnp.concatenate([rotate_half_block(x[..., :ROPE_HALF], ang_r),
                            rotate_half_block(x[..., ROPE_HALF:], ang_c)], axis=-1)


def attention_mixer(q, k, v, q_gain, k_gain):
    b, s, _ = q.shape
    q = rms_norm(q.reshape(b, s, N_KV_HEADS, Q_PER_KV, HEAD_DIM), q_gain)
    k = rms_norm(k.reshape(b, s, N_KV_HEADS, HEAD_DIM), k_gain)
    v = v.reshape(b, s, N_KV_HEADS, HEAD_DIM)
    ang_r, ang_c = axial_angles(s)
    q = axial_rope(q, ang_r, ang_c)
    k = axial_rope(k, ang_r, ang_c)
    scale = HEAD_DIM ** -0.5
    nb = s // Q_BLOCK
    qb = q.reshape(b, nb, Q_BLOCK, N_KV_HEADS, Q_PER_KV, HEAD_DIM).transpose(1, 0, 2, 3, 4, 5)

    def one_block(qi):
        sc = jnp.einsum('bqkgd,bskd->bkgqs', qi, k, preferred_element_type=jnp.float32) * scale
        p = jax.nn.softmax(sc, axis=-1).astype(v.dtype)
        return jnp.einsum('bkgqs,bskd->bqkgd', p, v, preferred_element_type=jnp.float32).astype(v.dtype)

    o = lax.map(one_block, qb)
    return o.transpose(1, 0, 2, 3, 4, 5).reshape(b, s, ATTN_WIDTH)


def conv_mixer(h, gate_b, gate_c, conv_w):
    u = gate_c * h
    up = jnp.pad(u, ((0, 0), (1, 1), (0, 0)))
    y = up[:, :-2] * conv_w[0] + up[:, 1:-1] * conv_w[1] + up[:, 2:] * conv_w[2]
    return gate_b * y


def pool_mixer(u, pool_w, pool_scale):
    b, s, _ = u.shape
    u32 = u.astype(jnp.float32)
    cs = jnp.concatenate([jnp.zeros((b, 1, POOL_WIDTH), jnp.float32), lax.cumsum(u32, axis=1)], axis=1)
    t = jnp.arange(s)
    outs = []
    for gi, w in enumerate(POOL_WINDOWS):
        lo = jnp.clip(t - w // 2, 0, s)
        hi = jnp.clip(t + w // 2, 0, s)
        sl = slice(gi * POOL_GROUP, (gi + 1) * POOL_GROUP)
        csg = cs[..., sl]
        tot = jnp.take(csg, hi, axis=1) - jnp.take(csg, lo, axis=1)
        cnt = (hi - lo).astype(jnp.float32)[None, :, None]
        outs.append(tot / cnt - u32[..., sl])
    m = jnp.stack(outs, axis=2).astype(u.dtype)
    y = jnp.einsum('bsgc,gcd->bsgd', m, pool_w).reshape(b, s, POOL_WIDTH)
    return y * pool_scale


def encoder_layer(x, ln_mix_pre, ln_mix_post, ln_ffn_pre, ln_ffn_post, q_norm, k_norm,
                  w_in, conv_w, pool_w, pool_scale, w_out, w_gate, w_up, w_down):
    h = rms_norm(x, ln_mix_pre)
    proj = h @ w_in
    o = 0
    q = proj[..., o:o + ATTN_WIDTH]; o += ATTN_WIDTH
    k = proj[..., o:o + KV_WIDTH]; o += KV_WIDTH
    v = proj[..., o:o + KV_WIDTH]; o += KV_WIDTH
    ch = proj[..., o:o + CONV_WIDTH]; o += CONV_WIDTH
    cb = proj[..., o:o + CONV_WIDTH]; o += CONV_WIDTH
    cc = proj[..., o:o + CONV_WIDTH]; o += CONV_WIDTH
    pu = proj[..., o:o + POOL_WIDTH]
    a_out = attention_mixer(q, k, v, q_norm, k_norm)
    c_out = conv_mixer(ch, cb, cc, conv_w)
    p_out = pool_mixer(pu, pool_w, pool_scale)
    mix = jnp.concatenate([a_out, c_out, p_out], axis=-1) @ w_out
    x = x + rms_norm(mix, ln_mix_post)
    h = rms_norm(x, ln_ffn_pre)
    f = (jax.nn.silu(h @ w_gate) * (h @ w_up)) @ w_down
    return x + rms_norm(f, ln_ffn_post)


def trunk(x, ln_mix_pre, ln_mix_post, ln_ffn_pre, ln_ffn_post, q_norm, k_norm,
          w_in, conv_w, pool_w, pool_scale, w_out, w_gate, w_up, w_down):
    for l in range(DEPTH):
        x = encoder_layer(x, ln_mix_pre[l], ln_mix_post[l], ln_ffn_pre[l], ln_ffn_post[l],
                          q_norm[l], k_norm[l], w_in[l], conv_w[l], pool_w[l], pool_scale[l],
                          w_out[l], w_gate[l], w_up[l], w_down[l])
    return x


def setup_inputs(seed: int = 0) -> dict:
    key = jax.random.key(seed)
    ks = jax.random.split(key, 18)
    f32 = jnp.float32

    def gain(k, n):
        return 1.0 + 0.05 * jax.random.normal(k, (DEPTH, n), f32)

    return {
        "x_prompt": jax.random.normal(ks[0], (BATCH, SEQ, D_MODEL), f32),
        "x_sample": jax.random.normal(ks[1], (DEC_BATCH, DEC_SEQ, D_MODEL), f32),
        "ln_mix_pre": gain(ks[2], D_MODEL),
        "ln_mix_post": gain(ks[3], D_MODEL),
        "ln_ffn_pre": gain(ks[4], D_MODEL),
        "ln_ffn_post": gain(ks[5], D_MODEL),
        "q_norm": gain(ks[6], HEAD_DIM),
        "k_norm": gain(ks[7], HEAD_DIM),
        "w_in": jax.random.normal(ks[8], (DEPTH, D_MODEL, IN_WIDTH), f32) * D_MODEL ** -0.5,
        "conv_w": jax.random.normal(ks[9], (DEPTH, CONV_K, CONV_WIDTH), f32) * CONV_K ** -0.5,
        "pool_w": jax.random.normal(ks[10], (DEPTH, len(POOL_WINDOWS), POOL_GROUP, POOL_GROUP), f32) * POOL_GROUP ** -0.5,
        "pool_scale": 1.0 + 0.1 * jax.random.normal(ks[11], (DEPTH, POOL_WIDTH), f32),
        "w_out": jax.random.normal(ks[12], (DEPTH, MIX_WIDTH, D_MODEL), f32) * MIX_WIDTH ** -0.5,
        "w_gate": jax.random.normal(ks[13], (DEPTH, D_MODEL, D_FF), f32) * D_MODEL ** -0.5,
        "w_up": jax.random.normal(ks[14], (DEPTH, D_MODEL, D_FF), f32) * D_MODEL ** -0.5,
        "w_down": jax.random.normal(ks[15], (DEPTH, D_FF, D_MODEL), f32) * D_FF ** -0.5,
    }


def reference(x_prompt, x_sample, ln_mix_pre, ln_mix_post, ln_ffn_pre, ln_ffn_post, q_norm, k_norm,
              w_in, conv_w, pool_w, pool_scale, w_out, w_gate, w_up, w_down):
    y_prompt = trunk(x_prompt, ln_mix_pre, ln_mix_post, ln_ffn_pre, ln_ffn_post, q_norm, k_norm,
                     w_in, conv_w, pool_w, pool_scale, w_out, w_gate, w_up, w_down)
    y_sample = trunk(x_sample, ln_mix_pre, ln_mix_post, ln_ffn_pre, ln_ffn_post, q_norm, k_norm,
                     w_in, conv_w, pool_w, pool_scale, w_out, w_gate, w_up, w_down)
    return (y_prompt, y_sample)
```

```cpp
#include <hip/hip_runtime.h>
#include <hip/hip_bf16.h>
#include <cstdio>
#include <cstdint>

#ifndef MK_FUSED
#define MK_FUSED 1
#endif

constexpr int DM = 4096, M_TOK = 24576, SEQ_P = 16384, SEQ_S = 4096, NLAYER = 2;
constexpr int NIN = 7168, DFF = 11008, NGU = 2 * DFF;
constexpr int HD = 128, NQH = 16, NKVH = 4;
constexpr int C_Q = 0, C_K = 2048, C_V = 2560, C_CH = 3072, C_CB = 4096, C_CC = 5120, C_PU = 6144;
constexpr int MX_A = 0, MX_C = 2048, MX_P = 3072;
constexpr float RMS_EPS = 1e-6f;
namespace pg8 {
#define PG8_LAS __attribute__((address_space(3)))
typedef unsigned short bf16_t;
typedef short bf16x8 __attribute__((ext_vector_type(8)));
typedef float f32x4 __attribute__((ext_vector_type(4)));
typedef unsigned u32x4 __attribute__((ext_vector_type(4)));
constexpr int BM = 256, BK = 64, HALF = 128, HTB = HALF * BK * 2  , STAGE_BYTES = 8 * HTB, NXCD = 8, WGM = 8;

__host__ __device__ __forceinline__ int lds_byte(int r, int c) { const int st = (r >> 4) * 2 + (c >> 5), rr = r & 15, cc = c & 31, ob = rr * 64 + cc * 2; return st * 1024 + (ob ^ (((ob >> 9) & 1) << 5)); }
__host__ __device__ __forceinline__ void stage_rc(int b, int& R, int& C) { const int st = b / 1024, sb = b % 1024, swz = sb ^ (((sb >> 9) & 1) << 5); R = (st >> 1) * 16 + swz / 64; C = (st & 1) * 32 + (swz % 64) / 2; }
__host__ __device__ __forceinline__ int perm32(int rho) { const int n = rho >> 4, i = rho & 15; return 8 * (i >> 2) + 4 * n + (i & 3); }

struct Unit { int pm, pn; };
struct Gemm { const bf16_t* A; const bf16_t* Bt; int M, N, K; };

struct StaticOrder {
    int nM, nN, nwg, G, c;
    __host__ __device__ void init(int M, int N, int G_, int c_) { nM = M / BM; nN = N / BM; nwg = nM * nN; G = G_; c = c_; }
    __host__ __device__ bool next(int i, Unit& u) const {
        const long L = (long)i * G + c; if (L >= nwg) return false;
        int wgid = (int)L; { const int q = nwg / NXCD, r = nwg % NXCD, xcd = wgid % NXCD, off = wgid / NXCD; wgid = (xcd < r ? xcd * (q + 1) : r * (q + 1) + (xcd - r) * q) + off; }
        const int nig = WGM * nN, gid = wgid / nig, fm = gid * WGM, gsz = (nM - fm) < WGM ? (nM - fm) : WGM;
        u.pm = fm + ((wgid % nig) % gsz); u.pn = (wgid % nig) / gsz; return true;
    }
    __device__ __forceinline__ void a_ready(const Unit&) const {}
    __device__ __forceinline__ void done(const Unit&) const {}
};

__device__ __forceinline__ unsigned cvt_pk_bf16(float lo, float hi) { unsigned r; asm volatile("v_cvt_pk_bf16_f32 %0, %1, %2" : "=v"(r) : "v"(lo), "v"(hi)); return r; }
typedef float f32x2 __attribute__((ext_vector_type(2)));
struct EpiBf16 {
    static constexpr bool PERM = true, AFTER_DRAIN = false;
    bf16_t* O; int ldc;
    __device__ __forceinline__ void operator()(const f32x4 (&acc)[2][2][4][2], const Unit& u, int wr, int wc, int fr, int fq) const {
        const int row0 = u.pm * BM + wr * 64 + fr; const int col0 = u.pn * BM + wc * 32 + 8 * fq;
#pragma unroll
        for (int ai = 0; ai < 2; ++ai)
#pragma unroll
            for (int m = 0; m < 4; ++m) { bf16_t* rowp = O + (size_t)(row0 + ai * HALF + m * 16) * ldc + col0;
#pragma unroll
                for (int bj = 0; bj < 2; ++bj) { const f32x4 v0 = acc[ai][bj][m][0], v1 = acc[ai][bj][m][1];
                    u32x4 w; w.x = cvt_pk_bf16(v0[0], v0[1]); w.y = cvt_pk_bf16(v0[2], v0[3]); w.z = cvt_pk_bf16(v1[0], v1[1]); w.w = cvt_pk_bf16(v1[2], v1[3]);
                    *(u32x4*)(rowp + bj * HALF) = w; } }
    }
};
__device__ __forceinline__ float silu_mul(float g, float u) { const float e = __builtin_amdgcn_exp2f(g * -1.4426950408889634f); return g * __builtin_amdgcn_rcpf(1.0f + e) * u; }
struct EpiSwiGLU {
    static constexpr bool PERM = true, AFTER_DRAIN = false;
    bf16_t* O; int ldc;
    __device__ __forceinline__ void operator()(const f32x4 (&acc)[2][2][4][2], const Unit& u, int wr, int wc, int fr, int fq) const {
        const int row0 = u.pm * BM + wr * 64 + fr; const int col0 = u.pn * HALF + wc * 32 + 8 * fq;
#pragma unroll
        for (int ai = 0; ai < 2; ++ai)
#pragma unroll
            for (int m = 0; m < 4; ++m) { bf16_t* rowp = O + (size_t)(row0 + ai * HALF + m * 16) * ldc + col0;
                const f32x4 g0 = acc[ai][0][m][0], g1 = acc[ai][0][m][1], u0 = acc[ai][1][m][0], u1 = acc[ai][1][m][1];
                u32x4 w; w.x = cvt_pk_bf16(silu_mul(g0[0], u0[0]), silu_mul(g0[1], u0[1])); w.y = cvt_pk_bf16(silu_mul(g0[2], u0[2]), silu_mul(g0[3], u0[3]));
                w.z = cvt_pk_bf16(silu_mul(g1[0], u1[0]), silu_mul(g1[1], u1[1])); w.w = cvt_pk_bf16(silu_mul(g1[2], u1[2]), silu_mul(g1[3], u1[3]));
                *(u32x4*)rowp = w; }
    }
};
template <class Epi, class Sched, bool ALIGN_EPI = false, bool SP2 = false>
__device__ __forceinline__ void gemm_phase(PG8_LAS unsigned char* lds, const Gemm g, const Sched& S, const Epi& E) {
    const int tid = threadIdx.x, wid = __builtin_amdgcn_readfirstlane(tid >> 6), lane = tid & 63, wr = wid >> 2, wc = wid & 3, fr = lane & 15, fq = lane >> 4;
    const int K = g.K, nt = K / BK;
    unsigned voffA[2], voffB[2];
#pragma unroll
    for (int i = 0; i < 2; ++i) { int R, C; stage_rc(tid * 16 + i * 8192, R, C); const int Rb = Epi::PERM ? ((R & ~31) + perm32(R & 31)) : R;
        voffA[i] = (unsigned)(R * K + C) * 2u; voffB[i] = (unsigned)(Rb * K + C) * 2u; }
    const size_t kstep = (size_t)(BK * 2);
    const size_t hstep = (size_t)HALF * K * 2;
    const size_t tstep = 2 * hstep;
    const unsigned ldsw = (unsigned)wid * 1024u;
    const int aoff = lds_byte(wr * 64 + fr, fq * 8), boff = lds_byte(wc * 32 + fr, fq * 8);
#define PG8_SA(b, h) (((b) * 2 + (h)) * HTB)
#define PG8_SB(b, h) ((4 + (b) * 2 + (h)) * HTB)
#define PG8_STAGE(bufoff, gbase, voff) do { _Pragma("unroll") for (int _i = 0; _i < 2; ++_i) \
        __builtin_amdgcn_global_load_lds((const unsigned*)((const char*)(gbase) + (voff)[_i]), (PG8_LAS unsigned*)(lds + (bufoff) + ldsw + _i * 8192), 16, 0, 0); } while (0)
#define PG8_LDA(dst, b, h) do { _Pragma("unroll") for (int m = 0; m < 4; ++m) _Pragma("unroll") for (int k = 0; k < 2; ++k) dst[m][k] = *(const PG8_LAS bf16x8*)(lds + PG8_SA(b, h) + aoff + m * 2048 + k * 1024); } while (0)
#define PG8_LDB(dst, b, h) do { _Pragma("unroll") for (int n = 0; n < 2; ++n) _Pragma("unroll") for (int k = 0; k < 2; ++k) dst[n][k] = *(const PG8_LAS bf16x8*)(lds + PG8_SB(b, h) + boff + n * 2048 + k * 1024); } while (0)
#define PG8_MMA(ai, bj, At, Bt) do { __builtin_amdgcn_s_setprio(1); _Pragma("unroll") for (int m = 0; m < 4; ++m) _Pragma("unroll") for (int n = 0; n < 2; ++n) _Pragma("unroll") for (int k = 0; k < 2; ++k) \
        acc[ai][bj][m][n] = __builtin_amdgcn_mfma_f32_16x16x32_bf16(Bt[n][k], At[m][k], acc[ai][bj][m][n], 0, 0, 0); __builtin_amdgcn_s_setprio(0); } while (0)
#define PG8_WAIT_V(n) asm volatile("s_waitcnt vmcnt(" #n ")" ::: "memory")
#define PG8_WAIT_L(n) asm volatile("s_waitcnt lgkmcnt(" #n ")" ::: "memory")
#define PG8_BAR __builtin_amdgcn_s_barrier()
#define PG8_SCHED __builtin_amdgcn_sched_barrier(0)
    Unit cur, nxt; int ui = 0;
    if (!S.next(0, cur)) return;
    f32x4 acc[2][2][4][2];
#pragma unroll
    for (int a = 0; a < 2; ++a)
#pragma unroll
        for (int b = 0; b < 2; ++b)
#pragma unroll
            for (int m = 0; m < 4; ++m)
#pragma unroll
                for (int n = 0; n < 2; ++n) acc[a][b][m][n] = (f32x4){0.f, 0.f, 0.f, 0.f};
    bf16x8 At[4][2], B0[2][2], B1[2][2];
    const char* cA = (const char*)g.A + (size_t)cur.pm * tstep; const char* cB = (const char*)g.Bt + (size_t)cur.pn * tstep;
    S.a_ready(cur);
    if constexpr (SP2) {
        PG8_STAGE(PG8_SB(0, 0), cB, voffB); PG8_STAGE(PG8_SB(0, 1), cB + hstep, voffB); PG8_STAGE(PG8_SA(0, 0), cA, voffA); PG8_STAGE(PG8_SA(0, 1), cA + hstep, voffA);
        if (wr == 1) PG8_BAR;
        PG8_WAIT_V(2); PG8_BAR;
        PG8_STAGE(PG8_SB(1, 0), cB + kstep, voffB); PG8_STAGE(PG8_SA(1, 0), cA + kstep, voffA); PG8_STAGE(PG8_SB(1, 1), cB + hstep + kstep, voffB);
        PG8_WAIT_V(6); PG8_BAR;
    } else {
        PG8_STAGE(PG8_SB(0, 0), cB, voffB); PG8_STAGE(PG8_SA(0, 0), cA, voffA); PG8_STAGE(PG8_SB(0, 1), cB + hstep, voffB); PG8_STAGE(PG8_SA(0, 1), cA + hstep, voffA);
        if (wr == 1) PG8_BAR;
        PG8_WAIT_V(4); PG8_BAR;
        PG8_STAGE(PG8_SB(1, 0), cB + kstep, voffB); PG8_STAGE(PG8_SA(1, 0), cA + kstep, voffA); PG8_STAGE(PG8_SB(1, 1), cB + hstep + kstep, voffB);
        PG8_WAIT_V(6); PG8_BAR;
    }
    for (;;) {
        const bool has_next = S.next(ui + 1, nxt);
        const char* nA = has_next ? (const char*)g.A + (size_t)nxt.pm * tstep : cA; const char* nB = has_next ? (const char*)g.Bt + (size_t)nxt.pn * tstep : cB;
        for (int t = 0; t < nt; t += 2) {
            const bool last = (t == nt - 2);
            const char* a1 = cA + (size_t)(t + 1) * kstep;
            const char* a2 = last ? nA : cA + (size_t)(t + 2) * kstep; const char* b2 = last ? nB : cB + (size_t)(t + 2) * kstep;
            const char* a3 = a2 + kstep; const char* b3 = b2 + kstep;
            if (last && has_next) S.a_ready(nxt);
            if constexpr (SP2) {
            PG8_LDB(B0, 0, 0); PG8_LDB(B1, 0, 1); PG8_SCHED; PG8_LDA(At, 0, 0); PG8_STAGE(PG8_SA(1, 1), a1 + hstep, voffA);
            PG8_WAIT_V(8); PG8_WAIT_L(0); PG8_BAR; PG8_MMA(0, 0, At, B0); PG8_MMA(0, 1, At, B1); PG8_BAR; PG8_SCHED;
            PG8_LDA(At, 0, 1); PG8_STAGE(PG8_SB(0, 0), b2, voffB); PG8_STAGE(PG8_SB(0, 1), b2 + hstep, voffB); PG8_STAGE(PG8_SA(0, 0), a2, voffA);
            PG8_WAIT_V(8); PG8_WAIT_L(0); PG8_BAR; PG8_MMA(1, 0, At, B0); PG8_MMA(1, 1, At, B1); PG8_BAR; PG8_SCHED;
            PG8_LDB(B0, 1, 0); PG8_LDB(B1, 1, 1); PG8_SCHED; PG8_LDA(At, 1, 0); PG8_STAGE(PG8_SA(0, 1), a2 + hstep, voffA);
            PG8_WAIT_V(8); PG8_WAIT_L(0); PG8_BAR; PG8_MMA(0, 0, At, B0); PG8_MMA(0, 1, At, B1); PG8_BAR; PG8_SCHED;
            PG8_LDA(At, 1, 1); PG8_STAGE(PG8_SB(1, 0), b3, voffB); PG8_STAGE(PG8_SB(1, 1), b3 + hstep, voffB); PG8_STAGE(PG8_SA(1, 0), a3, voffA);
            PG8_WAIT_V(8); PG8_WAIT_L(0); PG8_BAR; PG8_MMA(1, 0, At, B0); PG8_MMA(1, 1, At, B1); PG8_BAR; PG8_SCHED;
            } else {
            PG8_LDB(B0, 0, 0); PG8_SCHED; PG8_LDA(At, 0, 0); PG8_STAGE(PG8_SA(1, 1), a1 + hstep, voffA);
            PG8_WAIT_L(8); PG8_BAR; PG8_WAIT_L(0); PG8_MMA(0, 0, At, B0); PG8_BAR; PG8_SCHED;
            PG8_LDB(B1, 0, 1); PG8_STAGE(PG8_SB(0, 0), b2, voffB);
            PG8_BAR; PG8_WAIT_L(0); PG8_MMA(0, 1, At, B1); PG8_BAR;
            PG8_LDA(At, 0, 1); PG8_STAGE(PG8_SA(0, 0), a2, voffA);
            PG8_BAR; PG8_WAIT_L(0); PG8_MMA(1, 0, At, B0); PG8_BAR; PG8_SCHED;
            PG8_STAGE(PG8_SB(0, 1), b2 + hstep, voffB);
            PG8_WAIT_V(6); PG8_BAR; PG8_MMA(1, 1, At, B1); PG8_BAR;
            PG8_LDB(B0, 1, 0); PG8_SCHED; PG8_LDA(At, 1, 0); PG8_STAGE(PG8_SA(0, 1), a2 + hstep, voffA);
            PG8_WAIT_L(8); PG8_BAR; PG8_WAIT_L(0); PG8_MMA(0, 0, At, B0); PG8_BAR; PG8_SCHED;
            PG8_LDB(B1, 1, 1); PG8_STAGE(PG8_SB(1, 0), b3, voffB);
            PG8_BAR; PG8_WAIT_L(0); PG8_MMA(0, 1, At, B1); PG8_BAR;
            PG8_LDA(At, 1, 1); PG8_STAGE(PG8_SA(1, 0), a3, voffA);
            PG8_BAR; PG8_WAIT_L(0); PG8_MMA(1, 0, At, B0); PG8_BAR; PG8_SCHED;
            PG8_STAGE(PG8_SB(1, 1), b3 + hstep, voffB);
            PG8_WAIT_V(6); PG8_BAR; PG8_MMA(1, 1, At, B1); PG8_BAR;
            }
        }
        if constexpr (ALIGN_EPI) { if (wr == 0) PG8_BAR; }
        if constexpr (!Epi::AFTER_DRAIN) { E(acc, cur, wr, wc, fr, fq); S.done(cur); }
        if (!has_next) break;
#pragma unroll
        for (int a = 0; a < 2; ++a)
#pragma unroll
            for (int b = 0; b < 2; ++b)
#pragma unroll
                for (int m = 0; m < 4; ++m)
#pragma unroll
                    for (int n = 0; n < 2; ++n) acc[a][b][m][n] = (f32x4){0.f, 0.f, 0.f, 0.f};
        cur = nxt; cA = nA; cB = nB; ++ui;
        if constexpr (ALIGN_EPI) { if (wr == 1) PG8_BAR; }
    }
    PG8_WAIT_V(0);
    if constexpr (!ALIGN_EPI) { if (wr == 0) PG8_BAR; }
    PG8_BAR;
    if constexpr (Epi::AFTER_DRAIN) { E.fused(acc, cur, wr, wc, fr, fq, lds, wid, lane); S.done(cur); }
#undef PG8_SA
#undef PG8_SB
#undef PG8_STAGE
#undef PG8_LDA
#undef PG8_LDB
#undef PG8_MMA
#undef PG8_WAIT_V
#undef PG8_WAIT_L
#undef PG8_BAR
#undef PG8_SCHED
}
}
namespace attn128 {
using bf16 = __hip_bfloat16;
constexpr int   D = 128, NW = 8, QBLK = 32, KVBLK = 64;
constexpr float SCALE = 0.088388347648318440f;
constexpr float THR = 8.f;
constexpr int SDEPTH = 2;
constexpr int LDQ = NIN, LDK = NIN, LDO = DM;
constexpr size_t SHM_V = KVBLK * D * 2, SHM_K = KVBLK * D * 2, SHM_ATTN = 2 * SHM_V + 2 * SHM_K + NW * 64 * 4;
using bf16x8 = __attribute__((ext_vector_type(8))) short;
using s16x4  = __attribute__((ext_vector_type(4))) short;
using f32x16 = __attribute__((ext_vector_type(16))) float;
using f32x8  = __attribute__((ext_vector_type(8))) float;
using u32x4  = __attribute__((ext_vector_type(4))) unsigned;
#define KSWZ(row, colB) ((row) * 256 + ((colB) ^ (((row) & 7) << 4)))
#define SBAR() __builtin_amdgcn_sched_barrier(0)
__device__ __forceinline__ int crow(int r, int hi) { return (r & 3) + 8 * (r >> 2) + 4 * hi; }
__device__ __forceinline__ unsigned cvtpk(float lo, float hi) {
  unsigned r; asm volatile("v_cvt_pk_bf16_f32 %0, %1, %2" : "=v"(r) : "v"(lo), "v"(hi)); return r;
}
template <typename TIn> struct Stage;
template <> struct Stage<bf16>  { using T = bf16x8;
  __device__ static __forceinline__ T ld8(const bf16* p) { return *reinterpret_cast<const bf16x8*>(p); }
  __device__ static __forceinline__ bf16x8 tobf(T x) { return x; } };
template <> struct Stage<float> { using T = f32x8;
  __device__ static __forceinline__ T ld8(const float* p) { return *reinterpret_cast<const f32x8*>(p); }
  __device__ static __forceinline__ bf16x8 tobf(T x) {
    u32x4 w = {cvtpk(x[0], x[1]), cvtpk(x[2], x[3]), cvtpk(x[4], x[5]), cvtpk(x[6], x[7])}; return *reinterpret_cast<bf16x8*>(&w); } };

__device__ __forceinline__ void partialSM(f32x16& p0, f32x16& p1, float& m_reg, float& mn, float& alpha) {
  constexpr float C = SCALE * 1.4426950408889634f;
  float pmax = p0[0]; for (int r = 1; r < 16; ++r) pmax = fmaxf(pmax, p0[r]); for (int r = 0; r < 16; ++r) pmax = fmaxf(pmax, p1[r]);
  { auto rr = __builtin_amdgcn_permlane32_swap(__float_as_uint(pmax), __float_as_uint(pmax), false, false);
    pmax = fmaxf(__uint_as_float(rr[0]), __uint_as_float(rr[1])); }
  if (__builtin_expect(__all(pmax - m_reg <= THR / SCALE), 1)) { mn = m_reg; alpha = 1.f; }
  else { mn = fmaxf(m_reg, pmax); alpha = __builtin_amdgcn_exp2f((m_reg - mn) * C); m_reg = mn; }
  float mnC = -mn * C;
  for (int r = 0; r < 16; ++r) p0[r] = fmaf(p0[r], C, mnC); for (int r = 0; r < 16; ++r) p1[r] = fmaf(p1[r], C, mnC);
  for (int r = 0; r < 16; ++r) p0[r] = __builtin_amdgcn_exp2f(p0[r]);
}
__device__ __forceinline__ void finishSM(f32x16& p0, f32x16& p1, float alpha, float& l_reg, bf16x8& pa0, bf16x8& pa1, bf16x8& pa2, bf16x8& pa3) {
  for (int r = 0; r < 16; ++r) p1[r] = __builtin_amdgcn_exp2f(p1[r]);
  float ps = 0; for (int r = 0; r < 16; ++r) ps += p0[r]; for (int r = 0; r < 16; ++r) ps += p1[r];
  { auto rr = __builtin_amdgcn_permlane32_swap(__float_as_uint(ps), __float_as_uint(ps), false, false);
    ps = __uint_as_float(rr[0]) + __uint_as_float(rr[1]); }
  l_reg = l_reg * alpha + ps;
#define PK4(P, BASE, OUT) do { unsigned a0 = cvtpk(P[BASE + 0], P[BASE + 1]), a1 = cvtpk(P[BASE + 2], P[BASE + 3]);   \
    unsigned b0 = cvtpk(P[BASE + 4], P[BASE + 5]), b1 = cvtpk(P[BASE + 6], P[BASE + 7]);                              \
    auto r0 = __builtin_amdgcn_permlane32_swap(a0, b0, false, false); auto r1 = __builtin_amdgcn_permlane32_swap(a1, b1, false, false); \
    u32x4 w = {r0[0], r1[0], r0[1], r1[1]}; OUT = *reinterpret_cast<bf16x8*>(&w); } while (0)
  PK4(p0, 0, pa0); PK4(p0, 8, pa1); PK4(p1, 0, pa2); PK4(p1, 8, pa3);
#undef PK4
}
__device__ __forceinline__ void qkt(f32x16& p0, f32x16& p1, const bf16* Ks, const bf16x8* qr, int r32, int hi) {
  p0 = f32x16{}; p1 = f32x16{};
  for (int d0 = 0; d0 < 8; ++d0) { int cb = (d0 * 16 + hi * 8) * 2;
    bf16x8 b0 = *reinterpret_cast<const bf16x8*>((const char*)Ks + KSWZ(r32, cb));
    bf16x8 b1 = *reinterpret_cast<const bf16x8*>((const char*)Ks + KSWZ(32 + r32, cb));
    p0 = __builtin_amdgcn_mfma_f32_32x32x16_bf16(b0, qr[d0], p0, 0, 0, 0);
    p1 = __builtin_amdgcn_mfma_f32_32x32x16_bf16(b1, qr[d0], p1, 0, 0, 0); }
}
__device__ __forceinline__ int v_st(int k, int c) { const int kk = (k & ~0xC) | ((k & 4) << 1) | ((k & 8) >> 1); return ((kk >> 3) * 4 + (c >> 5)) * 512 + ((kk & 7) * 32 + (c & 31)) * 2; }
__device__ __forceinline__ int v_rd_base(int lane) { return ((lane & 3) << 3) | (((lane >> 2) & 3) << 6) | (((lane >> 4) & 1) << 5) | (((lane >> 5) & 1) << 8); }
constexpr int v_rd_off(int d0, int ks, int half) { return d0 * 512 + ks * 4096 + half * 2048; }
template <int OFF> __device__ __forceinline__ s16x4 tr_read(int vb) {
  s16x4 r; asm volatile("ds_read_b64_tr_b16 %0, %1 offset:%2" : "=&v"(r) : "v"(vb), "i"(OFF) : "memory"); return r;
}
template <int D0> __device__ __forceinline__ void pv_one(f32x16& od, int vb, bf16x8 pa0, bf16x8 pa1, bf16x8 pa2, bf16x8 pa3) {
  const s16x4 l0 = tr_read<v_rd_off(D0, 0, 0)>(vb), h0 = tr_read<v_rd_off(D0, 0, 1)>(vb), l1 = tr_read<v_rd_off(D0, 1, 0)>(vb), h1 = tr_read<v_rd_off(D0, 1, 1)>(vb);
  const s16x4 l2 = tr_read<v_rd_off(D0, 2, 0)>(vb), h2 = tr_read<v_rd_off(D0, 2, 1)>(vb), l3 = tr_read<v_rd_off(D0, 3, 0)>(vb), h3 = tr_read<v_rd_off(D0, 3, 1)>(vb);
  asm volatile("s_waitcnt lgkmcnt(0)" ::: "memory"); SBAR();
#define PK(L, H) (bf16x8){L[0], L[1], L[2], L[3], H[0], H[1], H[2], H[3]}
  od = __builtin_amdgcn_mfma_f32_32x32x16_bf16(pa0, PK(l0, h0), od, 0, 0, 0);
  od = __builtin_amdgcn_mfma_f32_32x32x16_bf16(pa1, PK(l1, h1), od, 0, 0, 0);
  od = __builtin_amdgcn_mfma_f32_32x32x16_bf16(pa2, PK(l2, h2), od, 0, 0, 0);
  od = __builtin_amdgcn_mfma_f32_32x32x16_bf16(pa3, PK(l3, h3), od, 0, 0, 0);
#undef PK
}
__device__ __forceinline__ void pv_d0(f32x16* o, int vb, bf16x8 pa0, bf16x8 pa1, bf16x8 pa2, bf16x8 pa3) {
  pv_one<0>(o[0], vb, pa0, pa1, pa2, pa3); pv_one<1>(o[1], vb, pa0, pa1, pa2, pa3); pv_one<2>(o[2], vb, pa0, pa1, pa2, pa3); pv_one<3>(o[3], vb, pa0, pa1, pa2, pa3);
}

template <typename TQ>
__device__ __forceinline__ void attn_dense_body(const TQ* __restrict__ Qb, const bf16* __restrict__ Kh, const bf16* __restrict__ Vh,
                                                bf16* __restrict__ Ob, int seq, char* lds) {
  using St = Stage<bf16>; using SQ = Stage<TQ>;
  const int tid = threadIdx.x, wid = tid >> 6, lane = tid & 63, r32 = lane & 31, hi = lane >> 5;
  bf16* V_lds = (bf16*)lds; bf16* K_lds = (bf16*)(lds + 2 * SHM_V);
  float* ws = (float*)(lds + 2 * SHM_V + 2 * SHM_K) + wid * 64; float* li_l = ws; float* al_l = ws + 32;
  float m_reg = -1e30f, l_reg = 0; f32x16 o[4] = {}; bf16x8 qr[8];
  const TQ* Qw = Qb + (long)(wid * QBLK + r32) * LDQ + hi * 8;
#pragma unroll
  for (int d0 = 0; d0 < 8; ++d0) qr[d0] = SQ::tobf(SQ::ld8(Qw + d0 * 16));
  const int sr = tid >> 4, sc = (tid & 15) * 8, vst0 = v_st(sr, sc), vst1 = v_st(32 + sr, sc);
  const int vb0 = (int)(uintptr_t)V_lds + v_rd_base(lane);
  struct { typename St::T vs0, vs1, ks0, ks1; } sr_[SDEPTH];
#define SLOAD(i, k0) do { sr_[i].vs0 = St::ld8(&Vh[(long)((k0) + sr) * LDK + sc]); sr_[i].vs1 = St::ld8(&Vh[(long)((k0) + 32 + sr) * LDK + sc]); \
    sr_[i].ks0 = St::ld8(&Kh[(long)((k0) + sr) * LDK + sc]); sr_[i].ks1 = St::ld8(&Kh[(long)((k0) + 32 + sr) * LDK + sc]); } while (0)
#define SWRITE(b, i) do { *(bf16x8*)((char*)V_lds + (b) * SHM_V + vst0) = St::tobf(sr_[i].vs0);          \
    *(bf16x8*)((char*)V_lds + (b) * SHM_V + vst1) = St::tobf(sr_[i].vs1); int kc = sc * 2;               \
    *(bf16x8*)((char*)K_lds + (b) * SHM_K + KSWZ(sr, kc)) = St::tobf(sr_[i].ks0);                       \
    *(bf16x8*)((char*)K_lds + (b) * SHM_K + KSWZ(32 + sr, kc)) = St::tobf(sr_[i].ks1); } while (0)
#define SWAIT() do { if constexpr (SDEPTH == 2) asm volatile("s_waitcnt vmcnt(4)" ::: "memory"); else asm volatile("s_waitcnt vmcnt(0)" ::: "memory"); } while (0)
#define RESC(a) do { if (__any((a) < 1.f)) { if (hi == 0) al_l[r32] = (a); asm volatile("s_waitcnt lgkmcnt(0)" ::: "memory"); \
    for (int d = 0; d < 4; ++d) for (int r = 0; r < 16; ++r) o[d][r] *= al_l[crow(r, hi)]; } } while (0)
  f32x16 pA0, pA1, pB0, pB1; float mnA, mnB, alA, alB; bf16x8 pa0, pa1, pa2, pa3; const int NT = seq / KVBLK;
  constexpr int SE = 0, SO = SDEPTH - 1;
  SLOAD(SE, 0); asm volatile("s_waitcnt vmcnt(0)" ::: "memory"); SWRITE(0, SE); __syncthreads();
  qkt(pA0, pA1, K_lds, qr, r32, hi); partialSM(pA0, pA1, m_reg, mnA, alA);
  SLOAD(SO, KVBLK); if constexpr (SDEPTH == 2) { if (2 < NT) SLOAD(SE, 2 * KVBLK); }
  SWAIT(); SWRITE(1, SO); __syncthreads();
  for (int j = 1; j + 1 < NT; j += 2) {
    SBAR(); qkt(pB0, pB1, (bf16*)((char*)K_lds + SHM_K), qr, r32, hi);
    finishSM(pA0, pA1, alA, l_reg, pa0, pa1, pa2, pa3); SBAR();
    SLOAD(SO, (j + SDEPTH) * KVBLK); SBAR();
    pv_d0(o, vb0, pa0, pa1, pa2, pa3); partialSM(pB0, pB1, m_reg, mnB, alB);
    __syncthreads(); SWAIT(); SWRITE(0, SE);
    RESC(alB); __syncthreads();
    SBAR(); qkt(pA0, pA1, K_lds, qr, r32, hi);
    finishSM(pB0, pB1, alB, l_reg, pa0, pa1, pa2, pa3); SBAR();
    if (SDEPTH == 1 || j + 3 < NT) SLOAD(SE, (j + 1 + SDEPTH) * KVBLK); SBAR();
    pv_d0(o, vb0 + (int)SHM_V, pa0, pa1, pa2, pa3); partialSM(pA0, pA1, m_reg, mnA, alA);
    __syncthreads(); SWAIT(); SWRITE(1, SO);
    RESC(alA); __syncthreads();
  }
  SBAR(); qkt(pB0, pB1, (bf16*)((char*)K_lds + SHM_K), qr, r32, hi);
  finishSM(pA0, pA1, alA, l_reg, pa0, pa1, pa2, pa3); SBAR();
  pv_d0(o, vb0, pa0, pa1, pa2, pa3); partialSM(pB0, pB1, m_reg, mnB, alB);
  __syncthreads(); RESC(alB);
  finishSM(pB0, pB1, alB, l_reg, pa0, pa1, pa2, pa3); SBAR();
  pv_d0(o, vb0 + (int)SHM_V, pa0, pa1, pa2, pa3);
  if (hi == 0) li_l[r32] = l_reg; asm volatile("s_waitcnt lgkmcnt(0)" ::: "memory");
  float rli[16];
#pragma unroll
  for (int r = 0; r < 16; ++r) rli[r] = __builtin_amdgcn_rcpf(li_l[crow(r, hi)]);
  bf16* Ow = Ob + (long)(wid * QBLK) * LDO;
#pragma unroll
  for (int r = 0; r < 16; ++r) { int orow = crow(r, hi);
    for (int d0 = 0; d0 < 4; ++d0) Ow[(long)orow * LDO + d0 * 32 + r32] = __float2bfloat16(o[d0][r] * rli[r]); }
#undef SLOAD
#undef SWRITE
#undef SWAIT
#undef RESC
}
}

constexpr int NWAVES = 8;
constexpr int N_PHASES = 1 + 8 * NLAYER;

constexpr size_t MiB = 1u << 20;
constexpr size_t WS_CTL = 0, CTL_ZERO_BYTES = 1 * MiB;
constexpr size_t SZ_WIN = (size_t)NIN * DM * 2, SZ_WOUT = (size_t)DM * DM * 2, SZ_WGU = (size_t)NGU * DM * 2, SZ_WDN = (size_t)DM * DFF * 2;
constexpr size_t SZ_WLAYER = SZ_WIN + SZ_WOUT + SZ_WGU + SZ_WDN;
constexpr size_t WS_W0 = 2 * MiB;
constexpr size_t WS_H = WS_W0 + NLAYER * SZ_WLAYER;
constexpr size_t SZ_ACT = (size_t)M_TOK * DM * 2;
constexpr size_t WS_PRE = WS_H + SZ_ACT;
constexpr size_t WS_PROJ = WS_PRE + SZ_ACT;
constexpr size_t WS_MIX = WS_PROJ + (size_t)M_TOK * NIN * 2;
constexpr size_t WS_HID = WS_PROJ;
constexpr size_t WS_END = WS_MIX + SZ_ACT;
static_assert(WS_HID + (size_t)M_TOK * DFF * 2 <= WS_END, "hidden overlay fits proj|mix");
static_assert(SZ_WIN % MiB == 0 && SZ_WOUT % MiB == 0 && SZ_WGU % MiB == 0 && SZ_WDN % MiB == 0, "weight copies MiB-aligned");
constexpr int CW_TMO = 0, CW_CODE = 1;
constexpr int CW_BAR = 4096;

constexpr int RING_OFF = 0, RING_BYTES = 131072;
constexpr int LDSCTL_OFF = RING_BYTES, MISC_OFF = LDSCTL_OFF + 320;
constexpr int LDS_BYTES = 147456;
static_assert(MISC_OFF + 128 <= LDS_BYTES, "LDS map");

#define GAS __attribute__((address_space(1)))
#define LAS __attribute__((address_space(3)))
typedef unsigned short bf16;
typedef unsigned v4u __attribute__((ext_vector_type(4)));
typedef float f32x4 __attribute__((ext_vector_type(4)));
typedef short bf16x8 __attribute__((ext_vector_type(8)));
typedef GAS unsigned gu32;
typedef GAS unsigned long long gu64;
#define RLX_AGENT __ATOMIC_RELAXED, __HIP_MEMORY_SCOPE_AGENT
#define LDS_WAIT() asm volatile("s_waitcnt lgkmcnt(0)" ::: "memory")
#define VM_WAIT() asm volatile("s_waitcnt vmcnt(0)" ::: "memory")
__device__ __forceinline__ unsigned long long rt() { return __builtin_amdgcn_s_memrealtime(); }
__device__ __forceinline__ unsigned f2bf(float f) { unsigned u = __builtin_bit_cast(unsigned, f); return (u + 0x7fffu + ((u >> 16) & 1u)) >> 16; }
__device__ __forceinline__ unsigned pk2(float lo, float hi) { return f2bf(lo) | (f2bf(hi) << 16); }
#define XB_TMO      128
#define XB_XCNT(j)  (256  + 64 * (j))
#define XB_XSUB(j)  (1280 + 64 * (j))
#define XB_XGEN(j)  (2304 + 64 * (j))
#define XB_TOP      3328
#define XB_TOPGEN   3392
#define XCD_BAR_WORDS 3456
#define XB_SPIN_CAP (1u << 18)

__device__ __forceinline__ unsigned xb_ld(unsigned* p)              { return __hip_atomic_load(p, __ATOMIC_RELAXED, __HIP_MEMORY_SCOPE_AGENT); }
__device__ __forceinline__ unsigned xb_add(unsigned* p, unsigned v) { return __hip_atomic_fetch_add(p, v, __ATOMIC_RELAXED, __HIP_MEMORY_SCOPE_AGENT); }
__device__ __forceinline__ unsigned xb_xcc_id() { return (unsigned)__builtin_amdgcn_s_getreg((3 << 11) | 20) & 0xFu; }
#define XB_SPIN(cond, bar) do { unsigned _sp = 0; while (cond) { __builtin_amdgcn_s_sleep(1); \
    if ((++_sp & 255u) == 0u) { if (xb_ld(&(bar)[XB_TMO])) break; if (_sp > XB_SPIN_CAP) { atomicAdd(&(bar)[XB_TMO], 1u); break; } } } } while (0)

struct XcdBarrier {
    unsigned* bar; unsigned x;
    volatile LAS unsigned* st;
};

__device__ __forceinline__ XcdBarrier xcd_barrier_post(unsigned* bar, volatile LAS unsigned* st) {
    XcdBarrier b; b.bar = bar; b.x = xb_xcc_id(); b.st = st;
    if (threadIdx.x == 0) (void)xb_add(&bar[XB_XCNT(b.x)], 1u);
    return b;
}
__device__ __forceinline__ void xcd_barrier_complete(unsigned* bar, unsigned x, unsigned& nloc, unsigned& nx) {
    const unsigned G = gridDim.x * gridDim.y * gridDim.z;
    unsigned sum, cnt, mine, sp = 0u;
    for (;;) {
        sum = 0u; cnt = 0u; mine = 0u;
#pragma unroll
        for (unsigned j = 0; j < 16; ++j) { const unsigned c = xb_ld(&bar[XB_XCNT(j)]); sum += c; cnt += (c > 0u) ? 1u : 0u; mine = (j == x) ? c : mine; }
        if (sum == G) break;
        __builtin_amdgcn_s_sleep(1);
        if ((++sp & 255u) == 0u) { if (xb_ld(&bar[XB_TMO])) break; if (sp > XB_SPIN_CAP) { atomicAdd(&bar[XB_TMO], 1u); break; } }
    }
    nloc = mine > 0u ? mine : 1u; nx = cnt > 0u ? cnt : 1u;
}

__device__ __forceinline__ void xcd_barrier(const XcdBarrier& b) {
    asm volatile("s_waitcnt vmcnt(0)" ::: "memory");
    __syncthreads();
    if (threadIdx.x == 0) {
        unsigned* bar = b.bar;
        __builtin_amdgcn_s_waitcnt(0);
        unsigned nloc = b.st[0], nx = b.st[1];
        if (nloc == 0u) { xcd_barrier_complete(bar, b.x, nloc, nx); b.st[0] = nloc; b.st[1] = nx; }
        const unsigned old = xb_add(&bar[XB_XSUB(b.x)], 1u);
        const unsigned gen = old / nloc;
        if (old + 1u == (gen + 1u) * nloc) {
            __builtin_amdgcn_fence(__ATOMIC_RELEASE, "agent");
            asm volatile("s_waitcnt vmcnt(0)" ::: "memory");
            const unsigned og = xb_add(&bar[XB_TOP], 1u);
            const unsigned tg = og / nx;
            if (og + 1u == (tg + 1u) * nx) xb_add(&bar[XB_TOPGEN], 1u);
            else XB_SPIN(xb_ld(&bar[XB_TOPGEN]) == tg, bar);
            __builtin_amdgcn_fence(__ATOMIC_ACQUIRE, "agent");
            xb_add(&bar[XB_XGEN(b.x)], 1u);
            asm volatile("s_waitcnt vmcnt(0)" ::: "memory");
        } else {
            XB_SPIN(xb_ld(&bar[XB_XGEN(b.x)]) == gen, bar);
            __builtin_amdgcn_fence(__ATOMIC_ACQUIRE, "agent");
            asm volatile("s_waitcnt vmcnt(0)" ::: "memory");
        }
    }
    __syncthreads();
}

struct Frame {
    LAS unsigned char* lds;
    volatile LAS unsigned* MISC;
    gu32* ctl;
    int tid, lane, wave;
    int vcu, G;
};
typedef unsigned v2u __attribute__((ext_vector_type(2)));

__device__ __forceinline__ float wave_sum(float v) {
#pragma unroll
    for (int o = 1; o < 64; o <<= 1) v += __shfl_xor(v, o);
    return v;
}
__device__ __forceinline__ float bf_lo(unsigned w) { return __uint_as_float(w << 16); }
__device__ __forceinline__ float bf_hi(unsigned w) { return __uint_as_float(w & 0xffff0000u); }
__device__ __forceinline__ unsigned pkbf(float lo, float hi) { return pg8::cvt_pk_bf16(lo, hi); }
__device__ __forceinline__ void seq_of(int m, int& s0, int& slen) { if (m < SEQ_P) { s0 = 0; slen = SEQ_P; } else { s0 = SEQ_P + ((m - SEQ_P) / SEQ_S) * SEQ_S; slen = SEQ_S; } }
__device__ __forceinline__ const float* xin_row(const float* xp, const float* xs, int m) { return m < SEQ_P ? xp + (size_t)m * DM : xs + (size_t)(m - SEQ_P) * DM; }

__device__ __forceinline__ void transpose_item(const float* W, int ldw, bf16* WT, int ldo, int orow0, int k0, int n0, LAS float* scr, int lane) {
#pragma unroll 8
    for (int i = 0; i < 32; ++i) { const int kk = 2 * i + (lane >> 5); scr[kk * 33 + (lane & 31)] = W[(size_t)(k0 + kk) * ldw + n0 + (lane & 31)]; }
    LDS_WAIT(); asm volatile("" ::: "memory");
    const int c = lane & 7;
#pragma unroll
    for (int j = 0; j < 4; ++j) { const int n = (lane >> 3) + 8 * j; const LAS float* s = scr + (8 * c) * 33 + n;
        v4u o; o.x = pkbf(s[0 * 33], s[1 * 33]); o.y = pkbf(s[2 * 33], s[3 * 33]); o.z = pkbf(s[4 * 33], s[5 * 33]); o.w = pkbf(s[6 * 33], s[7 * 33]);
        *(GAS v4u*)(WT + (size_t)(orow0 + n) * ldo + k0 + 8 * c) = o; }
    LDS_WAIT(); asm volatile("" ::: "memory");
}
__device__ __forceinline__ void fold_item(const float* pool_w, const float* pscale, const float* Wout, bf16* WT, int item, int lane) {
    const int nblk = item & 63, cblk = (item >> 6) & 31, g = item >> 11;
    const int n = nblk * 64 + lane, c0 = cblk * 8;
    const float* pw = pool_w + (size_t)g * 65536 + (size_t)c0 * 256;
    const float* sc = pscale + g * 256;
    const float* wo = Wout + (size_t)(MX_P + g * 256) * DM + n;
    float acc[8];
#pragma unroll
    for (int cc = 0; cc < 8; ++cc) acc[cc] = 0.f;
#pragma unroll 4
    for (int d = 0; d < 256; ++d) { const float wv = wo[(size_t)d * DM] * sc[d];
#pragma unroll
        for (int cc = 0; cc < 8; ++cc) acc[cc] = fmaf(pw[cc * 256 + d], wv, acc[cc]); }
    v4u o; o.x = pkbf(acc[0], acc[1]); o.y = pkbf(acc[2], acc[3]); o.z = pkbf(acc[4], acc[5]); o.w = pkbf(acc[6], acc[7]);
    *(GAS v4u*)(WT + (size_t)n * DM + MX_P + g * 256 + c0) = o;
}
struct LayerW { bf16 *win, *wout, *wgu, *wdn; };
__device__ __forceinline__ LayerW layer_w(unsigned char* ws, int l) { LayerW w; unsigned char* b = ws + WS_W0 + (size_t)l * SZ_WLAYER;
    w.win = (bf16*)b; w.wout = (bf16*)(b + SZ_WIN); w.wgu = (bf16*)(b + SZ_WIN + SZ_WOUT); w.wdn = (bf16*)(b + SZ_WIN + SZ_WOUT + SZ_WGU); return w; }

constexpr int I_IN = (DM / 64) * (NIN / 32), I_OUT = (MX_P / 64) * (DM / 32), I_G = (DM / 64) * (DFF / 32), I_D = (DFF / 64) * (DM / 32), I_FOLD = 4 * 32 * 64;
constexpr int I_TR_LAYER = I_IN + I_OUT + 2 * I_G + I_D;

__device__ __forceinline__ void prenorm_phase(Frame& F, const float* xp, const float* xs, const float* g, bf16* H) {
    LAS f32x4* G1 = (LAS f32x4*)(F.lds + RING_OFF);
    for (int i = F.tid; i < DM / 4; i += NWAVES * 64) G1[i] = ((const GAS f32x4*)g)[i];
    __syncthreads();
    const int gw = F.vcu * NWAVES + F.wave, NGW = F.G * NWAVES;
    for (int m = gw; m < M_TOK; m += NGW) {
        const GAS f32x4* xr = (const GAS f32x4*)xin_row(xp, xs, m) + F.lane;
        f32x4 v[16]; float s = 0.f;
#pragma unroll
        for (int j = 0; j < 16; ++j) { v[j] = xr[64 * j]; s += (v[j].x * v[j].x + v[j].y * v[j].y) + (v[j].z * v[j].z + v[j].w * v[j].w); }
        const float rstd = 1.0f / sqrtf(wave_sum(s) * (1.f / DM) + RMS_EPS);
        GAS v2u* o8 = (GAS v2u*)(H + (size_t)m * DM) + F.lane;
#pragma unroll
        for (int j = 0; j < 16; ++j) { const f32x4 gg = G1[F.lane + 64 * j]; v2u o; o.x = pkbf(v[j].x * rstd * gg.x, v[j].y * rstd * gg.y); o.y = pkbf(v[j].z * rstd * gg.z, v[j].w * rstd * gg.w); o8[64 * j] = o; }
    }
    __syncthreads();
}
__device__ __forceinline__ void resnorm_phase(Frame& F, bool from_in, const float* xp, const float* xs, float* out, const bf16* PRE, const float* g1, const float* g2, bf16* H) {
    LAS f32x4* G1 = (LAS f32x4*)(F.lds + RING_OFF); LAS f32x4* G2 = G1 + DM / 4;
    for (int i = F.tid; i < DM / 4; i += NWAVES * 64) { G1[i] = ((const GAS f32x4*)g1)[i]; if (g2) G2[i] = ((const GAS f32x4*)g2)[i]; }
    __syncthreads();
    const int gw = F.vcu * NWAVES + F.wave, NGW = F.G * NWAVES;
    for (int m = gw; m < M_TOK; m += NGW) {
        const float* xrow = from_in ? xin_row(xp, xs, m) : out + (size_t)m * DM;
        const GAS f32x4* xr = (const GAS f32x4*)xrow + F.lane;
        const GAS v2u* pr = (const GAS v2u*)(PRE + (size_t)m * DM) + F.lane;
        f32x4 v[16]; v2u p[16]; float s = 0.f;
#pragma unroll
        for (int j = 0; j < 16; ++j) { v[j] = xr[64 * j]; p[j] = pr[64 * j]; }
#pragma unroll
        for (int j = 0; j < 16; ++j) { const float a = bf_lo(p[j].x), b = bf_hi(p[j].x), c = bf_lo(p[j].y), d = bf_hi(p[j].y); s += (a * a + b * b) + (c * c + d * d); }
        const float rstd1 = 1.0f / sqrtf(wave_sum(s) * (1.f / DM) + RMS_EPS);
        GAS f32x4* xo = (GAS f32x4*)(out + (size_t)m * DM) + F.lane;
        float s2 = 0.f;
#pragma unroll
        for (int j = 0; j < 16; ++j) { const f32x4 gg = G1[F.lane + 64 * j];
            v[j].x += bf_lo(p[j].x) * rstd1 * gg.x; v[j].y += bf_hi(p[j].x) * rstd1 * gg.y; v[j].z += bf_lo(p[j].y) * rstd1 * gg.z; v[j].w += bf_hi(p[j].y) * rstd1 * gg.w;
            s2 += (v[j].x * v[j].x + v[j].y * v[j].y) + (v[j].z * v[j].z + v[j].w * v[j].w);
            xo[64 * j] = v[j]; }
        if (g2) {
            const float rstd2 = 1.0f / sqrtf(wave_sum(s2) * (1.f / DM) + RMS_EPS);
            GAS v2u* o8 = (GAS v2u*)(H + (size_t)m * DM) + F.lane;
#pragma unroll
            for (int j = 0; j < 16; ++j) { const f32x4 gg = G2[F.lane + 64 * j]; v2u o; o.x = pkbf(v[j].x * rstd2 * gg.x, v[j].y * rstd2 * gg.y); o.y = pkbf(v[j].z * rstd2 * gg.z, v[j].w * rstd2 * gg.w); o8[64 * j] = o; }
        }
    }
    __syncthreads();
}

__device__ __forceinline__ void unpack8(const v4u w, float (&x)[8]) { x[0] = bf_lo(w.x); x[1] = bf_hi(w.x); x[2] = bf_lo(w.y); x[3] = bf_hi(w.y); x[4] = bf_lo(w.z); x[5] = bf_hi(w.z); x[6] = bf_lo(w.w); x[7] = bf_hi(w.w); }
__device__ __forceinline__ v4u pack8(const float (&x)[8]) { v4u o; o.x = pkbf(x[0], x[1]); o.y = pkbf(x[2], x[3]); o.z = pkbf(x[4], x[5]); o.w = pkbf(x[6], x[7]); return o; }
__device__ __forceinline__ void mixer_elem_phase(Frame& F, bf16* PROJ, bf16* MIX, const float* qg, const float* kg, const float* conv_w) {
    const int gw = F.vcu * NWAVES + F.wave, NGW = F.G * NWAVES, lane = F.lane;
    {
        const int s = lane & 15;
        float qgv[8], kgv[8], invf[8];
#pragma unroll
        for (int e = 0; e < 8; ++e) { qgv[e] = qg[8 * s + e]; kgv[e] = kg[8 * s + e]; invf[e] = __builtin_amdgcn_exp2f(-(float)(8 * (s & 3) + e) * (13.287712379549449f / 32.0f)); }
        const float sgn = (s & 4) ? 1.f : -1.f;
        for (int m = gw; m < M_TOK; m += NGW) {
            int s0, slen; seq_of(m, s0, slen); const int t = m - s0;
            const float pos = (s < 8) ? (float)(t >> 6) : (float)(t & 63);
            float cs[8], sn[8];
#pragma unroll
            for (int e = 0; e < 8; ++e) { float rev = (pos * invf[e]) * 0.15915494309189535f; rev -= floorf(rev); cs[e] = __builtin_amdgcn_cosf(rev); sn[e] = __builtin_amdgcn_sinf(rev); }
            GAS v4u* rowp = (GAS v4u*)(PROJ + (size_t)m * NIN) + lane;
            v4u w[5];
#pragma unroll
            for (int ps = 0; ps < 5; ++ps) w[ps] = rowp[64 * ps];
#pragma unroll
            for (int ps = 0; ps < 5; ++ps) {
                float x[8]; unpack8(w[ps], x);
                float ss = 0.f;
#pragma unroll
                for (int e = 0; e < 8; ++e) ss += x[e] * x[e];
                ss += __shfl_xor(ss, 1); ss += __shfl_xor(ss, 2); ss += __shfl_xor(ss, 4); ss += __shfl_xor(ss, 8);
                const float rstd = 1.0f / sqrtf(ss * (1.f / HD) + RMS_EPS);
                float y[8], o[8];
#pragma unroll
                for (int e = 0; e < 8; ++e) y[e] = x[e] * rstd * (ps < 4 ? qgv[e] : kgv[e]);
#pragma unroll
                for (int e = 0; e < 8; ++e) { const float pe = __shfl_xor(y[e], 4); o[e] = y[e] * cs[e] + sgn * pe * sn[e]; }
                rowp[64 * ps] = pack8(o);
            }
        }
    }
    for (int it = gw; it < (M_TOK / 8) * 2; it += NGW) {
        const int m0 = (it >> 1) * 8, c0 = (it & 1) * 512 + lane * 8;
        int s0, slen; seq_of(m0, s0, slen); const int s1 = s0 + slen;
        float w0[8], w1[8], w2[8];
#pragma unroll
        for (int e = 0; e < 8; ++e) { w0[e] = conv_w[c0 + e]; w1[e] = conv_w[1024 + c0 + e]; w2[e] = conv_w[2048 + c0 + e]; }
        float up[8], uc[8], un[8];
#define LOAD_U(dst, mm) do { if ((mm) >= s0 && (mm) < s1) { const bf16* r_ = PROJ + (size_t)(mm) * NIN + c0; float a_[8], b_[8]; unpack8(*(const GAS v4u*)(r_ + C_CH), a_); unpack8(*(const GAS v4u*)(r_ + C_CC), b_); \
        _Pragma("unroll") for (int e = 0; e < 8; ++e) dst[e] = a_[e] * b_[e]; } else { _Pragma("unroll") for (int e = 0; e < 8; ++e) dst[e] = 0.f; } } while (0)
        LOAD_U(up, m0 - 1); LOAD_U(uc, m0);
        for (int i = 0; i < 8; ++i) { const int m = m0 + i;
            LOAD_U(un, m + 1);
            float gb[8], o[8]; unpack8(*(const GAS v4u*)(PROJ + (size_t)m * NIN + C_CB + c0), gb);
#pragma unroll
            for (int e = 0; e < 8; ++e) { o[e] = gb[e] * (up[e] * w0[e] + uc[e] * w1[e] + un[e] * w2[e]); up[e] = uc[e]; uc[e] = un[e]; }
            *(GAS v4u*)(MIX + (size_t)m * DM + MX_C + c0) = pack8(o); }
#undef LOAD_U
    }
    for (int it = gw; it < (M_TOK / 8) * 2; it += NGW) {
        const int m0 = (it >> 1) * 8, half = it & 1, c0 = half * 512 + lane * 8;
        const int hw = 1 << (half * 2 + (lane >> 5));
        int s0, slen; seq_of(m0, s0, slen); const int s1 = s0 + slen;
        const bf16* col = PROJ + C_PU + c0;
        float S[8];
#pragma unroll
        for (int e = 0; e < 8; ++e) S[e] = 0.f;
        for (int k = 0; k < 16; ++k) { const int sidx = m0 - hw + k;
            if (k < 2 * hw && sidx >= s0 && sidx < s1) { float a[8]; unpack8(*(const GAS v4u*)(col + (size_t)sidx * NIN), a);
#pragma unroll
                for (int e = 0; e < 8; ++e) S[e] += a[e]; } }
        for (int i = 0; i < 8; ++i) { const int m = m0 + i;
            const int lo = (m - hw > s0) ? m - hw : s0, hi = (m + hw < s1) ? m + hw : s1;
            const float rc = 1.0f / (float)(hi - lo);
            float cur[8], o[8]; unpack8(*(const GAS v4u*)(col + (size_t)m * NIN), cur);
#pragma unroll
            for (int e = 0; e < 8; ++e) o[e] = S[e] * rc - cur[e];
            *(GAS v4u*)(MIX + (size_t)m * DM + MX_P + c0) = pack8(o);
            if (m + hw < s1) { float a[8]; unpack8(*(const GAS v4u*)(col + (size_t)(m + hw) * NIN), a);
#pragma unroll
                for (int e = 0; e < 8; ++e) S[e] += a[e]; }
            if (m - hw >= s0) { float a[8]; unpack8(*(const GAS v4u*)(col + (size_t)(m - hw) * NIN), a);
#pragma unroll
                for (int e = 0; e < 8; ++e) S[e] -= a[e]; } }
    }
}

__device__ __forceinline__ void attn_phase(Frame& F, const bf16* PROJ, bf16* MIX) {
    for (int u = F.vcu; u < 1536; u += F.G) {
        int seq, kvh, head, qb;
        if (u < 1024) { const int i = u >> 8, v = u & 255, x = v >> 5, j = v & 31; seq = 0; kvh = i; qb = 8 * x + (j & 7); head = kvh * 4 + (j >> 3); }
        else { const int u2 = u - 1024, i = u2 >> 8, v = u2 & 255, x = v >> 5, j = v & 31, e = i * 8 + x, sk = e >> 1; seq = 1 + (sk >> 2); kvh = sk & 3; qb = 8 * (e & 1) + (j & 7); head = kvh * 4 + (j >> 3); }
        const int row0 = seq == 0 ? 0 : SEQ_P + (seq - 1) * SEQ_S, slen = seq == 0 ? SEQ_P : SEQ_S;
        const attn128::bf16* Qb = (const attn128::bf16*)(PROJ + (size_t)(row0 + qb * 256) * NIN + C_Q + head * HD);
        const attn128::bf16* Kh = (const attn128::bf16*)(PROJ + (size_t)row0 * NIN + C_K + kvh * HD);
        const attn128::bf16* Vh = (const attn128::bf16*)(PROJ + (size_t)row0 * NIN + C_V + kvh * HD);
        attn128::bf16* Ob = (attn128::bf16*)(MIX + (size_t)(row0 + qb * 256) * DM + MX_A + head * HD);
        attn128::attn_dense_body<attn128::bf16>(Qb, Kh, Vh, Ob, slen, (char*)F.lds + RING_OFF);
        __syncthreads();
    }
}


struct Ptrs { const float *xp, *xs, *ln_mix_pre, *ln_mix_post, *ln_ffn_pre, *ln_ffn_post, *q_norm, *k_norm, *conv_w; float* out; unsigned char* ws; };
#if MK_FUSED
#define GRID_BAR() xcd_barrier(bar)
#else
#define GRID_BAR() do { } while (0)
#endif
#define IN(k) (lo <= (k) && (k) < hi)
#define SEAM(k) do { if (IN((k) + 1)) GRID_BAR(); } while (0)
template <int L> __device__ __forceinline__ void layer_phases(Frame& F, const Ptrs P, const int lo, const int hi, const XcdBarrier bar) {
    unsigned char* ws = P.ws; const float* xp = P.xp; const float* xs = P.xs; float* out = P.out;
    const float *ln_mix_pre = P.ln_mix_pre, *ln_mix_post = P.ln_mix_post, *ln_ffn_pre = P.ln_ffn_pre, *ln_ffn_post = P.ln_ffn_post, *q_norm = P.q_norm, *k_norm = P.k_norm, *conv_w = P.conv_w;
    bf16* H = (bf16*)(ws + WS_H); bf16* PRE = (bf16*)(ws + WS_PRE); bf16* PROJ = (bf16*)(ws + WS_PROJ); bf16* MIX = (bf16*)(ws + WS_MIX); bf16* HID = (bf16*)(ws + WS_HID);
    {
        constexpr int l = L; const int pb = 1 + 8 * l; const LayerW W = layer_w(ws, l);
        if (IN(pb + 0)) {
            pg8::Gemm g{H, W.win, M_TOK, NIN, DM}; pg8::StaticOrder S; S.init(M_TOK, NIN, F.G, (int)blockIdx.x);
            pg8::EpiBf16 E{PROJ, NIN};
            pg8::gemm_phase<pg8::EpiBf16, pg8::StaticOrder, true, true>(F.lds + RING_OFF, g, S, E);
            SEAM(pb + 0);
        }
        if (IN(pb + 1)) { mixer_elem_phase(F, PROJ, MIX, q_norm + l * HD, k_norm + l * HD, conv_w + l * 3 * 1024); SEAM(pb + 1); }
        if (IN(pb + 2)) { attn_phase(F, PROJ, MIX); SEAM(pb + 2); }
        if (IN(pb + 3)) {
            pg8::Gemm g{MIX, W.wout, M_TOK, DM, DM}; pg8::StaticOrder S; S.init(M_TOK, DM, F.G, (int)blockIdx.x);
            pg8::EpiBf16 E{PRE, DM};
            pg8::gemm_phase<pg8::EpiBf16, pg8::StaticOrder, true, true>(F.lds + RING_OFF, g, S, E);
            SEAM(pb + 3);
        }
        if (IN(pb + 4)) { resnorm_phase(F, l == 0, xp, xs, out, PRE, ln_mix_post + l * DM, ln_ffn_pre + l * DM, H); SEAM(pb + 4); }
        if (IN(pb + 5)) {
            pg8::Gemm g{H, W.wgu, M_TOK, NGU, DM}; pg8::StaticOrder S; S.init(M_TOK, NGU, F.G, (int)blockIdx.x);
            pg8::EpiSwiGLU E{HID, DFF};
            pg8::gemm_phase<pg8::EpiSwiGLU, pg8::StaticOrder, true, true>(F.lds + RING_OFF, g, S, E);
            SEAM(pb + 5);
        }
        if (IN(pb + 6)) {
            pg8::Gemm g{HID, W.wdn, M_TOK, DM, DFF}; pg8::StaticOrder S; S.init(M_TOK, DM, F.G, (int)blockIdx.x);
            pg8::EpiBf16 E{PRE, DM};
            pg8::gemm_phase<pg8::EpiBf16, pg8::StaticOrder, true, true>(F.lds + RING_OFF, g, S, E);
            SEAM(pb + 6);
        }
        if (IN(pb + 7)) { resnorm_phase(F, false, xp, xs, out, PRE, ln_ffn_post + l * DM, (l + 1 < NLAYER) ? ln_mix_pre + (l + 1) * DM : nullptr, H); SEAM(pb + 7); }
    }
}

struct Args { const float* in[16]; float* out; unsigned char* ws; int ph_lo, ph_hi; };
__global__ void __launch_bounds__(NWAVES * 64, 2) enc_fwd(Args args) {
    extern __shared__ __attribute__((aligned(16))) unsigned char lds[];
    Frame F;
    F.lds = (LAS unsigned char*)lds;
    F.MISC = (volatile LAS unsigned*)(F.lds + MISC_OFF);
    F.tid = threadIdx.x; F.lane = F.tid & 63; F.wave = __builtin_amdgcn_readfirstlane(F.tid >> 6);
    F.G = gridDim.x; { const int bx = blockIdx.x; F.vcu = (F.G % 8 == 0) ? (bx % 8) * (F.G / 8) + bx / 8 : bx; }
    unsigned char* ws = args.ws;
    F.ctl = (gu32*)(ws + WS_CTL);
    for (int u = F.tid; u < (LDS_BYTES - LDSCTL_OFF) / 4; u += NWAVES * 64) ((LAS unsigned*)(F.lds + LDSCTL_OFF))[u] = 0u;
    __syncthreads();
#if MK_FUSED
    XcdBarrier bar = xcd_barrier_post((unsigned*)(F.ctl + CW_BAR), F.MISC + 8);
#else
    XcdBarrier bar; bar.bar = nullptr; bar.x = 0; bar.st = nullptr;
#endif
    const float* xp = args.in[0]; const float* xs = args.in[1];
    const float *ln_mix_pre = args.in[2], *ln_mix_post = args.in[3], *ln_ffn_pre = args.in[4], *ln_ffn_post = args.in[5], *q_norm = args.in[6], *k_norm = args.in[7];
    const float *w_in = args.in[8], *conv_w = args.in[9], *pool_w = args.in[10], *pool_scale = args.in[11], *w_out = args.in[12], *w_gate = args.in[13], *w_up = args.in[14], *w_down = args.in[15];
    float* out = args.out;
    bf16* H = (bf16*)(ws + WS_H); bf16* PRE = (bf16*)(ws + WS_PRE); bf16* PROJ = (bf16*)(ws + WS_PROJ); bf16* MIX = (bf16*)(ws + WS_MIX); bf16* HID = (bf16*)(ws + WS_HID);
    const int lo = args.ph_lo, hi = args.ph_hi;

    if (IN(0)) {
        LAS float* scr = (LAS float*)(F.lds + RING_OFF + F.wave * 16384);
        const int gw = F.vcu * NWAVES + F.wave, NGW = F.G * NWAVES;
        for (int it = gw; it < NLAYER * I_TR_LAYER; it += NGW) {
            const int l = it / I_TR_LAYER; int r = it % I_TR_LAYER; const LayerW W = layer_w(ws, l);
            if (r < I_IN) { const int kb = r / (NIN / 32), nb = r % (NIN / 32); transpose_item(w_in + (size_t)l * DM * NIN, NIN, W.win, DM, 32 * nb, 64 * kb, 32 * nb, scr, F.lane); continue; } r -= I_IN;
            if (r < I_OUT) { const int kb = r / (DM / 32), nb = r % (DM / 32); transpose_item(w_out + (size_t)l * DM * DM, DM, W.wout, DM, 32 * nb, 64 * kb, 32 * nb, scr, F.lane); continue; } r -= I_OUT;
            if (r < 2 * I_G) { const int up = r >= I_G; if (up) r -= I_G; const int kb = r / (DFF / 32), nb = r % (DFF / 32), n0 = 32 * nb;
                transpose_item((up ? w_up : w_gate) + (size_t)l * DM * DFF, DFF, W.wgu, DM, (n0 >> 7) * 256 + (n0 & 127) + (up ? 128 : 0), 64 * kb, n0, scr, F.lane); continue; } r -= 2 * I_G;
            { const int kb = r / (DM / 32), nb = r % (DM / 32); transpose_item(w_down + (size_t)l * DFF * DM, DM, W.wdn, DFF, 32 * nb, 64 * kb, 32 * nb, scr, F.lane); }
        }
        for (int it = gw; it < NLAYER * I_FOLD; it += NGW) { const int l = it / I_FOLD, r = it % I_FOLD; const LayerW W = layer_w(ws, l);
            fold_item(pool_w + (size_t)l * 4 * 65536, pool_scale + l * 1024, w_out + (size_t)l * DM * DM, W.wout, r, F.lane); }
        __syncthreads();
        prenorm_phase(F, xp, xs, ln_mix_pre, H);
        SEAM(0);
    }

    { Ptrs P{xp, xs, ln_mix_pre, ln_mix_post, ln_ffn_pre, ln_ffn_post, q_norm, k_norm, conv_w, out, ws};
      layer_phases<0>(F, P, lo, hi, bar);
      layer_phases<1>(F, P, lo, hi, bar); }
#undef IN
#undef SEAM
}

extern "C" void kernel_launch(void* const* d_in, const int* in_sizes, int n_in, void* d_out, int out_size, void* d_ws, size_t ws_size, hipStream_t stream) {
    static int grid = 0;
    if (grid == 0) {
        if (n_in != 16 || in_sizes[0] != SEQ_P * DM || in_sizes[1] != 2 * SEQ_S * DM || out_size != M_TOK * DM || ws_size < WS_END) {
            fprintf(stderr, "kernel_launch: shape mismatch (n_in %d, in0 %d, out %d, ws %zu, need ws >= %zu); nothing launched\n", n_in, n_in > 0 ? in_sizes[0] : -1, out_size, ws_size, (size_t)WS_END); grid = -1; return; }
        int dev = 0, cus = 0, per_cu = 0;
        if (hipGetDevice(&dev) != hipSuccess || hipDeviceGetAttribute(&cus, hipDeviceAttributeMultiprocessorCount, dev) != hipSuccess) { fprintf(stderr, "kernel_launch: device query failed\n"); grid = -1; return; }
        if (hipFuncSetAttribute((const void*)enc_fwd, hipFuncAttributeMaxDynamicSharedMemorySize, LDS_BYTES) != hipSuccess) { fprintf(stderr, "kernel_launch: hipFuncSetAttribute failed\n"); grid = -1; return; }
        if (hipOccupancyMaxActiveBlocksPerMultiprocessor(&per_cu, (const void*)enc_fwd, NWAVES * 64, LDS_BYTES) != hipSuccess || per_cu < 1) {
            fprintf(stderr, "kernel_launch: occupancy query reports %d workgroups per CU; nothing launched\n", per_cu); (void)hipGetLastError(); grid = -1; return; }
        grid = cus;
    }
    if (grid < 0) return;
    if (hipMemsetAsync((char*)d_ws + WS_CTL, 0, CTL_ZERO_BYTES, stream) != hipSuccess) { fprintf(stderr, "kernel_launch: hipMemsetAsync failed\n"); return; }
    Args a{};
    for (int i = 0; i < 16; ++i) a.in[i] = (const float*)d_in[i];
    a.out = (float*)d_out; a.ws = (unsigned char*)d_ws;
#if MK_FUSED
    a.ph_lo = 0; a.ph_hi = N_PHASES;
    hipLaunchKernelGGL(enc_fwd, dim3(grid), dim3(NWAVES * 64), LDS_BYTES, stream, a);
#else
    for (int p = 0; p < N_PHASES; ++p) { a.ph_lo = p; a.ph_hi = p + 1; hipLaunchKernelGGL(enc_fwd, dim3(grid), dim3(NWAVES * 64), LDS_BYTES, stream, a); }
#endif
    const hipError_t le = hipPeekAtLastError();
    if (le != hipSuccess) fprintf(stderr, "kernel_launch: launch failed: %s (grid %d)\n", hipGetErrorName(le), grid);
}
```

```cpp
#include <hip/hip_runtime.h>
#include <hip/hip_bf16.h>
#include <cstdio>
#include <cstdint>

#ifndef MK_FUSED
#define MK_FUSED 1
#endif

#ifndef ATTN_DMA
#define ATTN_DMA 3
#endif
#define ATTN_PIN 0
#define PP_ONEBAR 0
#define PP_V2AHEAD 0
#define PP_RING 4
#define PP_LMFMA 0
#define PP_PREF16 1
#define PP_VT 1
#define PP_VDMA_M 1
#define PP_ONEBAR16 0
#define PP_SUMVOTE 0
#define PP_CVIS 2
#define PP_PRIO 2
#define KSW 15
#define PP_LATEWAIT 0
#define PP_DMALATE 0
#define PP_ALIGN 0
#define PP_NEGM 1
#define Q_PRESCALE (ATTN_DMA >= 2 && PP_NEGM)
#define PP_PREF false
#define TR_NT_STORE 0
#define ATT_LASTQ 0
#define RN_NT 0
#define CONV_SPLIT 0
#define GU_CHUNKED 0
#define TAIL_OVL 0
#define GEMM_ALIGN false
#define GEMM_SP2 true
#define PROBE_HALF 0
#define PROBE_SENS 0
#ifndef PROBE_DUP
#define PROBE_DUP 0
#endif

#ifndef PROBE_CLK
#define PROBE_CLK 0
#endif

#ifndef PROBE_SET
#define PROBE_SET 0
#endif
#ifndef PROBE_IDLE
#define PROBE_IDLE 0
#endif
#ifndef PROBE_STAT
#define PROBE_STAT 0
#endif
#define PROBE_MULT 2

constexpr int DM = 4096, M_TOK = 24576, SEQ_P = 16384, SEQ_S = 4096, NLAYER = 2;
constexpr int NIN = 7168, DFF = 11008, NGU = 2 * DFF;
constexpr int HD = 128, NQH = 16, NKVH = 4;
constexpr int C_Q = 0, C_K = 2048, C_V = 2560, C_CH = 3072, C_CB = 4096, C_CC = 5120, C_PU = 6144;
constexpr int MX_A = 0, MX_C = 2048, MX_P = 3072;
constexpr float RMS_EPS = 1e-6f;
namespace pg8 {
#define PG8_LAS __attribute__((address_space(3)))
typedef unsigned short bf16_t;
typedef short bf16x8 __attribute__((ext_vector_type(8)));
typedef float f32x4 __attribute__((ext_vector_type(4)));
typedef unsigned u32x4 __attribute__((ext_vector_type(4)));
constexpr int BM = 256, BK = 64, HALF = 128, HTB = HALF * BK * 2  , STAGE_BYTES = 8 * HTB, NXCD = 8, WGM = 4;

__host__ __device__ __forceinline__ int lds_byte(int r, int c) { const int st = (r >> 4) * 2 + (c >> 5), rr = r & 15, cc = c & 31, ob = rr * 64 + cc * 2; return st * 1024 + (ob ^ (((ob >> 9) & 1) << 5)); }
__host__ __device__ __forceinline__ void stage_rc(int b, int& R, int& C) { const int st = b / 1024, sb = b % 1024, swz = sb ^ (((sb >> 9) & 1) << 5); R = (st >> 1) * 16 + swz / 64; C = (st & 1) * 32 + (swz % 64) / 2; }
__host__ __device__ __forceinline__ int perm32(int rho) { const int n = rho >> 4, i = rho & 15; return 8 * (i >> 2) + 4 * n + (i & 3); }

struct Unit { int pm, pn; };
struct Gemm { const bf16_t* A; const bf16_t* Bt; int M, N, K; };

struct StaticOrder {
    int nM, nN, nwg, G, c;
    __host__ __device__ void init(int M, int N, int G_, int c_) { nM = M / BM; nN = N / BM; nwg = nM * nN; G = G_; c = c_; }
    __host__ __device__ bool next(int i, Unit& u) const {
        const long L = (long)i * G + c; if (L >= nwg) return false;
        int wgid = (int)L; { const int q = nwg / NXCD, r = nwg % NXCD, xcd = wgid % NXCD, off = wgid / NXCD; wgid = (xcd < r ? xcd * (q + 1) : r * (q + 1) + (xcd - r) * q) + off; }
        const int nig = WGM * nN, gid = wgid / nig, fm = gid * WGM, gsz = (nM - fm) < WGM ? (nM - fm) : WGM;
        u.pm = fm + ((wgid % nig) % gsz); u.pn = (wgid % nig) / gsz; return true;
    }
    __device__ __forceinline__ void a_ready(const Unit&) const {}
    __device__ __forceinline__ void done(const Unit&) const {}
};

template <int I0, int I1> struct RangeOrder {
    StaticOrder S;
    __host__ __device__ bool next(int i, Unit& u) const { return (i + I0 < I1) && S.next(i + I0, u); }
    __device__ __forceinline__ void a_ready(const Unit&) const {}
    __device__ __forceinline__ void done(const Unit&) const {}
};

__device__ __forceinline__ unsigned cvt_pk_bf16(float lo, float hi) { unsigned r; asm volatile("v_cvt_pk_bf16_f32 %0, %1, %2" : "=v"(r) : "v"(lo), "v"(hi)); return r; }
typedef float f32x2 __attribute__((ext_vector_type(2)));
template <bool NT_STORE> struct EpiBf16T {
    static constexpr bool PERM = true, AFTER_DRAIN = false;
    bf16_t* O; int ldc;
    __device__ __forceinline__ void operator()(const f32x4 (&acc)[2][2][4][2], const Unit& u, int wr, int wc, int fr, int fq) const {
        const int row0 = u.pm * BM + wr * 64 + fr; const int col0 = u.pn * BM + wc * 32 + 8 * fq;
#pragma unroll
        for (int ai = 0; ai < 2; ++ai)
#pragma unroll
            for (int m = 0; m < 4; ++m) { bf16_t* rowp = O + (size_t)(row0 + ai * HALF + m * 16) * ldc + col0;
#pragma unroll
                for (int bj = 0; bj < 2; ++bj) { const f32x4 v0 = acc[ai][bj][m][0], v1 = acc[ai][bj][m][1];
                    u32x4 w; w.x = cvt_pk_bf16(v0[0], v0[1]); w.y = cvt_pk_bf16(v0[2], v0[3]); w.z = cvt_pk_bf16(v1[0], v1[1]); w.w = cvt_pk_bf16(v1[2], v1[3]);
                    if (NT_STORE) __builtin_nontemporal_store(w, (u32x4*)(rowp + bj * HALF)); else *(u32x4*)(rowp + bj * HALF) = w; } }
    }
};
typedef EpiBf16T<false> EpiBf16; typedef EpiBf16T<true> EpiBf16NT;
__device__ __forceinline__ float silu_mul(float g, float u) { const float e = __builtin_amdgcn_exp2f(g * -1.4426950408889634f); return g * __builtin_amdgcn_rcpf(1.0f + e) * u; }
struct EpiSwiGLU {
    static constexpr bool PERM = true, AFTER_DRAIN = false;
    bf16_t* O; int ldc;
    __device__ __forceinline__ void operator()(const f32x4 (&acc)[2][2][4][2], const Unit& u, int wr, int wc, int fr, int fq) const {
        const int row0 = u.pm * BM + wr * 64 + fr; const int col0 = u.pn * HALF + wc * 32 + 8 * fq;
#pragma unroll
        for (int ai = 0; ai < 2; ++ai)
#pragma unroll
            for (int m = 0; m < 4; ++m) { bf16_t* rowp = O + (size_t)(row0 + ai * HALF + m * 16) * ldc + col0;
                const f32x4 g0 = acc[ai][0][m][0], g1 = acc[ai][0][m][1], u0 = acc[ai][1][m][0], u1 = acc[ai][1][m][1];
                u32x4 w; w.x = cvt_pk_bf16(silu_mul(g0[0], u0[0]), silu_mul(g0[1], u0[1])); w.y = cvt_pk_bf16(silu_mul(g0[2], u0[2]), silu_mul(g0[3], u0[3]));
                w.z = cvt_pk_bf16(silu_mul(g1[0], u1[0]), silu_mul(g1[1], u1[1])); w.w = cvt_pk_bf16(silu_mul(g1[2], u1[2]), silu_mul(g1[3], u1[3]));
                *(u32x4*)rowp = w; }
    }
};

struct ChunkOrder {
    int nN, x, r, vr;
    __host__ __device__ void init(int N, int c) { nN = N / BM; x = c & 7; r = c >> 3; vr = (nN - (r >> 2) + 7) / 8; }
    __host__ __device__ bool next(int i, Unit& u) const { const int chunk = i / vr, ri = i - chunk * vr; if (chunk >= 3) return false; u.pm = 32 * chunk + 4 * x + (r & 3); u.pn = 8 * ri + (r >> 2); return true; }
    __device__ __forceinline__ void a_ready(const Unit&) const {}
    __device__ __forceinline__ void done(const Unit&) const {}
};
template <class Epi, class Sched, bool ALIGN_EPI = false, bool SP2 = false>
__device__ __forceinline__ void gemm_phase(PG8_LAS unsigned char* lds, const Gemm g, const Sched& S, const Epi& E) {
    const int tid = threadIdx.x, wid = __builtin_amdgcn_readfirstlane(tid >> 6), lane = tid & 63, wr = wid >> 2, wc = wid & 3, fr = lane & 15, fq = lane >> 4;
    const int K = g.K, nt = K / BK;
    unsigned voffA[2], voffB[2];
#pragma unroll
    for (int i = 0; i < 2; ++i) { int R, C; stage_rc(tid * 16 + i * 8192, R, C); const int Rb = Epi::PERM ? ((R & ~31) + perm32(R & 31)) : R;
        voffA[i] = (unsigned)(R * K + C) * 2u; voffB[i] = (unsigned)(Rb * K + C) * 2u; }
    const size_t kstep = (size_t)(BK * 2);
    const size_t hstep = (size_t)HALF * K * 2;
    const size_t tstep = 2 * hstep;
    const unsigned ldsw = (unsigned)wid * 1024u;
    const int aoff = lds_byte(wr * 64 + fr, fq * 8), boff = lds_byte(wc * 32 + fr, fq * 8);
#define PG8_SA(b, h) (((b) * 2 + (h)) * HTB)
#define PG8_SB(b, h) ((4 + (b) * 2 + (h)) * HTB)
#define PG8_STAGE(bufoff, gbase, voff) do { _Pragma("unroll") for (int _i = 0; _i < 2; ++_i) \
        __builtin_amdgcn_global_load_lds((const unsigned*)((const char*)(gbase) + (voff)[_i]), (PG8_LAS unsigned*)(lds + (bufoff) + ldsw + _i * 8192), 16, 0, 0); } while (0)
#define PG8_LDA(dst, b, h) do { _Pragma("unroll") for (int m = 0; m < 4; ++m) _Pragma("unroll") for (int k = 0; k < 2; ++k) dst[m][k] = *(const PG8_LAS bf16x8*)(lds + PG8_SA(b, h) + aoff + m * 2048 + k * 1024); } while (0)
#define PG8_LDB(dst, b, h) do { _Pragma("unroll") for (int n = 0; n < 2; ++n) _Pragma("unroll") for (int k = 0; k < 2; ++k) dst[n][k] = *(const PG8_LAS bf16x8*)(lds + PG8_SB(b, h) + boff + n * 2048 + k * 1024); } while (0)
#define PG8_MMA(ai, bj, At, Bt) do { __builtin_amdgcn_s_setprio(1); _Pragma("unroll") for (int m = 0; m < 4; ++m) _Pragma("unroll") for (int n = 0; n < 2; ++n) _Pragma("unroll") for (int k = 0; k < 2; ++k) \
        acc[ai][bj][m][n] = __builtin_amdgcn_mfma_f32_16x16x32_bf16(Bt[n][k], At[m][k], acc[ai][bj][m][n], 0, 0, 0); __builtin_amdgcn_s_setprio(0); } while (0)
#define PG8_WAIT_V(n) asm volatile("s_waitcnt vmcnt(" #n ")" ::: "memory")
#define PG8_WAIT_L(n) asm volatile("s_waitcnt lgkmcnt(" #n ")" ::: "memory")
#define PG8_BAR __builtin_amdgcn_s_barrier()
#define PG8_SCHED __builtin_amdgcn_sched_barrier(0)
    Unit cur, nxt; int ui = 0;
    if (!S.next(0, cur)) return;
    f32x4 acc[2][2][4][2];
#pragma unroll
    for (int a = 0; a < 2; ++a)
#pragma unroll
        for (int b = 0; b < 2; ++b)
#pragma unroll
            for (int m = 0; m < 4; ++m)
#pragma unroll
                for (int n = 0; n < 2; ++n) acc[a][b][m][n] = (f32x4){0.f, 0.f, 0.f, 0.f};
    bf16x8 At[4][2], B0[2][2], B1[2][2];
    const char* cA = (const char*)g.A + (size_t)cur.pm * tstep; const char* cB = (const char*)g.Bt + (size_t)cur.pn * tstep;
    S.a_ready(cur);
    if constexpr (SP2) {
        PG8_STAGE(PG8_SB(0, 0), cB, voffB); PG8_STAGE(PG8_SB(0, 1), cB + hstep, voffB); PG8_STAGE(PG8_SA(0, 0), cA, voffA); PG8_STAGE(PG8_SA(0, 1), cA + hstep, voffA);
        if (wr == 1) PG8_BAR;
        PG8_WAIT_V(2); PG8_BAR;
        PG8_STAGE(PG8_SB(1, 0), cB + kstep, voffB); PG8_STAGE(PG8_SA(1, 0), cA + kstep, voffA); PG8_STAGE(PG8_SB(1, 1), cB + hstep + kstep, voffB);
        PG8_WAIT_V(6); PG8_BAR;
    } else {
        PG8_STAGE(PG8_SB(0, 0), cB, voffB); PG8_STAGE(PG8_SA(0, 0), cA, voffA); PG8_STAGE(PG8_SB(0, 1), cB + hstep, voffB); PG8_STAGE(PG8_SA(0, 1), cA + hstep, voffA);
        if (wr == 1) PG8_BAR;
        PG8_WAIT_V(4); PG8_BAR;
        PG8_STAGE(PG8_SB(1, 0), cB + kstep, voffB); PG8_STAGE(PG8_SA(1, 0), cA + kstep, voffA); PG8_STAGE(PG8_SB(1, 1), cB + hstep + kstep, voffB);
        PG8_WAIT_V(6); PG8_BAR;
    }
    for (;;) {
        const bool has_next = S.next(ui + 1, nxt);
        const char* nA = has_next ? (const char*)g.A + (size_t)nxt.pm * tstep : cA; const char* nB = has_next ? (const char*)g.Bt + (size_t)nxt.pn * tstep : cB;
        for (int t = 0; t < nt; t += 2) {
            const bool last = (t == nt - 2);
            const char* a1 = cA + (size_t)(t + 1) * kstep;
            const char* a2 = last ? nA : cA + (size_t)(t + 2) * kstep; const char* b2 = last ? nB : cB + (size_t)(t + 2) * kstep;
            const char* a3 = a2 + kstep; const char* b3 = b2 + kstep;
            if (last && has_next) S.a_ready(nxt);
            if constexpr (SP2) {
            PG8_LDB(B0, 0, 0); PG8_LDB(B1, 0, 1); PG8_SCHED; PG8_LDA(At, 0, 0); PG8_STAGE(PG8_SA(1, 1), a1 + hstep, voffA);
            PG8_WAIT_V(8); PG8_WAIT_L(0); PG8_BAR; PG8_MMA(0, 0, At, B0); PG8_MMA(0, 1, At, B1); PG8_BAR; PG8_SCHED;
            PG8_LDA(At, 0, 1); PG8_STAGE(PG8_SB(0, 0), b2, voffB); PG8_STAGE(PG8_SB(0, 1), b2 + hstep, voffB); PG8_STAGE(PG8_SA(0, 0), a2, voffA);
            PG8_WAIT_V(8); PG8_WAIT_L(0); PG8_BAR; PG8_MMA(1, 0, At, B0); PG8_MMA(1, 1, At, B1); PG8_BAR; PG8_SCHED;
            PG8_LDB(B0, 1, 0); PG8_LDB(B1, 1, 1); PG8_SCHED; PG8_LDA(At, 1, 0); PG8_STAGE(PG8_SA(0, 1), a2 + hstep, voffA);
            PG8_WAIT_V(8); PG8_WAIT_L(0); PG8_BAR; PG8_MMA(0, 0, At, B0); PG8_MMA(0, 1, At, B1); PG8_BAR; PG8_SCHED;
            PG8_LDA(At, 1, 1); PG8_STAGE(PG8_SB(1, 0), b3, voffB); PG8_STAGE(PG8_SB(1, 1), b3 + hstep, voffB); PG8_STAGE(PG8_SA(1, 0), a3, voffA);
            PG8_WAIT_V(8); PG8_WAIT_L(0); PG8_BAR; PG8_MMA(1, 0, At, B0); PG8_MMA(1, 1, At, B1); PG8_BAR; PG8_SCHED;
            } else {
            PG8_LDB(B0, 0, 0); PG8_SCHED; PG8_LDA(At, 0, 0); PG8_STAGE(PG8_SA(1, 1), a1 + hstep, voffA);
            PG8_WAIT_L(8); PG8_BAR; PG8_WAIT_L(0); PG8_MMA(0, 0, At, B0); PG8_BAR; PG8_SCHED;
            PG8_LDB(B1, 0, 1); PG8_STAGE(PG8_SB(0, 0), b2, voffB);
            PG8_BAR; PG8_WAIT_L(0); PG8_MMA(0, 1, At, B1); PG8_BAR;
            PG8_LDA(At, 0, 1); PG8_STAGE(PG8_SA(0, 0), a2, voffA);
            PG8_BAR; PG8_WAIT_L(0); PG8_MMA(1, 0, At, B0); PG8_BAR; PG8_SCHED;
            PG8_STAGE(PG8_SB(0, 1), b2 + hstep, voffB);
            PG8_WAIT_V(6); PG8_BAR; PG8_MMA(1, 1, At, B1); PG8_BAR;
            PG8_LDB(B0, 1, 0); PG8_SCHED; PG8_LDA(At, 1, 0); PG8_STAGE(PG8_SA(0, 1), a2 + hstep, voffA);
            PG8_WAIT_L(8); PG8_BAR; PG8_WAIT_L(0); PG8_MMA(0, 0, At, B0); PG8_BAR; PG8_SCHED;
            PG8_LDB(B1, 1, 1); PG8_STAGE(PG8_SB(1, 0), b3, voffB);
            PG8_BAR; PG8_WAIT_L(0); PG8_MMA(0, 1, At, B1); PG8_BAR;
            PG8_LDA(At, 1, 1); PG8_STAGE(PG8_SA(1, 0), a3, voffA);
            PG8_BAR; PG8_WAIT_L(0); PG8_MMA(1, 0, At, B0); PG8_BAR; PG8_SCHED;
            PG8_STAGE(PG8_SB(1, 1), b3 + hstep, voffB);
            PG8_WAIT_V(6); PG8_BAR; PG8_MMA(1, 1, At, B1); PG8_BAR;
            }
        }
        if constexpr (ALIGN_EPI) { if (wr == 0) PG8_BAR; }
        if constexpr (!Epi::AFTER_DRAIN) { E(acc, cur, wr, wc, fr, fq); S.done(cur); }
        if (!has_next) break;
#pragma unroll
        for (int a = 0; a < 2; ++a)
#pragma unroll
            for (int b = 0; b < 2; ++b)
#pragma unroll
                for (int m = 0; m < 4; ++m)
#pragma unroll
                    for (int n = 0; n < 2; ++n) acc[a][b][m][n] = (f32x4){0.f, 0.f, 0.f, 0.f};
        cur = nxt; cA = nA; cB = nB; ++ui;
        if constexpr (ALIGN_EPI) { if (wr == 1) PG8_BAR; }
    }
    PG8_WAIT_V(0);
    if constexpr (!ALIGN_EPI) { if (wr == 0) PG8_BAR; }
    PG8_BAR;
    if constexpr (Epi::AFTER_DRAIN) { E.fused(acc, cur, wr, wc, fr, fq, lds, wid, lane); S.done(cur); }
#undef PG8_SA
#undef PG8_SB
#undef PG8_STAGE
#undef PG8_LDA
#undef PG8_LDB
#undef PG8_MMA
#undef PG8_WAIT_V
#undef PG8_WAIT_L
#undef PG8_BAR
#undef PG8_SCHED
}
}
namespace attn128 {
using bf16 = __hip_bfloat16;
constexpr int   D = 128, NW = 8, QBLK = 32, KVBLK = 64;
constexpr float SCALE = 0.088388347648318440f;
constexpr float THR = 8.f;
constexpr int SDEPTH = 2;
constexpr int LDQ = NIN, LDK = D, LDO = DM;
constexpr size_t SHM_V = KVBLK * D * 2, SHM_K = KVBLK * D * 2, SHM_ATTN = 2 * SHM_V + 2 * SHM_K + NW * 64 * 4;
using bf16x8 = __attribute__((ext_vector_type(8))) short;
using s16x4  = __attribute__((ext_vector_type(4))) short;
using f32x16 = __attribute__((ext_vector_type(16))) float;
using f32x8  = __attribute__((ext_vector_type(8))) float;
using u32x4  = __attribute__((ext_vector_type(4))) unsigned;
#define KSWZ(row, colB) ((row) * 256 + ((colB) ^ (((row) & 7) << 4)))
#define SBAR() __builtin_amdgcn_sched_barrier(0)
__device__ __forceinline__ int crow(int r, int hi) { return (r & 3) + 8 * (r >> 2) + 4 * hi; }
__device__ __forceinline__ unsigned cvtpk(float lo, float hi) {
  unsigned r; asm volatile("v_cvt_pk_bf16_f32 %0, %1, %2" : "=v"(r) : "v"(lo), "v"(hi)); return r;
}
template <typename TIn> struct Stage;
template <> struct Stage<bf16>  { using T = bf16x8;
  __device__ static __forceinline__ T ld8(const bf16* p) { return *reinterpret_cast<const bf16x8*>(p); }
  __device__ static __forceinline__ bf16x8 tobf(T x) { return x; } };
template <> struct Stage<float> { using T = f32x8;
  __device__ static __forceinline__ T ld8(const float* p) { return *reinterpret_cast<const f32x8*>(p); }
  __device__ static __forceinline__ bf16x8 tobf(T x) {
    u32x4 w = {cvtpk(x[0], x[1]), cvtpk(x[2], x[3]), cvtpk(x[4], x[5]), cvtpk(x[6], x[7])}; return *reinterpret_cast<bf16x8*>(&w); } };

__device__ __forceinline__ void partialSM(f32x16& p0, f32x16& p1, float& m_reg, float& mn, float& alpha) {
  constexpr float C = SCALE * 1.4426950408889634f;
  float pmax = p0[0]; for (int r = 1; r < 16; ++r) pmax = fmaxf(pmax, p0[r]); for (int r = 0; r < 16; ++r) pmax = fmaxf(pmax, p1[r]);
  { auto rr = __builtin_amdgcn_permlane32_swap(__float_as_uint(pmax), __float_as_uint(pmax), false, false);
    pmax = fmaxf(__uint_as_float(rr[0]), __uint_as_float(rr[1])); }
  if (__builtin_expect(__all(pmax - m_reg <= THR / SCALE), 1)) { mn = m_reg; alpha = 1.f; }
  else { mn = fmaxf(m_reg, pmax); alpha = __builtin_amdgcn_exp2f((m_reg - mn) * C); m_reg = mn; }
  float mnC = -mn * C;
  for (int r = 0; r < 16; ++r) p0[r] = fmaf(p0[r], C, mnC); for (int r = 0; r < 16; ++r) p1[r] = fmaf(p1[r], C, mnC);
  for (int r = 0; r < 16; ++r) p0[r] = __builtin_amdgcn_exp2f(p0[r]);
}
__device__ __forceinline__ void finishSM(f32x16& p0, f32x16& p1, float alpha, float& l_reg, bf16x8& pa0, bf16x8& pa1, bf16x8& pa2, bf16x8& pa3) {
  for (int r = 0; r < 16; ++r) p1[r] = __builtin_amdgcn_exp2f(p1[r]);
  float ps = 0; for (int r = 0; r < 16; ++r) ps += p0[r]; for (int r = 0; r < 16; ++r) ps += p1[r];
  { auto rr = __builtin_amdgcn_permlane32_swap(__float_as_uint(ps), __float_as_uint(ps), false, false);
    ps = __uint_as_float(rr[0]) + __uint_as_float(rr[1]); }
  l_reg = l_reg * alpha + ps;
#define PK4(P, BASE, OUT) do { unsigned a0 = cvtpk(P[BASE + 0], P[BASE + 1]), a1 = cvtpk(P[BASE + 2], P[BASE + 3]);   \
    unsigned b0 = cvtpk(P[BASE + 4], P[BASE + 5]), b1 = cvtpk(P[BASE + 6], P[BASE + 7]);                              \
    auto r0 = __builtin_amdgcn_permlane32_swap(a0, b0, false, false); auto r1 = __builtin_amdgcn_permlane32_swap(a1, b1, false, false); \
    u32x4 w = {r0[0], r1[0], r0[1], r1[1]}; OUT = *reinterpret_cast<bf16x8*>(&w); } while (0)
  PK4(p0, 0, pa0); PK4(p0, 8, pa1); PK4(p1, 0, pa2); PK4(p1, 8, pa3);
#undef PK4
}
__device__ __forceinline__ void qkt(f32x16& p0, f32x16& p1, const bf16* Ks, const bf16x8* qr, int r32, int hi) {
  p0 = f32x16{}; p1 = f32x16{};
  for (int d0 = 0; d0 < 8; ++d0) { int cb = (d0 * 16 + hi * 8) * 2;
    bf16x8 b0 = *reinterpret_cast<const bf16x8*>((const char*)Ks + KSWZ(r32, cb));
    bf16x8 b1 = *reinterpret_cast<const bf16x8*>((const char*)Ks + KSWZ(32 + r32, cb));
    p0 = __builtin_amdgcn_mfma_f32_32x32x16_bf16(b0, qr[d0], p0, 0, 0, 0);
    p1 = __builtin_amdgcn_mfma_f32_32x32x16_bf16(b1, qr[d0], p1, 0, 0, 0); }
}
__device__ __forceinline__ int v_st(int k, int c) { const int kk = (k & ~0xC) | ((k & 4) << 1) | ((k & 8) >> 1); return ((kk >> 3) * 4 + (c >> 5)) * 512 + ((kk & 7) * 32 + (c & 31)) * 2; }
__device__ __forceinline__ int v_rd_base(int lane) { return ((lane & 3) << 3) | (((lane >> 2) & 3) << 6) | (((lane >> 4) & 1) << 5) | (((lane >> 5) & 1) << 8); }
constexpr int v_rd_off(int d0, int ks, int half) { return d0 * 512 + ks * 4096 + half * 2048; }
template <int OFF> __device__ __forceinline__ s16x4 tr_read(int vb) {
  s16x4 r; asm volatile("ds_read_b64_tr_b16 %0, %1 offset:%2" : "=&v"(r) : "v"(vb), "i"(OFF) : "memory"); return r;
}
template <int D0> __device__ __forceinline__ void pv_one(f32x16& od, int vb, bf16x8 pa0, bf16x8 pa1, bf16x8 pa2, bf16x8 pa3) {
  const s16x4 l0 = tr_read<v_rd_off(D0, 0, 0)>(vb), h0 = tr_read<v_rd_off(D0, 0, 1)>(vb), l1 = tr_read<v_rd_off(D0, 1, 0)>(vb), h1 = tr_read<v_rd_off(D0, 1, 1)>(vb);
  const s16x4 l2 = tr_read<v_rd_off(D0, 2, 0)>(vb), h2 = tr_read<v_rd_off(D0, 2, 1)>(vb), l3 = tr_read<v_rd_off(D0, 3, 0)>(vb), h3 = tr_read<v_rd_off(D0, 3, 1)>(vb);
  asm volatile("s_waitcnt lgkmcnt(0)" ::: "memory"); SBAR();
#define PK(L, H) (bf16x8){L[0], L[1], L[2], L[3], H[0], H[1], H[2], H[3]}
  od = __builtin_amdgcn_mfma_f32_32x32x16_bf16(pa0, PK(l0, h0), od, 0, 0, 0);
  od = __builtin_amdgcn_mfma_f32_32x32x16_bf16(pa1, PK(l1, h1), od, 0, 0, 0);
  od = __builtin_amdgcn_mfma_f32_32x32x16_bf16(pa2, PK(l2, h2), od, 0, 0, 0);
  od = __builtin_amdgcn_mfma_f32_32x32x16_bf16(pa3, PK(l3, h3), od, 0, 0, 0);
#undef PK
}
__device__ __forceinline__ void pv_d0(f32x16* o, int vb, bf16x8 pa0, bf16x8 pa1, bf16x8 pa2, bf16x8 pa3) {
  pv_one<0>(o[0], vb, pa0, pa1, pa2, pa3); pv_one<1>(o[1], vb, pa0, pa1, pa2, pa3); pv_one<2>(o[2], vb, pa0, pa1, pa2, pa3); pv_one<3>(o[3], vb, pa0, pa1, pa2, pa3);
}

template <typename TQ>
__device__ __forceinline__ void attn_dense_body(const TQ* __restrict__ Qb, const bf16* __restrict__ Kh, const bf16* __restrict__ Vh,
                                                bf16* __restrict__ Ob, int seq, char* lds) {
  using St = Stage<bf16>; using SQ = Stage<TQ>;
  const int tid = threadIdx.x, wid = tid >> 6, lane = tid & 63, r32 = lane & 31, hi = lane >> 5;
  bf16* V_lds = (bf16*)lds; bf16* K_lds = (bf16*)(lds + 2 * SHM_V);
  float* ws = (float*)(lds + 2 * SHM_V + 2 * SHM_K) + wid * 64; float* li_l = ws; float* al_l = ws + 32;
  float m_reg = -1e30f, l_reg = 0; f32x16 o[4] = {}; bf16x8 qr[8];
  const TQ* Qw = Qb + (long)(wid * QBLK + r32) * LDQ + hi * 8;
#pragma unroll
  for (int d0 = 0; d0 < 8; ++d0) qr[d0] = SQ::tobf(SQ::ld8(Qw + d0 * 16));
  const int sr = tid >> 4, sc = (tid & 15) * 8, vst0 = v_st(sr, sc), vst1 = v_st(32 + sr, sc);
  const int vb0 = (int)(uintptr_t)V_lds + v_rd_base(lane);
  struct { typename St::T vs0, vs1, ks0, ks1; } sr_[SDEPTH];
#define SLOAD(i, k0) do { sr_[i].vs0 = St::ld8(&Vh[(long)((k0) + sr) * LDK + sc]); sr_[i].vs1 = St::ld8(&Vh[(long)((k0) + 32 + sr) * LDK + sc]); \
    sr_[i].ks0 = St::ld8(&Kh[(long)((k0) + sr) * LDK + sc]); sr_[i].ks1 = St::ld8(&Kh[(long)((k0) + 32 + sr) * LDK + sc]); } while (0)
#define SWRITE(b, i) do { *(bf16x8*)((char*)V_lds + (b) * SHM_V + vst0) = St::tobf(sr_[i].vs0);          \
    *(bf16x8*)((char*)V_lds + (b) * SHM_V + vst1) = St::tobf(sr_[i].vs1); int kc = sc * 2;               \
    *(bf16x8*)((char*)K_lds + (b) * SHM_K + KSWZ(sr, kc)) = St::tobf(sr_[i].ks0);                       \
    *(bf16x8*)((char*)K_lds + (b) * SHM_K + KSWZ(32 + sr, kc)) = St::tobf(sr_[i].ks1); } while (0)
#define SWAIT() do { if constexpr (SDEPTH == 2) asm volatile("s_waitcnt vmcnt(4)" ::: "memory"); else asm volatile("s_waitcnt vmcnt(0)" ::: "memory"); } while (0)
#define RESC(a) do { if (__any((a) < 1.f)) { if (hi == 0) al_l[r32] = (a); asm volatile("s_waitcnt lgkmcnt(0)" ::: "memory"); \
    for (int d = 0; d < 4; ++d) for (int r = 0; r < 16; ++r) o[d][r] *= al_l[crow(r, hi)]; } } while (0)
  f32x16 pA0, pA1, pB0, pB1; float mnA, mnB, alA, alB; bf16x8 pa0, pa1, pa2, pa3; const int NT = seq / KVBLK;
  constexpr int SE = 0, SO = SDEPTH - 1;
  SLOAD(SE, 0); asm volatile("s_waitcnt vmcnt(0)" ::: "memory"); SWRITE(0, SE); __syncthreads();
  qkt(pA0, pA1, K_lds, qr, r32, hi); partialSM(pA0, pA1, m_reg, mnA, alA);
  SLOAD(SO, KVBLK); if constexpr (SDEPTH == 2) { if (2 < NT) SLOAD(SE, 2 * KVBLK); }
  SWAIT(); SWRITE(1, SO); __syncthreads();
  for (int j = 1; j + 1 < NT; j += 2) {
    SBAR(); qkt(pB0, pB1, (bf16*)((char*)K_lds + SHM_K), qr, r32, hi);
    finishSM(pA0, pA1, alA, l_reg, pa0, pa1, pa2, pa3); SBAR();
    SLOAD(SO, (j + SDEPTH) * KVBLK); SBAR();
    pv_d0(o, vb0, pa0, pa1, pa2, pa3); partialSM(pB0, pB1, m_reg, mnB, alB);
    __syncthreads(); SWAIT(); SWRITE(0, SE);
    RESC(alB); __syncthreads();
    SBAR(); qkt(pA0, pA1, K_lds, qr, r32, hi);
    finishSM(pB0, pB1, alB, l_reg, pa0, pa1, pa2, pa3); SBAR();
    if (SDEPTH == 1 || j + 3 < NT) SLOAD(SE, (j + 1 + SDEPTH) * KVBLK); SBAR();
    pv_d0(o, vb0 + (int)SHM_V, pa0, pa1, pa2, pa3); partialSM(pA0, pA1, m_reg, mnA, alA);
    __syncthreads(); SWAIT(); SWRITE(1, SO);
    RESC(alA); __syncthreads();
  }
  SBAR(); qkt(pB0, pB1, (bf16*)((char*)K_lds + SHM_K), qr, r32, hi);
  finishSM(pA0, pA1, alA, l_reg, pa0, pa1, pa2, pa3); SBAR();
  pv_d0(o, vb0, pa0, pa1, pa2, pa3); partialSM(pB0, pB1, m_reg, mnB, alB);
  __syncthreads(); RESC(alB);
  finishSM(pB0, pB1, alB, l_reg, pa0, pa1, pa2, pa3); SBAR();
  pv_d0(o, vb0 + (int)SHM_V, pa0, pa1, pa2, pa3);
  if (hi == 0) li_l[r32] = l_reg; asm volatile("s_waitcnt lgkmcnt(0)" ::: "memory");
  float rli[16];
#pragma unroll
  for (int r = 0; r < 16; ++r) rli[r] = __builtin_amdgcn_rcpf(li_l[crow(r, hi)]);
  bf16* Ow = Ob + (long)(wid * QBLK) * LDO;
#pragma unroll
  for (int r = 0; r < 16; ++r) { int orow = crow(r, hi);
    for (int d0 = 0; d0 < 4; ++d0) Ow[(long)orow * LDO + d0 * 32 + r32] = __float2bfloat16(o[d0][r] * rli[r]); }
#undef SLOAD
#undef SWRITE
#undef SWAIT
#undef RESC
}

constexpr size_t SHM_ATTN_DMA = 3 * SHM_V + 3 * SHM_K + NW * 64 * 4;
typedef __attribute__((address_space(3))) unsigned char* lds_ptr;
__device__ __forceinline__ void attn_dma_body(const bf16* __restrict__ Qb, const bf16* __restrict__ Kh, const bf16* __restrict__ Vh, bf16* __restrict__ Ob, int seq, lds_ptr lds3) {
  char* lds = (char*)lds3;
  int tid = threadIdx.x; asm volatile("" : "+v"(tid));
  const int wid = __builtin_amdgcn_readfirstlane(tid >> 6), lane = tid & 63, r32 = lane & 31, hi = lane >> 5;
  char* K_lds = lds; char* V_lds = lds + 3 * SHM_K;
  float* ws = (float*)(lds + 3 * SHM_K + 3 * SHM_V) + wid * 64; float* li_l = ws; float* al_l = ws + 32;
  float m_reg = -1e30f, l_reg = 0; bf16x8 qr[8];
  int koff[2], voff[2];
#pragma unroll
  for (int i = 0; i < 2; ++i) { const int w = 2 * wid + i;
    { const int row = 4 * w + (lane >> 4), ch = (lane & 15) ^ (row & 7); koff[i] = row * LDK + ch * 8; }
    { const int s = 2 * w + (lane >> 5), kk = (s >> 2) * 8 + ((lane & 31) >> 2), k = (kk & ~0xC) | ((kk & 4) << 1) | ((kk & 8) >> 1), c = (s & 3) * 32 + 8 * (lane & 3); voff[i] = k * LDK + c; } }
#define DMA_K(t, slot) do { _Pragma("unroll") for (int i_ = 0; i_ < 2; ++i_) __builtin_amdgcn_global_load_lds((const __attribute__((address_space(1))) unsigned*)(Kh + (long)(t) * (KVBLK * LDK) + koff[i_]), \
      (__attribute__((address_space(3))) unsigned*)(lds3 + (slot) * (int)SHM_K + (2 * wid + i_) * 1024), 16, 0, 0); } while (0)
#define DMA_V(t, slot) do { _Pragma("unroll") for (int i_ = 0; i_ < 2; ++i_) __builtin_amdgcn_global_load_lds((const __attribute__((address_space(1))) unsigned*)(Vh + (long)(t) * (KVBLK * LDK) + voff[i_]), \
      (__attribute__((address_space(3))) unsigned*)(lds3 + 3 * (int)SHM_K + (slot) * (int)SHM_V + (2 * wid + i_) * 1024), 16, 0, 0); } while (0)
  const int NT = seq / KVBLK;
  DMA_K(0, 0); DMA_V(0, 0); DMA_K(1, 1);
  const bf16* Qw = Qb + (long)(wid * QBLK + r32) * LDQ + hi * 8;
#pragma unroll
  for (int d0 = 0; d0 < 8; ++d0) qr[d0] = *reinterpret_cast<const bf16x8*>(Qw + d0 * 16);
  const int vb0 = (int)(uintptr_t)V_lds + v_rd_base(lane);
#define RESC(a) do { if (__any((a) < 1.f)) { if (hi == 0) al_l[r32] = (a); asm volatile("s_waitcnt lgkmcnt(0)" ::: "memory"); \
    for (int d = 0; d < 4; ++d) for (int r = 0; r < 16; ++r) o[d][r] *= al_l[crow(r, hi)]; } } while (0)
  f32x16 pA0, pA1, pB0, pB1; float mnA, mnB, alA, alB; bf16x8 pa0, pa1, pa2, pa3;
  asm volatile("s_waitcnt vmcnt(0)" ::: "memory"); __builtin_amdgcn_s_barrier(); asm volatile("" ::: "memory");
  DMA_K(2, 2); DMA_V(1, 1);
  SBAR(); qkt(pA0, pA1, (const bf16*)K_lds, qr, r32, hi); SBAR(); partialSM(pA0, pA1, m_reg, mnA, alA); SBAR();
  f32x16 o[4] = {};
  int sk = 1, sv = 0;
#define STEP(PC0, PC1, MNC, ALC, PP0, PP1, ALP, t) do { \
    asm volatile("s_waitcnt vmcnt(4) lgkmcnt(0)" ::: "memory"); __builtin_amdgcn_s_barrier(); asm volatile("" ::: "memory"); \
    { const int tk_ = ((t) + 2 < NT) ? (t) + 2 : NT - 1, tv_ = ((t) + 1 < NT) ? (t) + 1 : NT - 1; const int sk2_ = (sk == 0) ? 2 : sk - 1, sv2_ = (sv == 0) ? 2 : sv - 1; \
      DMA_K(tk_, sk2_); DMA_V(tv_, sv2_); }     \
    int kb_ = sk * (int)SHM_K; asm volatile("" : "+v"(kb_));     \
    SBAR(); qkt(PC0, PC1, (const bf16*)(K_lds + kb_), qr, r32, hi); \
    finishSM(PP0, PP1, ALP, l_reg, pa0, pa1, pa2, pa3); if (ATTN_PIN) SBAR(); \
    pv_d0(o, vb0 + sv * (int)SHM_V, pa0, pa1, pa2, pa3); partialSM(PC0, PC1, m_reg, MNC, ALC); \
    RESC(ALC); sk = (sk == 2) ? 0 : sk + 1; sv = (sv == 2) ? 0 : sv + 1; } while (0)
  int t = 1;
  for (; t + 1 < NT; t += 2) {
    STEP(pB0, pB1, mnB, alB, pA0, pA1, alA, t);
    STEP(pA0, pA1, mnA, alA, pB0, pB1, alB, t + 1);
  }
  STEP(pB0, pB1, mnB, alB, pA0, pA1, alA, t);
  finishSM(pB0, pB1, alB, l_reg, pa0, pa1, pa2, pa3);
  asm volatile("s_waitcnt vmcnt(0) lgkmcnt(0)" ::: "memory"); __builtin_amdgcn_s_barrier(); asm volatile("" ::: "memory");
  SBAR(); pv_d0(o, vb0 + sv * (int)SHM_V, pa0, pa1, pa2, pa3);
  if (hi == 0) li_l[r32] = l_reg; asm volatile("s_waitcnt lgkmcnt(0)" ::: "memory");
  float rli[16];
#pragma unroll
  for (int r = 0; r < 16; ++r) rli[r] = __builtin_amdgcn_rcpf(li_l[crow(r, hi)]);
  bf16* Ow = Ob + (long)(wid * QBLK) * LDO;
#pragma unroll
  for (int r = 0; r < 16; ++r) { int orow = crow(r, hi);
    for (int d0 = 0; d0 < 4; ++d0) Ow[(long)orow * LDO + d0 * 32 + r32] = __float2bfloat16(o[d0][r] * rli[r]); }
#undef DMA_K
#undef DMA_V
#undef RESC
#undef STEP
}

__device__ __forceinline__ void softmax_tile(f32x16& p0, f32x16& p1, float& m_reg, float& l_reg, float& alpha, bf16x8& pa0, bf16x8& pa1, bf16x8& pa2, bf16x8& pa3) {
  constexpr float C = SCALE * 1.4426950408889634f;
  float pmax = p0[0]; for (int r = 1; r < 16; ++r) pmax = fmaxf(pmax, p0[r]); for (int r = 0; r < 16; ++r) pmax = fmaxf(pmax, p1[r]);
  { auto rr = __builtin_amdgcn_permlane32_swap(__float_as_uint(pmax), __float_as_uint(pmax), false, false);
    pmax = fmaxf(__uint_as_float(rr[0]), __uint_as_float(rr[1])); }
  float mn;
  if (__builtin_expect(__all(pmax - m_reg <= THR / SCALE), 1)) { mn = m_reg; alpha = 1.f; }
  else { mn = fmaxf(m_reg, pmax); alpha = __builtin_amdgcn_exp2f((m_reg - mn) * C); m_reg = mn; }
  const float mnC = -mn * C;
  for (int r = 0; r < 16; ++r) p0[r] = __builtin_amdgcn_exp2f(fmaf(p0[r], C, mnC));
  for (int r = 0; r < 16; ++r) p1[r] = __builtin_amdgcn_exp2f(fmaf(p1[r], C, mnC));
  float ps = 0; for (int r = 0; r < 16; ++r) ps += p0[r]; for (int r = 0; r < 16; ++r) ps += p1[r];
  { auto rr = __builtin_amdgcn_permlane32_swap(__float_as_uint(ps), __float_as_uint(ps), false, false);
    ps = __uint_as_float(rr[0]) + __uint_as_float(rr[1]); }
  l_reg = l_reg * alpha + ps;
#define PK4(P, BASE, OUT) do { unsigned a0 = cvtpk(P[BASE + 0], P[BASE + 1]), a1 = cvtpk(P[BASE + 2], P[BASE + 3]);   \
    unsigned b0 = cvtpk(P[BASE + 4], P[BASE + 5]), b1 = cvtpk(P[BASE + 6], P[BASE + 7]);                              \
    auto r0 = __builtin_amdgcn_permlane32_swap(a0, b0, false, false); auto r1 = __builtin_amdgcn_permlane32_swap(a1, b1, false, false); \
    u32x4 w = {r0[0], r1[0], r0[1], r1[1]}; OUT = *reinterpret_cast<bf16x8*>(&w); } while (0)
  PK4(p0, 0, pa0); PK4(p0, 8, pa1); PK4(p1, 0, pa2); PK4(p1, 8, pa3);
#undef PK4
}
__device__ __forceinline__ void softmax_tile_neg(f32x16& p0, f32x16& p1, float& mhat, float& l_reg, float& alpha, f32x16& negm, bool first, bf16x8& pa0, bf16x8& pa1, bf16x8& pa2, bf16x8& pa3) {
  constexpr float THR2 = THR * 1.4426950408889634f;
  float pmax = p0[0]; for (int r = 1; r < 16; ++r) pmax = fmaxf(pmax, p0[r]); for (int r = 0; r < 16; ++r) pmax = fmaxf(pmax, p1[r]);
  { auto rr = __builtin_amdgcn_permlane32_swap(__float_as_uint(pmax), __float_as_uint(pmax), false, false);
    pmax = fmaxf(__uint_as_float(rr[0]), __uint_as_float(rr[1])); }
  alpha = 1.f;
  if (__builtin_expect(first || !__all(pmax <= THR2), 0)) {
    const float dl = first ? pmax : fmaxf(pmax, 0.f);
    mhat += dl;
    for (int r = 0; r < 16; ++r) { p0[r] -= dl; p1[r] -= dl; }
    if (!first) alpha = __builtin_amdgcn_exp2f(-dl);
    for (int r = 0; r < 16; ++r) negm[r] = -mhat;
    asm volatile("" : "+v"(negm));
  }
  for (int r = 0; r < 16; ++r) p0[r] = __builtin_amdgcn_exp2f(p0[r]);
  for (int r = 0; r < 16; ++r) p1[r] = __builtin_amdgcn_exp2f(p1[r]);
  float ps = 0; for (int r = 0; r < 16; ++r) ps += p0[r]; for (int r = 0; r < 16; ++r) ps += p1[r];
  { auto rr = __builtin_amdgcn_permlane32_swap(__float_as_uint(ps), __float_as_uint(ps), false, false);
    ps = __uint_as_float(rr[0]) + __uint_as_float(rr[1]); }
  l_reg = l_reg * alpha + ps;
#define PK4(P, BASE, OUT) do { unsigned a0 = cvtpk(P[BASE + 0], P[BASE + 1]), a1 = cvtpk(P[BASE + 2], P[BASE + 3]);   \
    unsigned b0 = cvtpk(P[BASE + 4], P[BASE + 5]), b1 = cvtpk(P[BASE + 6], P[BASE + 7]);                              \
    auto r0 = __builtin_amdgcn_permlane32_swap(a0, b0, false, false); auto r1 = __builtin_amdgcn_permlane32_swap(a1, b1, false, false); \
    u32x4 w = {r0[0], r1[0], r0[1], r1[1]}; OUT = *reinterpret_cast<bf16x8*>(&w); } while (0)
  PK4(p0, 0, pa0); PK4(p0, 8, pa1); PK4(p1, 0, pa2); PK4(p1, 8, pa3);
#undef PK4
}
template <int OFF> __device__ __forceinline__ bf16x8 lds_rd128(int addr) { bf16x8 r; asm volatile("ds_read_b128 %0, %1 offset:%2" : "=&v"(r) : "v"(addr), "i"(OFF) : "memory"); return r; }
#define LGKM_WAIT(n) do { asm volatile("s_waitcnt lgkmcnt(" #n ")" ::: "memory"); SBAR(); } while (0)
#define MF(a, b, c) __builtin_amdgcn_mfma_f32_32x32x16_bf16(a, b, c, 0, 0, 0)
#define PKV(L, H) (bf16x8){L[0], L[1], L[2], L[3], H[0], H[1], H[2], H[3]}
template <int D0> struct VRd { s16x4 l0, h0, l1, h1, l2, h2, l3, h3;
  __device__ __forceinline__ void issue(int vb) { l0 = tr_read<v_rd_off(D0, 0, 0)>(vb); h0 = tr_read<v_rd_off(D0, 0, 1)>(vb); l1 = tr_read<v_rd_off(D0, 1, 0)>(vb); h1 = tr_read<v_rd_off(D0, 1, 1)>(vb);
                                                l2 = tr_read<v_rd_off(D0, 2, 0)>(vb); h2 = tr_read<v_rd_off(D0, 2, 1)>(vb); l3 = tr_read<v_rd_off(D0, 3, 0)>(vb); h3 = tr_read<v_rd_off(D0, 3, 1)>(vb); }
  __device__ __forceinline__ void mma(f32x16& od, bf16x8 pa0, bf16x8 pa1, bf16x8 pa2, bf16x8 pa3) const { od = MF(pa0, PKV(l0, h0), od); od = MF(pa1, PKV(l1, h1), od); od = MF(pa2, PKV(l2, h2), od); od = MF(pa3, PKV(l3, h3), od); } };
template <bool WITH_QK, bool WITH_PV>
__device__ __forceinline__ void mblock(f32x16& p0, f32x16& p1, f32x16 (&o)[4], const int (&kas)[4], int vb, const bf16x8 (&qr)[8], bf16x8 pa0, bf16x8 pa1, bf16x8 pa2, bf16x8 pa3, const f32x16& cinit) {
  bf16x8 ka[8], kb[8];
  VRd<0> v0; VRd<1> v1; VRd<2> v2; VRd<3> v3;
  SBAR();
  if (PP_PRIO == 2) __builtin_amdgcn_s_setprio(1);
  if constexpr (WITH_QK) {
#pragma unroll
    for (int j = 0; j < 4; ++j) { ka[2 * j] = lds_rd128<0>(kas[j]); ka[2 * j + 1] = lds_rd128<8192>(kas[j]); }
#pragma unroll
    for (int j = 0; j < 4; ++j) { const int kh_ = kas[j] ^ 128; kb[2 * j] = lds_rd128<0>(kh_); kb[2 * j + 1] = lds_rd128<8192>(kh_); }
    LGKM_WAIT(12);
    p0 = MF(ka[0], qr[0], cinit); p1 = MF(ka[1], qr[0], cinit); p0 = MF(ka[2], qr[1], p0); p1 = MF(ka[3], qr[1], p1); SBAR();
    LGKM_WAIT(8);
    p0 = MF(ka[4], qr[2], p0); p1 = MF(ka[5], qr[2], p1); p0 = MF(ka[6], qr[3], p0); p1 = MF(ka[7], qr[3], p1); SBAR();
    if constexpr (WITH_PV) { if (PROBE_SENS == 2) { f32x16 d0_ = MF(ka[0], qr[0], cinit), d1_ = MF(ka[1], qr[0], cinit); d0_ = MF(ka[2], qr[1], d0_); d1_ = MF(ka[3], qr[1], d1_); d0_ = MF(ka[4], qr[2], d0_); d1_ = MF(ka[5], qr[2], d1_); d0_ = MF(ka[6], qr[3], d0_); d1_ = MF(ka[7], qr[3], d1_); asm volatile("" :: "v"(d0_), "v"(d1_)); SBAR(); } }
    if constexpr (WITH_PV) { v0.issue(vb); if (PP_V2AHEAD) { v1.issue(vb); LGKM_WAIT(15); } else LGKM_WAIT(8); } else { LGKM_WAIT(0); }
#pragma unroll
    for (int j = 0; j < 4; ++j) { p0 = MF(kb[2 * j], qr[4 + j], p0); p1 = MF(kb[2 * j + 1], qr[4 + j], p1); }
    SBAR();
    if constexpr (WITH_PV) {
      if (!PP_V2AHEAD) v1.issue(vb);
      v2.issue(vb); LGKM_WAIT(15); v0.mma(o[0], pa0, pa1, pa2, pa3); SBAR();
      v3.issue(vb); LGKM_WAIT(15); v1.mma(o[1], pa0, pa1, pa2, pa3); SBAR();
      LGKM_WAIT(8); v2.mma(o[2], pa0, pa1, pa2, pa3); SBAR();
      LGKM_WAIT(0); v3.mma(o[3], pa0, pa1, pa2, pa3); SBAR();
    }
    if (PP_PRIO == 2) __builtin_amdgcn_s_setprio(0);
  } else if constexpr (WITH_PV) {
    v0.issue(vb); v1.issue(vb); LGKM_WAIT(8); v0.mma(o[0], pa0, pa1, pa2, pa3); SBAR();
    v2.issue(vb); LGKM_WAIT(8); v1.mma(o[1], pa0, pa1, pa2, pa3); SBAR();
    v3.issue(vb); LGKM_WAIT(8); v2.mma(o[2], pa0, pa1, pa2, pa3); SBAR();
    LGKM_WAIT(0); v3.mma(o[3], pa0, pa1, pa2, pa3); SBAR();
  }
}
#undef MF
#undef PKV
__device__ __forceinline__ void attn_pp_body(const bf16* __restrict__ Qb, const bf16* __restrict__ Kh, const bf16* __restrict__ Vh, bf16* __restrict__ Ob, int seq, lds_ptr lds3) {
  char* lds = (char*)lds3;
  int tid = threadIdx.x; asm volatile("" : "+v"(tid));
  const int wid = __builtin_amdgcn_readfirstlane(tid >> 6), lane = tid & 63, r32 = lane & 31, hi = lane >> 5;
  const bool trailing = wid >= 4;
  char* V_lds = lds + 3 * SHM_K;
  float* ws = (float*)(lds + 3 * SHM_K + 3 * SHM_V) + wid * 64; float* li_l = ws; float* al_l = ws + 32;
  float m_reg = -1e30f, l_reg = 0; bf16x8 qr[8];
  int koff[2], voff[2];
#pragma unroll
  for (int i = 0; i < 2; ++i) { const int w = 2 * wid + i;
    { const int row = 4 * w + (lane >> 4), ch = (lane & 15) ^ (row & KSW); koff[i] = row * LDK + ch * 8; }
    { const int s = 2 * w + (lane >> 5), kk = (s >> 2) * 8 + ((lane & 31) >> 2), k = (kk & ~0xC) | ((kk & 4) << 1) | ((kk & 8) >> 1), c = (s & 3) * 32 + 8 * (lane & 3); voff[i] = k * LDK + c; } }
#define DMA_K(t, slot) do { _Pragma("unroll") for (int i_ = 0; i_ < 2; ++i_) __builtin_amdgcn_global_load_lds((const __attribute__((address_space(1))) unsigned*)(Kh + (long)(t) * (KVBLK * LDK) + koff[i_]), \
      (__attribute__((address_space(3))) unsigned*)(lds3 + (slot) * (int)SHM_K + (2 * wid + i_) * 1024), 16, 0, 0); } while (0)
#define DMA_V(t, slot) do { _Pragma("unroll") for (int i_ = 0; i_ < 2; ++i_) __builtin_amdgcn_global_load_lds((const __attribute__((address_space(1))) unsigned*)(Vh + (long)(t) * (KVBLK * LDK) + voff[i_]), \
      (__attribute__((address_space(3))) unsigned*)(lds3 + 3 * (int)SHM_K + (slot) * (int)SHM_V + (2 * wid + i_) * 1024), 16, 0, 0); } while (0)
#define STEP_END_L() do { asm volatile("s_waitcnt vmcnt(4) lgkmcnt(0)" ::: "memory"); SBAR(); __builtin_amdgcn_s_barrier(); asm volatile("" ::: "memory"); SBAR(); } while (0)
#define STEP_END_T() do { asm volatile("s_waitcnt vmcnt(0) lgkmcnt(0)" ::: "memory"); SBAR(); __builtin_amdgcn_s_barrier(); asm volatile("" ::: "memory"); SBAR(); } while (0)
#define BLOCK_END_M_() do { if (PP_LATEWAIT && !trailing) asm volatile("s_waitcnt lgkmcnt(0)" ::: "memory"); else asm volatile("s_waitcnt vmcnt(0) lgkmcnt(0)" ::: "memory"); SBAR(); __builtin_amdgcn_s_barrier(); asm volatile("" ::: "memory"); SBAR(); } while (0)
#define BLOCK_END_V_() do { if (PP_LATEWAIT && !trailing) asm volatile("s_waitcnt vmcnt(4) lgkmcnt(0)" ::: "memory"); else asm volatile("s_waitcnt lgkmcnt(0)" ::: "memory");     SBAR(); __builtin_amdgcn_s_barrier(); asm volatile("" ::: "memory"); SBAR(); } while (0)
#define BLOCK_END_M() do { if (PP_ONEBAR) { if (trailing) STEP_END_T(); else SBAR(); } else BLOCK_END_M_(); } while (0)
#define BLOCK_END_V() do { if (PP_ONEBAR) { if (!trailing) STEP_END_L(); else SBAR(); } else BLOCK_END_V_(); } while (0)
#define RESC(a) do { if (__any((a) < 1.f)) { if (hi == 0) al_l[r32] = (a); asm volatile("s_waitcnt lgkmcnt(0)" ::: "memory"); \
    for (int d = 0; d < 4; ++d) for (int r = 0; r < 16; ++r) o[d][r] *= al_l[crow(r, hi)]; } } while (0)
  const int NT = seq / KVBLK;
  DMA_K(0, 0); DMA_V(0, 0); DMA_K(1, 1);
  const bf16* Qw = Qb + (long)(wid * QBLK + r32) * LDQ + hi * 8;
#pragma unroll
  for (int d0 = 0; d0 < 8; ++d0) qr[d0] = *reinterpret_cast<const bf16x8*>(Qw + d0 * 16);
  const int lds0 = (int)(uintptr_t)lds;
  const int vb0 = (int)(uintptr_t)V_lds + v_rd_base(lane);
  int kad[4];
#pragma unroll
  for (int j = 0; j < 4; ++j) kad[j] = lds0 + r32 * 256 + ((32 * j + 16 * hi) ^ ((r32 & KSW) << 4));
  f32x16 p0, p1; float alpha = 1.f; bf16x8 pa0, pa1, pa2, pa3;
  if (PP_NEGM) m_reg = 0.f;
  asm volatile("s_waitcnt vmcnt(0)" ::: "memory"); __builtin_amdgcn_s_barrier(); asm volatile("" ::: "memory");
  if (!PP_ONEBAR && trailing) { __builtin_amdgcn_s_barrier(); asm volatile("" ::: "memory"); if (PP_PRIO == 1) __builtin_amdgcn_s_setprio(1); }
  f32x16 o[4] = {};
  f32x16 negm; { float z_ = 0.f; asm volatile("" : "+v"(z_)); for (int r = 0; r < 16; ++r) negm[r] = z_; asm volatile("" : "+v"(negm)); }
  { int kas[4];
#pragma unroll
    for (int j = 0; j < 4; ++j) kas[j] = kad[j];
    mblock<true, false>(p0, p1, o, kas, vb0, qr, pa0, pa0, pa0, pa0, negm); }
  BLOCK_END_M();
  DMA_K(2, 2); DMA_V(1, 1);
  if (PP_NEGM) softmax_tile_neg(p0, p1, m_reg, l_reg, alpha, negm, true, pa0, pa1, pa2, pa3); else softmax_tile(p0, p1, m_reg, l_reg, alpha, pa0, pa1, pa2, pa3);
  BLOCK_END_V();
  int sk = 1, sv = 0;
#if PP_ALIGN == 1
  asm volatile(".p2align 8");
#elif PP_ALIGN == 2
  asm volatile(".p2align 8\n\ts_nop 0");
#elif PP_ALIGN == 3
  asm volatile("s_nop 0");
#endif
  for (int t = 1; t < NT; ++t) {
    { int kas[4]; const int kbs = sk * (int)SHM_K;
#pragma unroll
      for (int j = 0; j < 4; ++j) kas[j] = kad[j] + kbs;
      f32x16 q0, q1;
      mblock<true, true>(q0, q1, o, kas, vb0 + sv * (int)SHM_V, qr, pa0, pa1, pa2, pa3, negm);
      BLOCK_END_M();
#if PP_DMALATE
      if (PROBE_SENS == 3) { _Pragma("unroll") for (int i_ = 0; i_ < 4; ++i_) __builtin_amdgcn_global_load_lds((const __attribute__((address_space(1))) unsigned*)(Kh + koff[i_ & 1]), (__attribute__((address_space(3))) unsigned*)(lds3 + 102400 + (4 * wid + i_) * 1024), 16, 0, 0); }
      if (PROBE_SENS == 1) { for (int r = 0; r < 16; ++r) { float t0_ = __builtin_amdgcn_exp2f(q0[r]), t1_ = __builtin_amdgcn_exp2f(q1[r]); asm volatile("" :: "v"(t0_), "v"(t1_)); } }
      if (PP_NEGM) softmax_tile_neg(q0, q1, m_reg, l_reg, alpha, negm, false, pa0, pa1, pa2, pa3); else softmax_tile(q0, q1, m_reg, l_reg, alpha, pa0, pa1, pa2, pa3);
      RESC(alpha);
      SBAR();
      { const int tk_ = (t + 2 < NT) ? t + 2 : NT - 1, tv_ = (t + 1 < NT) ? t + 1 : NT - 1; const int sk2_ = (sk == 0) ? 2 : sk - 1, sv2_ = (sv == 0) ? 2 : sv - 1; DMA_K(tk_, sk2_); DMA_V(tv_, sv2_); }
#else
      { const int tk_ = (t + 2 < NT) ? t + 2 : NT - 1, tv_ = (t + 1 < NT) ? t + 1 : NT - 1; const int sk2_ = (sk == 0) ? 2 : sk - 1, sv2_ = (sv == 0) ? 2 : sv - 1; DMA_K(tk_, sk2_); DMA_V(tv_, sv2_); }
      if (PROBE_SENS == 1) { for (int r = 0; r < 16; ++r) { float t0_ = __builtin_amdgcn_exp2f(q0[r]), t1_ = __builtin_amdgcn_exp2f(q1[r]); asm volatile("" :: "v"(t0_), "v"(t1_)); } }
      if (PP_NEGM) softmax_tile_neg(q0, q1, m_reg, l_reg, alpha, negm, false, pa0, pa1, pa2, pa3); else softmax_tile(q0, q1, m_reg, l_reg, alpha, pa0, pa1, pa2, pa3);
      RESC(alpha);
      if (PROBE_SENS == 4) { const int ka_ = lds0 + r32 * 256 + 16 * hi; _Pragma("unroll") for (int j = 0; j < 8; ++j) { bf16x8 d0_, d1_; asm volatile("ds_read_b128 %0, %2 offset:%3\n\tds_read_b128 %1, %2 offset:%4\n\ts_waitcnt lgkmcnt(0)" : "=&v"(d0_), "=&v"(d1_) : "v"(ka_), "i"(j * 32), "i"(j * 32 + 8192) : "memory"); asm volatile("" :: "v"(d0_), "v"(d1_)); } }
#endif
      BLOCK_END_V(); }
    sk = (sk == 2) ? 0 : sk + 1; sv = (sv == 2) ? 0 : sv + 1;
  }
  asm volatile("s_waitcnt vmcnt(0)" ::: "memory");
  { int kas[4] = {0, 0, 0, 0}; mblock<false, true>(p0, p1, o, kas, vb0 + sv * (int)SHM_V, qr, pa0, pa1, pa2, pa3, negm); }
  if (PP_ONEBAR) STEP_END_T(); else BLOCK_END_V();
  if (!PP_ONEBAR) { if (!trailing) { __builtin_amdgcn_s_barrier(); asm volatile("" ::: "memory"); } else if (PP_PRIO == 1) __builtin_amdgcn_s_setprio(0); }
  if (hi == 0) li_l[r32] = l_reg; asm volatile("s_waitcnt lgkmcnt(0)" ::: "memory");
  float rli[16];
#pragma unroll
  for (int r = 0; r < 16; ++r) rli[r] = __builtin_amdgcn_rcpf(li_l[crow(r, hi)]);
  { constexpr int PITCH = 272;
    char* stg = lds + wid * (32 * PITCH);
#pragma unroll
    for (int r = 0; r < 16; ++r) { const int orow = crow(r, hi);
#pragma unroll
      for (int d0 = 0; d0 < 4; ++d0) *(bf16*)(stg + orow * PITCH + (d0 * 32 + r32) * 2) = __float2bfloat16(o[d0][r] * rli[r]); }
    asm volatile("s_waitcnt lgkmcnt(0)" ::: "memory");
    bf16* Ow = Ob + (long)(wid * QBLK) * LDO;
#pragma unroll
    for (int i = 0; i < 8; ++i) { const int row = i * 4 + (lane >> 4), ch = lane & 15;
      const u32x4 v = *(const u32x4*)(stg + row * PITCH + ch * 16);
      *(u32x4*)(Ow + (long)row * LDO + ch * 8) = v; } }
#undef DMA_K
#undef DMA_V
#undef RESC
#undef BLOCK_END_M
#undef BLOCK_END_V
#undef BLOCK_END_M_
#undef BLOCK_END_V_
#undef STEP_END_L
#undef STEP_END_T
#undef LGKM_WAIT
}

using f32x4a = __attribute__((ext_vector_type(4))) float;
constexpr int RD = PP_RING;
#define MF16(a, b, c) __builtin_amdgcn_mfma_f32_16x16x32_bf16(a, b, c, 0, 0, 0)
#define LDSV_B8(p_) (*(const __attribute__((address_space(3))) bf16x8*)(unsigned)(p_))
#define LGKM_WAIT(n) do { asm volatile("s_waitcnt lgkmcnt(" #n ")" ::: "memory"); SBAR(); } while (0)
#define PKV(L, H) (bf16x8){L[0], L[1], L[2], L[3], H[0], H[1], H[2], H[3]}
__device__ __forceinline__ float vmax2(float a, float b) { float r; asm("v_max_f32 %0, %1, %2" : "=v"(r) : "v"(a), "v"(b)); return r; }
__device__ __forceinline__ float vmax3(float a, float b, float c) { float r; asm("v_max3_f32 %0, %1, %2, %3" : "=v"(r) : "v"(a), "v"(b), "v"(c)); return r; }
__device__ __forceinline__ float xg_max(float x) {
  auto s = __builtin_amdgcn_permlane16_swap(__float_as_uint(x), __float_as_uint(x), false, false); x = vmax2(__uint_as_float(s[0]), __uint_as_float(s[1]));
  auto t = __builtin_amdgcn_permlane32_swap(__float_as_uint(x), __float_as_uint(x), false, false); return vmax2(__uint_as_float(t[0]), __uint_as_float(t[1]));
}
__device__ __forceinline__ float xg_sum(float x) {
  auto s = __builtin_amdgcn_permlane16_swap(__float_as_uint(x), __float_as_uint(x), false, false); x = __uint_as_float(s[0]) + __uint_as_float(s[1]);
  auto t = __builtin_amdgcn_permlane32_swap(__float_as_uint(x), __float_as_uint(x), false, false); return __uint_as_float(t[0]) + __uint_as_float(t[1]);
}
__device__ __forceinline__ void softmax16(f32x4a (&s)[4][2], float (&mhat)[2], float (&l)[2], float (&alpha)[2], f32x4a (&negm)[2], bool first, bf16x8 (&pa)[2][2], f32x4a (&oT)[8][2], f32x4a (&lT)[2]) {
  constexpr float THR2 = THR * 1.4426950408889634f;
  float pm[2];
#pragma unroll
  for (int qb = 0; qb < 2; ++qb) {
    const float t0 = vmax3(s[0][qb][0], s[0][qb][1], s[0][qb][2]), t1 = vmax3(s[0][qb][3], s[1][qb][0], s[1][qb][1]), t2 = vmax3(s[1][qb][2], s[1][qb][3], s[2][qb][0]);
    const float t3 = vmax3(s[2][qb][1], s[2][qb][2], s[2][qb][3]), t4 = vmax3(s[3][qb][0], s[3][qb][1], s[3][qb][2]);
    pm[qb] = vmax2(vmax3(t0, t1, t2), vmax3(t3, t4, s[3][qb][3])); }
  alpha[0] = 1.f; alpha[1] = 1.f;
  if (__builtin_expect(first || !__all(vmax2(pm[0], pm[1]) <= THR2), 0)) {
#pragma unroll
    for (int qb = 0; qb < 2; ++qb) { pm[qb] = xg_max(pm[qb]);
      const float dl = first ? pm[qb] : fmaxf(pm[qb], 0.f);
      const float nm = negm[qb][0] - dl;
#pragma unroll
      for (int kb = 0; kb < 4; ++kb)
#pragma unroll
        for (int e = 0; e < 4; ++e) s[kb][qb][e] -= dl;
      if (!first) { alpha[qb] = __builtin_amdgcn_exp2f(-dl);
        if (PP_LMFMA) { const float a_ = alpha[qb];
#pragma unroll
          for (int db = 0; db < 8; ++db)
#pragma unroll
            for (int e = 0; e < 4; ++e) oT[db][qb][e] *= a_;
#pragma unroll
          for (int e = 0; e < 4; ++e) lT[qb][e] *= a_; } }
#pragma unroll
      for (int e = 0; e < 4; ++e) negm[qb][e] = nm;
      asm volatile("" : "+v"(negm[qb])); }
  }
}
template <int qb> __device__ __forceinline__ void softmax16_qb(f32x4a (&s)[4][2], float (&l)[2], const float (&alpha)[2], bf16x8 (&pa)[2][2]) {
#pragma unroll
  for (int kb = 0; kb < 4; ++kb)
#pragma unroll
    for (int e = 0; e < 4; ++e) s[kb][qb][e] = __builtin_amdgcn_exp2f(s[kb][qb][e]);
  if (!PP_LMFMA) { const f32x4a t = (s[0][qb] + s[1][qb]) + (s[2][qb] + s[3][qb]);
    l[qb] = l[qb] * alpha[qb] + ((t[0] + t[1]) + (t[2] + t[3])); }
#pragma unroll
  for (int j = 0; j < 2; ++j) { u32x4 w = {cvtpk(s[2 * j][qb][0], s[2 * j][qb][1]), cvtpk(s[2 * j][qb][2], s[2 * j][qb][3]), cvtpk(s[2 * j + 1][qb][0], s[2 * j + 1][qb][1]), cvtpk(s[2 * j + 1][qb][2], s[2 * j + 1][qb][3])};
    pa[j][qb] = *reinterpret_cast<bf16x8*>(&w); }
}
template <int qb> __device__ __forceinline__ float softmax16_qb_sum(f32x4a (&s)[4][2], bf16x8 (&pa)[2][2]) {
#pragma unroll
  for (int kb = 0; kb < 4; ++kb)
#pragma unroll
    for (int e = 0; e < 4; ++e) s[kb][qb][e] = __builtin_amdgcn_exp2f(s[kb][qb][e]);
  const f32x4a t = (s[0][qb] + s[1][qb]) + (s[2][qb] + s[3][qb]);
#pragma unroll
  for (int j = 0; j < 2; ++j) { u32x4 w = {cvtpk(s[2 * j][qb][0], s[2 * j][qb][1]), cvtpk(s[2 * j][qb][2], s[2 * j][qb][3]), cvtpk(s[2 * j + 1][qb][0], s[2 * j + 1][qb][1]), cvtpk(s[2 * j + 1][qb][2], s[2 * j + 1][qb][3])};
    pa[j][qb] = *reinterpret_cast<bf16x8*>(&w); }
  return (t[0] + t[1]) + (t[2] + t[3]);
}
__device__ __forceinline__ void softmax16_sum_finish(float t0, float t1, float (&l)[2], float (&alpha)[2], f32x4a (&negm)[2], bf16x8 (&pa)[2][2]) {
  constexpr float LIM = 2896.3093757f;
  alpha[0] = 1.f; alpha[1] = 1.f;
  if (__builtin_expect(__all(vmax2(t0, t1) <= LIM), 1)) { l[0] += t0; l[1] += t1; return; }
  const float tt[2] = {t0, t1};
#pragma unroll
  for (int qb = 0; qb < 2; ++qb) {
    const float T = xg_sum(tt[qb]);
    const float dl = (T > 1.f) ? ceilf(__builtin_amdgcn_logf(T)) : 0.f;
    const float a_ = __builtin_amdgcn_exp2f(-dl);
    l[qb] = (l[qb] + tt[qb]) * a_; alpha[qb] = a_;
{ const unsigned di_ = (unsigned)(int)dl, dw_ = (di_ << 23) | (di_ << 7);
#pragma unroll
      for (int j = 0; j < 2; ++j) { u32x4 w = __builtin_bit_cast(u32x4, pa[j][qb]); w -= dw_; pa[j][qb] = __builtin_bit_cast(bf16x8, w); } }
    const float nm = negm[qb][0] - dl;
#pragma unroll
    for (int e = 0; e < 4; ++e) negm[qb][e] = nm;
    asm volatile("" : "+v"(negm[qb])); }
}
template <int GI> struct VRd16 { s16x4 r[2][2][2];
  __device__ __forceinline__ void issue(const int (&vbx)[2][2]) {
    r[0][0][0] = tr_read<512 * GI>(vbx[0][0]); r[0][0][1] = tr_read<512 * GI>(vbx[1][0]); r[0][1][0] = tr_read<8192 + 512 * GI>(vbx[0][0]); r[0][1][1] = tr_read<8192 + 512 * GI>(vbx[1][0]);
    r[1][0][0] = tr_read<512 * GI>(vbx[0][1]); r[1][0][1] = tr_read<512 * GI>(vbx[1][1]); r[1][1][0] = tr_read<8192 + 512 * GI>(vbx[0][1]); r[1][1][1] = tr_read<8192 + 512 * GI>(vbx[1][1]); }
  __device__ __forceinline__ void mma(f32x4a (&oT)[8][2], const bf16x8 (&pa)[2][2]) const {
#pragma unroll
    for (int j = 0; j < 2; ++j)
#pragma unroll
      for (int dd = 0; dd < 2; ++dd)
#pragma unroll
        for (int qb = 0; qb < 2; ++qb) oT[2 * GI + dd][qb] = MF16(PKV(r[dd][j][0], r[dd][j][1]), pa[j][qb], oT[2 * GI + dd][qb]); } };
template <bool WITH_QK, bool WITH_PV, bool PREF>
__device__ __forceinline__ void mblock16(f32x4a (&s)[4][2], f32x4a (&oT)[8][2], f32x4a (&lT)[2], const bf16x8 (&kpf)[4], const int (&kas)[4], const int (&vbx)[2][2], const bf16x8 (&qf)[2][4], const bf16x8 (&pa)[2][2], const f32x4a (&cinit)[2]) {
  bf16x8 kf[4][4];
  VRd16<0> v0; VRd16<1> v1; VRd16<2> v2; VRd16<3> v3;
  SBAR();
  if (PP_PRIO == 2) __builtin_amdgcn_s_setprio(1);
#define QK_STEP(ks) do { _Pragma("unroll") for (int kb = 0; kb < 4; ++kb) { _Pragma("unroll") for (int qb = 0; qb < 2; ++qb) s[kb][qb] = MF16(kf[ks][kb], qf[qb][ks], (ks) == 0 ? cinit[qb] : s[kb][qb]); } SBAR(); } while (0)
#define K_RD(ks) do { kf[ks][0] = lds_rd128<0>(kas[ks]); kf[ks][1] = lds_rd128<4096>(kas[ks]); kf[ks][2] = lds_rd128<8192>(kas[ks]); kf[ks][3] = lds_rd128<12288>(kas[ks]); } while (0)
#define L_MFMA() do { if (PP_LMFMA) { const unsigned o1_ = 0x3F803F80u; const u32x4 ow_ = {o1_, o1_, o1_, o1_}; const bf16x8 ones_ = *reinterpret_cast<const bf16x8*>(&ow_); \
    lT[0] = MF16(ones_, pa[0][0], lT[0]); lT[1] = MF16(ones_, pa[0][1], lT[1]); lT[0] = MF16(ones_, pa[1][0], lT[0]); lT[1] = MF16(ones_, pa[1][1], lT[1]); SBAR(); } } while (0)
  if constexpr (WITH_QK) {
    if constexpr (PREF) {
      K_RD(1); K_RD(2);
#pragma unroll
      for (int kb = 0; kb < 4; ++kb) kf[0][kb] = kpf[kb];
      if constexpr (WITH_PV) L_MFMA();
      QK_STEP(0);
      K_RD(3); LGKM_WAIT(8); QK_STEP(1);
      if constexpr (WITH_PV) { v0.issue(vbx); LGKM_WAIT(12); } else { LGKM_WAIT(4); }
      QK_STEP(2);
      if constexpr (WITH_PV) { LGKM_WAIT(8); } else { LGKM_WAIT(0); }
      QK_STEP(3);
    } else if (PP_LMFMA) {
      K_RD(0); K_RD(1); K_RD(2);
      if constexpr (WITH_PV) L_MFMA();
      LGKM_WAIT(8); QK_STEP(0);
      K_RD(3); LGKM_WAIT(8); QK_STEP(1);
      if constexpr (WITH_PV) { v0.issue(vbx); LGKM_WAIT(12); } else { LGKM_WAIT(4); }
      QK_STEP(2);
      if constexpr (WITH_PV) { LGKM_WAIT(8); } else { LGKM_WAIT(0); }
      QK_STEP(3);
    } else {
    K_RD(0); K_RD(1); K_RD(2); K_RD(3);
    LGKM_WAIT(12); QK_STEP(0);
    LGKM_WAIT(8);  QK_STEP(1);
    if constexpr (WITH_PV) { v0.issue(vbx); LGKM_WAIT(12); } else { LGKM_WAIT(4); }
    QK_STEP(2);
    if constexpr (WITH_PV) { LGKM_WAIT(8); } else { LGKM_WAIT(0); }
    QK_STEP(3);
    }
    if constexpr (WITH_PV) {
      v1.issue(vbx); v2.issue(vbx); LGKM_WAIT(15); v0.mma(oT, pa); SBAR();
      v3.issue(vbx); LGKM_WAIT(15); v1.mma(oT, pa); SBAR();
      LGKM_WAIT(8); v2.mma(oT, pa); SBAR();
      LGKM_WAIT(0); v3.mma(oT, pa); SBAR();
    }
  } else if constexpr (WITH_PV) {
    v0.issue(vbx); v1.issue(vbx); L_MFMA(); LGKM_WAIT(8); v0.mma(oT, pa); SBAR();
    v2.issue(vbx); LGKM_WAIT(8); v1.mma(oT, pa); SBAR();
    v3.issue(vbx); LGKM_WAIT(8); v2.mma(oT, pa); SBAR();
    LGKM_WAIT(0); v3.mma(oT, pa); SBAR();
  }
  if (PP_PRIO == 2) __builtin_amdgcn_s_setprio(0);
#undef QK_STEP
#undef K_RD
#undef L_MFMA
}
template <bool WITH_QK, bool WITH_PV, bool PREF>
__device__ __forceinline__ void mblock16v(f32x4a (&s)[4][2], f32x4a (&oT)[8][2], f32x4a (&lT)[2], const bf16x8 (&kpf)[16], const int (&kas)[4], const int (&vbj)[2], const bf16x8 (&qf)[2][4], const bf16x8 (&pa)[2][2], const f32x4a (&cinit)[2]) {
  bf16x8 kf[4][4];
  bf16x8 vf[4][2][2];
  SBAR();
  if (PP_PRIO == 2) __builtin_amdgcn_s_setprio(1);
#define QK_STEP(ks) do { _Pragma("unroll") for (int kb = 0; kb < 4; ++kb) { _Pragma("unroll") for (int qb = 0; qb < 2; ++qb) s[kb][qb] = MF16(kf[ks][kb], qf[qb][ks], (ks) == 0 ? cinit[qb] : s[kb][qb]); } SBAR(); } while (0)
#define K_RD(ks) do { kf[ks][0] = lds_rd128<0>(kas[ks]); kf[ks][1] = lds_rd128<4096>(kas[ks]); kf[ks][2] = lds_rd128<8192>(kas[ks]); kf[ks][3] = lds_rd128<12288>(kas[ks]); } while (0)
#define V_RD(gi) do { vf[gi][0][0] = lds_rd128<2048 * (2 * (gi))>(vbj[0]); vf[gi][0][1] = lds_rd128<2048 * (2 * (gi))>(vbj[1]); vf[gi][1][0] = lds_rd128<2048 * (2 * (gi) + 1)>(vbj[0]); vf[gi][1][1] = lds_rd128<2048 * (2 * (gi) + 1)>(vbj[1]); } while (0)
#define PV_STEP(gi) do { _Pragma("unroll") for (int j = 0; j < 2; ++j) { _Pragma("unroll") for (int dd = 0; dd < 2; ++dd) { _Pragma("unroll") for (int qb = 0; qb < 2; ++qb) oT[2 * (gi) + dd][qb] = MF16(vf[gi][dd][j], pa[j][qb], oT[2 * (gi) + dd][qb]); } } SBAR(); } while (0)
#define L_MFMA() do { if (PP_LMFMA) { const unsigned o1_ = 0x3F803F80u; const u32x4 ow_ = {o1_, o1_, o1_, o1_}; const bf16x8 ones_ = *reinterpret_cast<const bf16x8*>(&ow_); \
    lT[0] = MF16(ones_, pa[0][0], lT[0]); lT[1] = MF16(ones_, pa[0][1], lT[1]); lT[0] = MF16(ones_, pa[1][0], lT[0]); lT[1] = MF16(ones_, pa[1][1], lT[1]); SBAR(); } } while (0)
  if constexpr (WITH_QK && WITH_PV) {
    if constexpr (PREF && PP_CVIS) {
#define V_RDV(gi) do { vf[gi][0][0] = LDSV_B8(vbj[0] + 2048 * (2 * (gi))); vf[gi][0][1] = LDSV_B8(vbj[1] + 2048 * (2 * (gi))); vf[gi][1][0] = LDSV_B8(vbj[0] + 2048 * (2 * (gi) + 1)); vf[gi][1][1] = LDSV_B8(vbj[1] + 2048 * (2 * (gi) + 1)); SBAR(); } while (0)
#pragma unroll
      for (int ks = 0; ks < (PP_CVIS == 1 ? 4 : 3); ++ks)
#pragma unroll
        for (int kb = 0; kb < 4; ++kb) kf[ks][kb] = kpf[4 * ks + kb];
      if (PP_CVIS == 2) { kf[3][0] = LDSV_B8(kas[3]); kf[3][1] = LDSV_B8(kas[3] + 4096); kf[3][2] = LDSV_B8(kas[3] + 8192); kf[3][3] = LDSV_B8(kas[3] + 12288); SBAR(); }
      QK_STEP(0); L_MFMA();
      V_RDV(0); QK_STEP(1);
      V_RDV(1); QK_STEP(2);
      V_RDV(2); QK_STEP(3);
      V_RDV(3); PV_STEP(0); PV_STEP(1); PV_STEP(2); PV_STEP(3);
#undef V_RDV
    } else if constexpr (PREF) {
#pragma unroll
      for (int kb = 0; kb < 4; ++kb) { kf[0][kb] = kpf[kb]; kf[1][kb] = kpf[4 + kb]; }
      K_RD(2); K_RD(3);
      QK_STEP(0); L_MFMA();
      V_RD(0); QK_STEP(1);
      V_RD(1); LGKM_WAIT(12); QK_STEP(2);
      V_RD(2); LGKM_WAIT(12); QK_STEP(3);
      V_RD(3); LGKM_WAIT(12); PV_STEP(0);
      LGKM_WAIT(8); PV_STEP(1);
      LGKM_WAIT(4); PV_STEP(2);
      LGKM_WAIT(0); PV_STEP(3);
    } else {
      K_RD(0); K_RD(1); K_RD(2); K_RD(3);
      L_MFMA();
      LGKM_WAIT(12); QK_STEP(0);
      V_RD(0); LGKM_WAIT(12); QK_STEP(1);
      V_RD(1); LGKM_WAIT(12); QK_STEP(2);
      V_RD(2); LGKM_WAIT(12); QK_STEP(3);
      V_RD(3); LGKM_WAIT(12); PV_STEP(0);
      LGKM_WAIT(8); PV_STEP(1);
      LGKM_WAIT(4); PV_STEP(2);
      LGKM_WAIT(0); PV_STEP(3);
    }
  } else if constexpr (WITH_QK) {
    K_RD(0); K_RD(1); K_RD(2); K_RD(3);
    LGKM_WAIT(12); QK_STEP(0); LGKM_WAIT(8); QK_STEP(1); LGKM_WAIT(4); QK_STEP(2); LGKM_WAIT(0); QK_STEP(3);
  } else {
    LGKM_WAIT(0);
    V_RD(0); V_RD(1); V_RD(2); V_RD(3); L_MFMA();
    LGKM_WAIT(12); PV_STEP(0); LGKM_WAIT(8); PV_STEP(1); LGKM_WAIT(4); PV_STEP(2); LGKM_WAIT(0); PV_STEP(3);
  }
  if (PP_PRIO == 2) __builtin_amdgcn_s_setprio(0);
#undef QK_STEP
#undef K_RD
#undef V_RD
#undef PV_STEP
#undef L_MFMA
}
template <bool sumvote> __device__ __forceinline__ void attn_pp16_body(const bf16* __restrict__ Qb, const bf16* __restrict__ Kh, const bf16* __restrict__ Vh, bf16* __restrict__ Ob, int seq, lds_ptr lds3) {
  char* lds = (char*)lds3;
  int tid = threadIdx.x; asm volatile("" : "+v"(tid));
  const int wid = __builtin_amdgcn_readfirstlane(tid >> 6), lane = tid & 63, r16 = lane & 15, g = lane >> 4;
  const bool trailing = wid >= 4;
  int koff[2], voff[2];
#pragma unroll
  for (int i = 0; i < 2; ++i) { const int w = 2 * wid + i;
    { const int row = 4 * w + (lane >> 4), ch = (lane & 15) ^ (row & 15); koff[i] = row * LDK + ch * 8; }
    if (PP_VT) voff[i] = 512 * w + 8 * lane;
    else { const int R = 8 * wid + ((lane & 31) >> 2), key = (R & 0x23) | ((R & 0x18) >> 1) | ((R & 4) << 2), ch = 4 * (2 * i + (lane >> 5)) + ((lane & 3) ^ ((R >> 2) & 3)); voff[i] = key * LDK + ch * 8; } }
#define DMA_K(t, slot) do { _Pragma("unroll") for (int i_ = 0; i_ < 2; ++i_) __builtin_amdgcn_global_load_lds((const __attribute__((address_space(1))) unsigned*)(Kh + (long)(t) * (KVBLK * LDK) + (i_ ? (koff[0] ^ 32) + 512 : koff[0])), \
      (__attribute__((address_space(3))) unsigned*)(lds3 + (slot) * (int)SHM_K + (2 * wid + i_) * 1024), 16, 0, 0); } while (0)
#define DMA_V(t, slot) do { _Pragma("unroll") for (int i_ = 0; i_ < 2; ++i_) __builtin_amdgcn_global_load_lds((const __attribute__((address_space(1))) unsigned*)(Vh + (long)(t) * (KVBLK * LDK) + voff[i_]), \
      (__attribute__((address_space(3))) unsigned*)(lds3 + RD * (int)SHM_K + (slot) * (int)SHM_V + (2 * wid + i_) * 1024), 16, 0, 0); } while (0)
#define BLOCK_END_M() do { if (RD == 4 && !PP_PREF16) asm volatile("s_waitcnt vmcnt(4) lgkmcnt(0)" ::: "memory"); else asm volatile("s_waitcnt vmcnt(0) lgkmcnt(0)" ::: "memory"); SBAR(); __builtin_amdgcn_s_barrier(); asm volatile("" ::: "memory"); if (PROBE_SENS == 5) __builtin_amdgcn_s_sleep(5); SBAR(); } while (0)
#define K_PREF23(slot) do { if (PP_CVIS && PP_PREF16 && PP_VT) { SBAR(); const int c_ = (kad0 + (slot) * (int)SHM_K) ^ 128, d_ = c_ ^ 64; \
    kpf[8] = LDSV_B8(c_); kpf[9] = LDSV_B8(c_ + 4096); kpf[10] = LDSV_B8(c_ + 8192); kpf[11] = LDSV_B8(c_ + 12288); if (PP_CVIS == 1) { kpf[12] = LDSV_B8(d_); kpf[13] = LDSV_B8(d_ + 4096); kpf[14] = LDSV_B8(d_ + 8192); kpf[15] = LDSV_B8(d_ + 12288); } SBAR(); } } while (0)
#define BLOCK_END_V() BLOCK_END_V2(-1)
#define BLOCK_END_V2(slot) do { asm volatile("s_waitcnt lgkmcnt(0)" ::: "memory"); if (PP_PREF16) { asm volatile("" :: "v"(kpf[0]), "v"(kpf[1]), "v"(kpf[2]), "v"(kpf[3])); if (PP_VT) asm volatile("" :: "v"(kpf[4]), "v"(kpf[5]), "v"(kpf[6]), "v"(kpf[7])); }     if ((slot) >= 0) K_PREF23(slot); SBAR(); __builtin_amdgcn_s_barrier(); asm volatile("" ::: "memory"); if (PROBE_SENS == 5) __builtin_amdgcn_s_sleep(5); SBAR(); } while (0)
#define KPF_USE() do { if (PP_PREF16) { asm volatile("" :: "v"(kpf[0]), "v"(kpf[1]), "v"(kpf[2]), "v"(kpf[3])); if (PP_VT) asm volatile("" :: "v"(kpf[4]), "v"(kpf[5]), "v"(kpf[6]), "v"(kpf[7])); } } while (0)
#define OB_END_M() do { if (trailing) { asm volatile("s_waitcnt vmcnt(4) lgkmcnt(0)" ::: "memory"); SBAR(); __builtin_amdgcn_s_barrier(); asm volatile("" ::: "memory"); } SBAR(); } while (0)
#define OB_END_V() do { if (!trailing) { asm volatile("s_waitcnt vmcnt(4) lgkmcnt(0)" ::: "memory"); KPF_USE(); SBAR(); __builtin_amdgcn_s_barrier(); asm volatile("" ::: "memory"); } else { asm volatile("s_waitcnt lgkmcnt(0)" ::: "memory"); KPF_USE(); } SBAR(); } while (0)
#define RESC16() do { if (!PP_LMFMA && __any(alpha[0] < 1.f || alpha[1] < 1.f)) { _Pragma("unroll") for (int db = 0; db < 8; ++db) { _Pragma("unroll") for (int qb = 0; qb < 2; ++qb) { _Pragma("unroll") for (int e = 0; e < 4; ++e) oT[db][qb][e] *= alpha[qb]; } } if (PP_LMFMA) { _Pragma("unroll") for (int qb = 0; qb < 2; ++qb) { _Pragma("unroll") for (int e = 0; e < 4; ++e) lT[qb][e] *= alpha[qb]; } } } } while (0)
#if PROBE_SENS >= 6
  unsigned long long tprev_ = 0; unsigned acc_ = 0;
constexpr int PS_BASE = (PROBE_SENS >= 16) ? 16 : 6, PS_COMP = (PROBE_SENS - PS_BASE) & 3, PS_WAVE = (PROBE_SENS >= 30) ? 0 : ((PROBE_SENS - PS_BASE) >> 2) & 1;
#define STAMP(k) do { const unsigned long long c_ = (PROBE_SENS >= 16 && PROBE_SENS != 31) ? __builtin_amdgcn_s_memrealtime() : __builtin_amdgcn_s_memtime(); if ((PS_COMP == (k) || PROBE_SENS >= 30) && (k) >= 0) acc_ += (unsigned)(c_ - tprev_); tprev_ = c_; } while (0)
#else
#define STAMP(k) do { } while (0)
#endif
  const int NT = seq / KVBLK;
  DMA_K(0, 0); DMA_V(0, 0); DMA_K(1, 1); if (RD == 4) { DMA_V(1, 1); DMA_K(2, 2); }
  bf16x8 qf[2][4];
  { const bf16* Qw = Qb + (long)(wid * QBLK + r16) * LDQ + g * 8;
#pragma unroll
    for (int qb = 0; qb < 2; ++qb)
#pragma unroll
      for (int ks = 0; ks < 4; ++ks) qf[qb][ks] = *reinterpret_cast<const bf16x8*>(Qw + (long)(16 * qb) * LDQ + ks * 32); }
  const int lds0 = (int)(uintptr_t)lds;
  const int kad0 = lds0 + r16 * 256 + ((g ^ r16) << 4);
const int vt0c_ = lds0 + RD * (int)SHM_K + 128 * r16 + 16 * (g ^ (r16 >> 1));
#define VT0() (vt0c_)
  const int vt0_unused_ = 0; (void)vt0_unused_;
  const int vb0 = lds0 + RD * (int)SHM_K + 2048 * g + 64 * ((lane & 15) >> 2) + 8 * (lane & 1) + 16 * ((lane >> 1) & 1) + 32 * (g & 1);
  bf16x8 kpf[16];
#define LDS_B8(p_) (*(const __attribute__((address_space(3))) bf16x8*)(unsigned)(p_))
#define K_PREF(slot) do { if (PP_PREF16) { SBAR(); const int a_ = kad0 + (slot) * (int)SHM_K; \
    kpf[0] = LDS_B8(a_); kpf[1] = LDS_B8(a_ + 4096); kpf[2] = LDS_B8(a_ + 8192); kpf[3] = LDS_B8(a_ + 12288); SBAR(); } } while (0)
#define K_PREF1(slot) do { if (PP_PREF16 && PP_VT) { SBAR(); const int b_ = (kad0 + (slot) * (int)SHM_K) ^ 64; \
    kpf[4] = LDS_B8(b_); kpf[5] = LDS_B8(b_ + 4096); kpf[6] = LDS_B8(b_ + 8192); kpf[7] = LDS_B8(b_ + 12288); SBAR(); } } while (0)
  f32x4a s[4][2]; float alpha[2] = {1.f, 1.f}, mhat[2] = {0.f, 0.f}, l[2] = {0.f, 0.f}; bf16x8 pa[2][2];
  asm volatile("s_waitcnt vmcnt(0)" ::: "memory"); __builtin_amdgcn_s_barrier(); asm volatile("" ::: "memory");
  if (!PP_ONEBAR16 && trailing) { __builtin_amdgcn_s_barrier(); asm volatile("" ::: "memory"); }
  f32x4a oT[8][2];
  f32x4a negm[2], lT[2];
  { float z_ = 0.f; asm volatile("" : "+v"(z_));
#pragma unroll
    for (int db = 0; db < 8; ++db)
#pragma unroll
      for (int qb = 0; qb < 2; ++qb) oT[db][qb] = f32x4a{z_, z_, z_, z_};
    negm[0] = f32x4a{z_, z_, z_, z_}; negm[1] = negm[0]; lT[0] = negm[0]; lT[1] = negm[0]; asm volatile("" : "+v"(negm[0]), "+v"(negm[1])); }
  { int kas[4], vbx[2][2];
#pragma unroll
    for (int ks = 0; ks < 4; ++ks) kas[ks] = kad0 ^ (64 * ks);
    vbx[0][0] = vb0; vbx[0][1] = vb0 ^ 32; vbx[1][0] = vb0 ^ 272; vbx[1][1] = vb0 ^ 304;
    pa[0][0] = qf[0][0]; pa[0][1] = qf[0][0]; pa[1][0] = qf[0][0]; pa[1][1] = qf[0][0];
    if (PP_VT) { const int vt0 = VT0(); const int vbj[2] = {vt0, vt0 ^ 64}; mblock16v<true, false, false>(s, oT, lT, kpf, kas, vbj, qf, pa, negm); }
    else { const bf16x8 (&kp4)[4] = *reinterpret_cast<const bf16x8 (*)[4]>(&kpf[0]); mblock16<true, false, false>(s, oT, lT, kp4, kas, vbx, qf, pa, negm); } }
  if (PP_ONEBAR16) { if (trailing) { DMA_K(3, 3); DMA_V(2, 2); } OB_END_M(); } else BLOCK_END_M();
  if (PP_ONEBAR16) { if (!trailing) { DMA_K(3, 3); DMA_V(2, 2); } else { DMA_K(4, 0); } }
  else if (RD == 4) { DMA_K(3, 3); DMA_V(2, 2); } else { DMA_K(2, 2); DMA_V(1, 1); }
  K_PREF(1);
  if constexpr (PP_SUMVOTE && sumvote) { const float t0_ = softmax16_qb_sum<0>(s, pa); K_PREF1(1); const float t1_ = softmax16_qb_sum<1>(s, pa); softmax16_sum_finish(t0_, t1_, l, alpha, negm, pa); }
  else { softmax16(s, mhat, l, alpha, negm, true, pa, oT, lT); softmax16_qb<0>(s, l, alpha, pa); K_PREF1(1); softmax16_qb<1>(s, l, alpha, pa); }
  if (PP_ONEBAR16) OB_END_V(); else BLOCK_END_V2(1);
  int sk = 1, sv = 0;
  STAMP(-1);
  for (int t = 1; t < NT; ++t) {
    { int kas[4], vbx[2][2]; const int kbs = sk * (int)SHM_K; const int vbs = vb0 + sv * (int)SHM_V;
#pragma unroll
      for (int ks = 0; ks < 4; ++ks) kas[ks] = (kad0 + kbs) ^ (64 * ks);
      vbx[0][0] = vbs; vbx[0][1] = vbs ^ 32; vbx[1][0] = vbs ^ 272; vbx[1][1] = vbs ^ 304;
      f32x4a q[4][2];
      if (PP_VT) { const int vts = VT0() + sv * (int)SHM_V; const int vbj[2] = {vts, vts ^ 64}; mblock16v<true, true, PP_PREF16 != 0>(q, oT, lT, kpf, kas, vbj, qf, pa, negm); }
      else { const bf16x8 (&kp4)[4] = *reinterpret_cast<const bf16x8 (*)[4]>(&kpf[0]); mblock16<true, true, PP_PREF16 != 0>(q, oT, lT, kp4, kas, vbx, qf, pa, negm); }
      STAMP(0);
      if (PP_ONEBAR16) { const int tv_ = (t + 2 < NT) ? t + 2 : NT - 1, sv2_ = (sv == 0) ? RD - 1 : sv - 1; DMA_V(tv_, sv2_); OB_END_M(); }
      else if (PP_VDMA_M) { const int tv_ = (t + RD - 2 < NT) ? t + RD - 2 : NT - 1, sv2_ = (sv == 0) ? RD - 1 : sv - 1; DMA_V(tv_, sv2_);
        if (PP_VDMA_M == 2) { const int tk_ = (t + RD - 1 < NT) ? t + RD - 1 : NT - 1, sk2_ = (sk == 0) ? RD - 1 : sk - 1; DMA_K(tk_, sk2_); asm volatile("s_waitcnt vmcnt(4) lgkmcnt(0)" ::: "memory"); }
        else asm volatile("s_waitcnt vmcnt(2) lgkmcnt(0)" ::: "memory");
        SBAR(); __builtin_amdgcn_s_barrier(); asm volatile("" ::: "memory"); SBAR(); }
      else BLOCK_END_M();
      STAMP(1);
      if (PP_PRIO == 3) __builtin_amdgcn_s_setprio(1);
      K_PREF((sk == RD - 1) ? 0 : sk + 1);
      if (PP_ONEBAR16) { const int tq_ = t + 3 + (trailing ? 1 : 0), tk_ = (tq_ < NT) ? tq_ : NT - 1, sk2_ = trailing ? sk : ((sk == 0) ? RD - 1 : sk - 1); DMA_K(tk_, sk2_); }
      else { const int tk_ = (t + RD - 1 < NT) ? t + RD - 1 : NT - 1, tv_ = (t + RD - 2 < NT) ? t + RD - 2 : NT - 1; const int sk2_ = (sk == 0) ? RD - 1 : sk - 1, sv2_ = (sv == 0) ? RD - 1 : sv - 1; if (PP_VDMA_M != 2) DMA_K(tk_, sk2_); if (!PP_VDMA_M) DMA_V(tv_, sv2_); }
      if constexpr (PP_SUMVOTE && sumvote) { const float t0_ = softmax16_qb_sum<0>(q, pa); K_PREF1((sk == RD - 1) ? 0 : sk + 1); const float t1_ = softmax16_qb_sum<1>(q, pa); softmax16_sum_finish(t0_, t1_, l, alpha, negm, pa); }
      else { softmax16(q, mhat, l, alpha, negm, false, pa, oT, lT); softmax16_qb<0>(q, l, alpha, pa); K_PREF1((sk == RD - 1) ? 0 : sk + 1); softmax16_qb<1>(q, l, alpha, pa); }
      RESC16();
      if (PP_PRIO == 3) __builtin_amdgcn_s_setprio(0);
      STAMP(2);
      if (PP_ONEBAR16) OB_END_V(); else BLOCK_END_V2((sk == RD - 1) ? 0 : sk + 1);
      STAMP(3); }
    sk = (sk == RD - 1) ? 0 : sk + 1; sv = (sv == RD - 1) ? 0 : sv + 1;
  }
#if PROBE_SENS >= 6
  if (blockIdx.x == 0 && tid == (PS_WAVE ? 256 : 0)) ((volatile unsigned*)(lds + 131072 + 320))[16] += (PROBE_SENS == 30) ? (acc_ >> 2) : (PROBE_SENS == 31) ? (acc_ >> 9) : (PROBE_SENS >= 16) ? acc_ : (acc_ >> 7);
#endif
  asm volatile("s_waitcnt vmcnt(0)" ::: "memory");
  { int kas[4] = {0, 0, 0, 0}, vbx[2][2]; const int vbs = vb0 + sv * (int)SHM_V;
    vbx[0][0] = vbs; vbx[0][1] = vbs ^ 32; vbx[1][0] = vbs ^ 272; vbx[1][1] = vbs ^ 304;
    if (PP_VT) { const int vts = VT0() + sv * (int)SHM_V; const int vbj[2] = {vts, vts ^ 64}; mblock16v<false, true, false>(s, oT, lT, kpf, kas, vbj, qf, pa, negm); }
    else { const bf16x8 (&kp4)[4] = *reinterpret_cast<const bf16x8 (*)[4]>(&kpf[0]); mblock16<false, true, false>(s, oT, lT, kp4, kas, vbx, qf, pa, negm); } }
  if (PP_ONEBAR16) { asm volatile("s_waitcnt lgkmcnt(0)" ::: "memory"); SBAR(); __builtin_amdgcn_s_barrier(); asm volatile("" ::: "memory"); SBAR(); } else
  BLOCK_END_V();
  if (!PP_ONEBAR16 && !trailing) { __builtin_amdgcn_s_barrier(); asm volatile("" ::: "memory"); }
  float rli[2]; if (PP_LMFMA) { rli[0] = __builtin_amdgcn_rcpf(lT[0][0]); rli[1] = __builtin_amdgcn_rcpf(lT[1][0]); } else { rli[0] = __builtin_amdgcn_rcpf(xg_sum(l[0])); rli[1] = __builtin_amdgcn_rcpf(xg_sum(l[1])); }
  { constexpr int PITCH = 272;
    char* stg = lds + wid * (32 * PITCH);
#pragma unroll
    for (int qb = 0; qb < 2; ++qb)
#pragma unroll
      for (int db = 0; db < 8; ++db) { const unsigned w0 = cvtpk(oT[db][qb][0] * rli[qb], oT[db][qb][1] * rli[qb]), w1 = cvtpk(oT[db][qb][2] * rli[qb], oT[db][qb][3] * rli[qb]);
        uint2 w; w.x = w0; w.y = w1; *(uint2*)(stg + (16 * qb + r16) * PITCH + (16 * db + 4 * g) * 2) = w; }
    asm volatile("s_waitcnt lgkmcnt(0)" ::: "memory");
    bf16* Ow = Ob + (long)(wid * QBLK) * LDO;
#pragma unroll
    for (int i = 0; i < 8; ++i) { const int row = i * 4 + (lane >> 4), ch = lane & 15;
      const u32x4 v = *(const u32x4*)(stg + row * PITCH + ch * 16);
      *(u32x4*)(Ow + (long)row * LDO + ch * 8) = v; } }
#undef DMA_K
#undef DMA_V
#undef RESC16
#undef OB_END_M
#undef OB_END_V
#undef KPF_USE
#undef K_PREF
#undef VT0
#undef K_PREF1
#undef LDS_B8
#undef STAMP
#undef BLOCK_END_M
#undef BLOCK_END_V
#undef BLOCK_END_V2
#undef K_PREF23
#undef LGKM_WAIT
#undef MF16
#undef PKV
}

using f32x16b = __attribute__((ext_vector_type(16))) float;
#define MF32(a, b, c) __builtin_amdgcn_mfma_f32_32x32x16_bf16(a, b, c, 0, 0, 0)
#define LGKM_WAIT(n) do { asm volatile("s_waitcnt lgkmcnt(" #n ")" ::: "memory"); SBAR(); } while (0)
__device__ __forceinline__ void softmax32_head(f32x16b (&p)[2], float& alpha, f32x16b& negm, bool first) {
  constexpr float THR2 = THR * 1.4426950408889634f;
  float m0 = vmax3(p[0][0], p[0][1], p[0][2]), m1 = vmax3(p[1][0], p[1][1], p[1][2]);
#pragma unroll
  for (int i = 3; i < 15; i += 2) { m0 = vmax3(m0, p[0][i], p[0][i + 1]); m1 = vmax3(m1, p[1][i], p[1][i + 1]); }
  float pm = vmax3(m0, m1, vmax2(p[0][15], p[1][15]));
  alpha = 1.f;
  if (__builtin_expect(first || !__all(pm <= THR2), 0)) {
    { auto rr = __builtin_amdgcn_permlane32_swap(__float_as_uint(pm), __float_as_uint(pm), false, false); pm = vmax2(__uint_as_float(rr[0]), __uint_as_float(rr[1])); }
    const float dl = first ? pm : fmaxf(pm, 0.f);
    const float nm = negm[0] - dl;
#pragma unroll
    for (int i = 0; i < 16; ++i) { p[0][i] -= dl; p[1][i] -= dl; }
    if (!first) alpha = __builtin_amdgcn_exp2f(-dl);
#pragma unroll
    for (int i = 0; i < 16; ++i) negm[i] = nm;
    asm volatile("" : "+v"(negm));
  }
}
template <int kb> __device__ __forceinline__ void softmax32_kb(f32x16b (&p)[2], float& lsum, bf16x8 (&pa)[4]) {
#pragma unroll
  for (int i = 0; i < 16; ++i) p[kb][i] = __builtin_amdgcn_exp2f(p[kb][i]);
  { typedef float f8 __attribute__((ext_vector_type(8))); typedef float f4 __attribute__((ext_vector_type(4)));
    const f8 a = __builtin_shufflevector(p[kb], p[kb], 0, 1, 2, 3, 4, 5, 6, 7) + __builtin_shufflevector(p[kb], p[kb], 8, 9, 10, 11, 12, 13, 14, 15);
    const f4 b = __builtin_shufflevector(a, a, 0, 1, 2, 3) + __builtin_shufflevector(a, a, 4, 5, 6, 7);
    lsum += (b[0] + b[1]) + (b[2] + b[3]); }
#pragma unroll
  for (int jj = 0; jj < 2; ++jj) { u32x4 w = {cvtpk(p[kb][8 * jj + 0], p[kb][8 * jj + 1]), cvtpk(p[kb][8 * jj + 2], p[kb][8 * jj + 3]), cvtpk(p[kb][8 * jj + 4], p[kb][8 * jj + 5]), cvtpk(p[kb][8 * jj + 6], p[kb][8 * jj + 7])};
    pa[2 * kb + jj] = *reinterpret_cast<bf16x8*>(&w); }
}
template <bool WITH_QK, bool WITH_PV, bool PREF>
__device__ __forceinline__ void mblock32(f32x16b (&p)[2], f32x16b (&oT)[4], const bf16x8 (&kpf)[8], int kx, int vx, const bf16x8 (&qr)[8], const bf16x8 (&pa)[4], const f32x16b& cinit) {
  bf16x8 kf[4][4];
  bf16x8 vf[4][4];
  SBAR();
  if (PP_PRIO == 2) __builtin_amdgcn_s_setprio(1);
#define K_RD(G) do { const int a0_ = kx ^ (64 * (G)), a1_ = kx ^ (64 * (G) + 32); kf[G][0] = lds_rd128<0>(a0_); kf[G][1] = lds_rd128<8192>(a0_); kf[G][2] = lds_rd128<0>(a1_); kf[G][3] = lds_rd128<8192>(a1_); } while (0)
#define QK_STEP(G) do { p[0] = MF32(kf[G][0], qr[2 * (G)], (G) == 0 ? cinit : p[0]); p[1] = MF32(kf[G][1], qr[2 * (G)], (G) == 0 ? cinit : p[1]); p[0] = MF32(kf[G][2], qr[2 * (G) + 1], p[0]); p[1] = MF32(kf[G][3], qr[2 * (G) + 1], p[1]); SBAR(); } while (0)
#define V_RD(js) do { const int a_ = vx ^ (32 * (js)); vf[js][0] = lds_rd128<0>(a_); vf[js][1] = lds_rd128<4096>(a_); vf[js][2] = lds_rd128<8192>(a_); vf[js][3] = lds_rd128<12288>(a_); } while (0)
#define PV_STEP(js) do { _Pragma("unroll") for (int db = 0; db < 4; ++db) oT[db] = MF32(vf[js][db], pa[js], oT[db]); SBAR(); } while (0)
  if constexpr (WITH_QK && WITH_PV) {
    if constexpr (PREF) {
#pragma unroll
      for (int i = 0; i < 4; ++i) { kf[0][i] = kpf[i]; kf[1][i] = kpf[4 + i]; }
      K_RD(2); K_RD(3);
      QK_STEP(0);
      V_RD(0); QK_STEP(1);
      V_RD(1); LGKM_WAIT(12); QK_STEP(2);
      V_RD(2); LGKM_WAIT(12); QK_STEP(3);
      V_RD(3); LGKM_WAIT(12); PV_STEP(0);
      LGKM_WAIT(8); PV_STEP(1);
      LGKM_WAIT(4); PV_STEP(2);
      LGKM_WAIT(0); PV_STEP(3);
    } else {
      K_RD(0); K_RD(1); K_RD(2); K_RD(3);
      LGKM_WAIT(12); QK_STEP(0);
      V_RD(0); LGKM_WAIT(12); QK_STEP(1);
      V_RD(1); LGKM_WAIT(12); QK_STEP(2);
      V_RD(2); LGKM_WAIT(12); QK_STEP(3);
      V_RD(3); LGKM_WAIT(12); PV_STEP(0);
      LGKM_WAIT(8); PV_STEP(1);
      LGKM_WAIT(4); PV_STEP(2);
      LGKM_WAIT(0); PV_STEP(3);
    }
  } else if constexpr (WITH_QK) {
    K_RD(0); K_RD(1); K_RD(2); K_RD(3);
    LGKM_WAIT(12); QK_STEP(0); LGKM_WAIT(8); QK_STEP(1); LGKM_WAIT(4); QK_STEP(2); LGKM_WAIT(0); QK_STEP(3);
  } else {
    LGKM_WAIT(0);
    V_RD(0); V_RD(1); V_RD(2); V_RD(3);
    LGKM_WAIT(12); PV_STEP(0); LGKM_WAIT(8); PV_STEP(1); LGKM_WAIT(4); PV_STEP(2); LGKM_WAIT(0); PV_STEP(3);
  }
  if (PP_PRIO == 2) __builtin_amdgcn_s_setprio(0);
#undef K_RD
#undef QK_STEP
#undef V_RD
#undef PV_STEP
}
__device__ __forceinline__ void attn_pp32_body(const bf16* __restrict__ Qb, const bf16* __restrict__ Kh, const bf16* __restrict__ Vh, bf16* __restrict__ Ob, int seq, lds_ptr lds3) {
  char* lds = (char*)lds3;
  int tid = threadIdx.x; asm volatile("" : "+v"(tid));
  const int wid = __builtin_amdgcn_readfirstlane(tid >> 6), lane = tid & 63, r32 = lane & 31, hi = lane >> 5;
  const bool trailing = wid >= 4;
  constexpr int RDS = 4;
  int koff0, voff0;
  { const int row = 8 * wid + (lane >> 4), ch = (lane & 15) ^ (row & 15); koff0 = row * LDK + ch * 8; voff0 = 1024 * wid + 8 * lane; }
#define DMA_K(t, slot) do { _Pragma("unroll") for (int i_ = 0; i_ < 2; ++i_) __builtin_amdgcn_global_load_lds((const __attribute__((address_space(1))) unsigned*)(Kh + (long)(t) * (KVBLK * LDK) + (i_ ? (koff0 ^ 32) + 512 : koff0)), \
      (__attribute__((address_space(3))) unsigned*)(lds3 + (slot) * (int)SHM_K + (2 * wid + i_) * 1024), 16, 0, 0); } while (0)
#define DMA_V(t, slot) do { _Pragma("unroll") for (int i_ = 0; i_ < 2; ++i_) __builtin_amdgcn_global_load_lds((const __attribute__((address_space(1))) unsigned*)(Vh + (long)(t) * (KVBLK * LDK) + voff0 + 512 * i_), \
      (__attribute__((address_space(3))) unsigned*)(lds3 + RDS * (int)SHM_K + (slot) * (int)SHM_V + (2 * wid + i_) * 1024), 16, 0, 0); } while (0)
#define BLOCK_END_M() do { asm volatile("s_waitcnt vmcnt(0) lgkmcnt(0)" ::: "memory"); SBAR(); __builtin_amdgcn_s_barrier(); asm volatile("" ::: "memory"); SBAR(); } while (0)
#define BLOCK_END_V() do { asm volatile("s_waitcnt lgkmcnt(0)" ::: "memory"); asm volatile("" :: "v"(kpf[0]), "v"(kpf[1]), "v"(kpf[2]), "v"(kpf[3])); asm volatile("" :: "v"(kpf[4]), "v"(kpf[5]), "v"(kpf[6]), "v"(kpf[7]));     SBAR(); __builtin_amdgcn_s_barrier(); asm volatile("" ::: "memory"); SBAR(); } while (0)
#define RESC32() do { if (__any(alpha < 1.f)) { _Pragma("unroll") for (int db = 0; db < 4; ++db) { _Pragma("unroll") for (int i = 0; i < 16; ++i) oT[db][i] *= alpha; } } } while (0)
  const int NT = seq / KVBLK;
  DMA_K(0, 0); DMA_V(0, 0); DMA_K(1, 1); DMA_V(1, 1); DMA_K(2, 2);
  bf16x8 qr[8];
  { const bf16* Qw = Qb + (long)(wid * QBLK + r32) * LDQ + hi * 8;
#pragma unroll
    for (int ks = 0; ks < 8; ++ks) qr[ks] = *reinterpret_cast<const bf16x8*>(Qw + ks * 16); }
  const int lds0 = (int)(uintptr_t)lds;
  const int kad0 = lds0 + r32 * 256 + ((hi ^ (r32 & 15)) << 4);
  const int vad0 = lds0 + RDS * (int)SHM_K + r32 * 128 + ((hi ^ ((r32 >> 1) & 7)) << 4);
  bf16x8 kpf[8];
#define LDS_B8(p_) (*(const __attribute__((address_space(3))) bf16x8*)(unsigned)(p_))
#define K_PREF(slot) do { SBAR(); const int a_ = kad0 + (slot) * (int)SHM_K; kpf[0] = LDS_B8(a_); kpf[1] = LDS_B8(a_ + 8192); kpf[2] = LDS_B8(a_ ^ 32); kpf[3] = LDS_B8((a_ ^ 32) + 8192); SBAR(); } while (0)
#define K_PREF1(slot) do { SBAR(); const int b_ = (kad0 + (slot) * (int)SHM_K) ^ 64; kpf[4] = LDS_B8(b_); kpf[5] = LDS_B8(b_ + 8192); kpf[6] = LDS_B8(b_ ^ 32); kpf[7] = LDS_B8((b_ ^ 32) + 8192); SBAR(); } while (0)
  f32x16b s[2]; float alpha = 1.f, lsum = 0.f; bf16x8 pa[4];
  asm volatile("s_waitcnt vmcnt(0)" ::: "memory"); __builtin_amdgcn_s_barrier(); asm volatile("" ::: "memory");
  if (trailing) { __builtin_amdgcn_s_barrier(); asm volatile("" ::: "memory"); }
  f32x16b oT[4];
  f32x16b negm;
  { float z_ = 0.f; asm volatile("" : "+v"(z_));
#pragma unroll
    for (int i = 0; i < 16; ++i) negm[i] = z_;
#pragma unroll
    for (int db = 0; db < 4; ++db) oT[db] = negm;
    asm volatile("" : "+v"(negm)); }
  pa[0] = qr[0]; pa[1] = qr[0]; pa[2] = qr[0]; pa[3] = qr[0];
  mblock32<true, false, false>(s, oT, kpf, kad0, vad0, qr, pa, negm);
  BLOCK_END_M();
  DMA_K(3, 3); DMA_V(2, 2);
  K_PREF(1);
  softmax32_head(s, alpha, negm, true); softmax32_kb<0>(s, lsum, pa); K_PREF1(1); softmax32_kb<1>(s, lsum, pa);
  BLOCK_END_V();
  int sk = 1, sv = 0;
  for (int t = 1; t < NT; ++t) {
    { f32x16b q[2];
      mblock32<true, true, true>(q, oT, kpf, kad0 + sk * (int)SHM_K, vad0 + sv * (int)SHM_V, qr, pa, negm);
      BLOCK_END_M();
      const int skn = (sk == RDS - 1) ? 0 : sk + 1;
      K_PREF(skn);
      { const int tk_ = (t + 3 < NT) ? t + 3 : NT - 1, tv_ = (t + 2 < NT) ? t + 2 : NT - 1; const int sk2_ = (sk == 0) ? RDS - 1 : sk - 1, sv2_ = (sv == 0) ? RDS - 1 : sv - 1; DMA_K(tk_, sk2_); DMA_V(tv_, sv2_); }
      softmax32_head(q, alpha, negm, false); lsum *= alpha; softmax32_kb<0>(q, lsum, pa); K_PREF1(skn); softmax32_kb<1>(q, lsum, pa);
      RESC32();
      BLOCK_END_V(); }
    sk = (sk == RDS - 1) ? 0 : sk + 1; sv = (sv == RDS - 1) ? 0 : sv + 1;
  }
  asm volatile("s_waitcnt vmcnt(0)" ::: "memory");
  mblock32<false, true, false>(s, oT, kpf, kad0, vad0 + sv * (int)SHM_V, qr, pa, negm);
  BLOCK_END_V();
  if (!trailing) { __builtin_amdgcn_s_barrier(); asm volatile("" ::: "memory"); }
  { auto rr = __builtin_amdgcn_permlane32_swap(__float_as_uint(lsum), __float_as_uint(lsum), false, false); lsum = __uint_as_float(rr[0]) + __uint_as_float(rr[1]); }
  const float rli = __builtin_amdgcn_rcpf(lsum);
  { constexpr int PITCH = 272;
    char* stg = lds + wid * (32 * PITCH);
#pragma unroll
    for (int db = 0; db < 4; ++db)
#pragma unroll
      for (int i4 = 0; i4 < 4; ++i4) { const unsigned w0 = cvtpk(oT[db][4 * i4 + 0] * rli, oT[db][4 * i4 + 1] * rli), w1 = cvtpk(oT[db][4 * i4 + 2] * rli, oT[db][4 * i4 + 3] * rli);
        uint2 w; w.x = w0; w.y = w1; *(uint2*)(stg + r32 * PITCH + (32 * db + 8 * i4 + 4 * hi) * 2) = w; }
    asm volatile("s_waitcnt lgkmcnt(0)" ::: "memory");
    bf16* Ow = Ob + (long)(wid * QBLK) * LDO;
#pragma unroll
    for (int i = 0; i < 8; ++i) { const int row = i * 4 + (lane >> 4), ch = lane & 15;
      const u32x4 v = *(const u32x4*)(stg + row * PITCH + ch * 16);
      *(u32x4*)(Ow + (long)row * LDO + ch * 8) = v; } }
#undef DMA_K
#undef DMA_V
#undef RESC32
#undef K_PREF
#undef K_PREF1
#undef LDS_B8
#undef BLOCK_END_M
#undef BLOCK_END_V
#undef LGKM_WAIT
#undef MF32
}
}

constexpr int NWAVES = 8;
constexpr int N_PHASES = 1 + 8 * NLAYER;

constexpr size_t MiB = 1u << 20;
constexpr size_t WS_CTL = 0, CTL_ZERO_BYTES = 1 * MiB;
constexpr size_t SZ_WIN = (size_t)NIN * DM * 2, SZ_WOUT = (size_t)DM * DM * 2, SZ_WGU = (size_t)NGU * DM * 2, SZ_WDN = (size_t)DM * DFF * 2;
constexpr size_t SZ_WLAYER = SZ_WIN + SZ_WOUT + SZ_WGU + SZ_WDN;
constexpr size_t WS_W0 = 2 * MiB;
constexpr size_t WS_H = WS_W0 + NLAYER * SZ_WLAYER;
constexpr size_t SZ_ACT = (size_t)M_TOK * DM * 2;
constexpr size_t WS_PRE = WS_H + SZ_ACT;
constexpr size_t WS_PROJ = WS_PRE + SZ_ACT;
constexpr size_t WS_MIX = WS_PROJ + (size_t)M_TOK * NIN * 2;
constexpr size_t WS_HID = WS_PROJ;
constexpr size_t WS_KC = WS_MIX + SZ_ACT, SZ_KV = (size_t)NKVH * M_TOK * HD * 2;
constexpr size_t WS_VC = WS_KC + SZ_KV;
constexpr size_t WS_END = WS_VC + SZ_KV;
static_assert(WS_HID + (size_t)M_TOK * DFF * 2 <= WS_KC, "hidden overlay fits proj|mix");
static_assert(SZ_WIN % MiB == 0 && SZ_WOUT % MiB == 0 && SZ_WGU % MiB == 0 && SZ_WDN % MiB == 0, "weight copies MiB-aligned");
constexpr int CW_TMO = 0, CW_CODE = 1;
constexpr int CW_ATTQ = 16384;
constexpr int CW_BAR = 4096;

constexpr int RING_OFF = 0, RING_BYTES = 131072;
constexpr int LDSCTL_OFF = RING_BYTES, MISC_OFF = LDSCTL_OFF + 320;
constexpr int LDS_BYTES = 147456;
static_assert(MISC_OFF + 128 <= LDS_BYTES, "LDS map");

#define GAS __attribute__((address_space(1)))
#define LAS __attribute__((address_space(3)))
typedef unsigned short bf16;
typedef unsigned v4u __attribute__((ext_vector_type(4)));
typedef float f32x4 __attribute__((ext_vector_type(4)));
typedef short bf16x8 __attribute__((ext_vector_type(8)));
typedef GAS unsigned gu32;
typedef GAS unsigned long long gu64;
#define RLX_AGENT __ATOMIC_RELAXED, __HIP_MEMORY_SCOPE_AGENT
#define LDS_WAIT() asm volatile("s_waitcnt lgkmcnt(0)" ::: "memory")
#define VM_WAIT() asm volatile("s_waitcnt vmcnt(0)" ::: "memory")
__device__ __forceinline__ unsigned long long rt() { return __builtin_amdgcn_s_memrealtime(); }
__device__ __forceinline__ unsigned f2bf(float f) { unsigned u = __builtin_bit_cast(unsigned, f); return (u + 0x7fffu + ((u >> 16) & 1u)) >> 16; }
__device__ __forceinline__ unsigned pk2(float lo, float hi) { return f2bf(lo) | (f2bf(hi) << 16); }
#define XB_TMO      128
#define XB_XCNT(j)  (256  + 64 * (j))
#define XB_XSUB(j)  (1280 + 64 * (j))
#define XB_XGEN(j)  (2304 + 64 * (j))
#define XB_TOP      3328
#define XB_TOPGEN   3392
#define XCD_BAR_WORDS 3456
#define XB_SPIN_CAP (1u << 18)

__device__ __forceinline__ unsigned xb_ld(unsigned* p)              { return __hip_atomic_load(p, __ATOMIC_RELAXED, __HIP_MEMORY_SCOPE_AGENT); }
__device__ __forceinline__ unsigned xb_add(unsigned* p, unsigned v) { return __hip_atomic_fetch_add(p, v, __ATOMIC_RELAXED, __HIP_MEMORY_SCOPE_AGENT); }
__device__ __forceinline__ unsigned xb_xcc_id() { return (unsigned)__builtin_amdgcn_s_getreg((3 << 11) | 20) & 0xFu; }
#define XB_SPIN(cond, bar) do { unsigned _sp = 0; while (cond) { __builtin_amdgcn_s_sleep(1); \
    if ((++_sp & 255u) == 0u) { if (xb_ld(&(bar)[XB_TMO])) break; if (_sp > XB_SPIN_CAP) { atomicAdd(&(bar)[XB_TMO], 1u); break; } } } } while (0)

struct XcdBarrier {
    unsigned* bar; unsigned x;
    volatile LAS unsigned* st;
};

__device__ __forceinline__ XcdBarrier xcd_barrier_post(unsigned* bar, volatile LAS unsigned* st) {
    XcdBarrier b; b.bar = bar; b.x = xb_xcc_id(); b.st = st;
    if (threadIdx.x == 0) (void)xb_add(&bar[XB_XCNT(b.x)], 1u);
    return b;
}
__device__ __forceinline__ void xcd_barrier_complete(unsigned* bar, unsigned x, unsigned& nloc, unsigned& nx) {
    const unsigned G = gridDim.x * gridDim.y * gridDim.z;
    unsigned sum, cnt, mine, sp = 0u;
    for (;;) {
        sum = 0u; cnt = 0u; mine = 0u;
#pragma unroll
        for (unsigned j = 0; j < 16; ++j) { const unsigned c = xb_ld(&bar[XB_XCNT(j)]); sum += c; cnt += (c > 0u) ? 1u : 0u; mine = (j == x) ? c : mine; }
        if (sum == G) break;
        __builtin_amdgcn_s_sleep(1);
        if ((++sp & 255u) == 0u) { if (xb_ld(&bar[XB_TMO])) break; if (sp > XB_SPIN_CAP) { atomicAdd(&bar[XB_TMO], 1u); break; } }
    }
    nloc = mine > 0u ? mine : 1u; nx = cnt > 0u ? cnt : 1u;
}

__device__ __forceinline__ void xcd_barrier(const XcdBarrier& b) {
    asm volatile("s_waitcnt vmcnt(0)" ::: "memory");
    __syncthreads();
    if (threadIdx.x == 0) {
        unsigned* bar = b.bar;
        __builtin_amdgcn_s_waitcnt(0);
        unsigned nloc = b.st[0], nx = b.st[1];
        if (nloc == 0u) { xcd_barrier_complete(bar, b.x, nloc, nx); b.st[0] = nloc; b.st[1] = nx; }
        const unsigned old = xb_add(&bar[XB_XSUB(b.x)], 1u);
        const unsigned gen = old / nloc;
        if (old + 1u == (gen + 1u) * nloc) {
            __builtin_amdgcn_fence(__ATOMIC_RELEASE, "agent");
            asm volatile("s_waitcnt vmcnt(0)" ::: "memory");
            const unsigned og = xb_add(&bar[XB_TOP], 1u);
            const unsigned tg = og / nx;
            if (og + 1u == (tg + 1u) * nx) xb_add(&bar[XB_TOPGEN], 1u);
            else XB_SPIN(xb_ld(&bar[XB_TOPGEN]) == tg, bar);
            __builtin_amdgcn_fence(__ATOMIC_ACQUIRE, "agent");
            xb_add(&bar[XB_XGEN(b.x)], 1u);
            asm volatile("s_waitcnt vmcnt(0)" ::: "memory");
        } else {
            XB_SPIN(xb_ld(&bar[XB_XGEN(b.x)]) == gen, bar);
            __builtin_amdgcn_fence(__ATOMIC_ACQUIRE, "agent");
            asm volatile("s_waitcnt vmcnt(0)" ::: "memory");
        }
    }
    __syncthreads();
}

struct Frame {
    LAS unsigned char* lds;
    volatile LAS unsigned* MISC;
    gu32* ctl;
    int tid, lane, wave;
    int vcu, G;
};
typedef unsigned v2u __attribute__((ext_vector_type(2)));

__device__ __forceinline__ float wave_sum(float v) {
#pragma unroll
    for (int o = 1; o < 64; o <<= 1) v += __shfl_xor(v, o);
    return v;
}
__device__ __forceinline__ float bf_lo(unsigned w) { return __uint_as_float(w << 16); }
__device__ __forceinline__ float bf_hi(unsigned w) { return __uint_as_float(w & 0xffff0000u); }
__device__ __forceinline__ unsigned pkbf(float lo, float hi) { return pg8::cvt_pk_bf16(lo, hi); }
__device__ __forceinline__ void seq_of(int m, int& s0, int& slen) { if (m < SEQ_P) { s0 = 0; slen = SEQ_P; } else { s0 = SEQ_P + ((m - SEQ_P) / SEQ_S) * SEQ_S; slen = SEQ_S; } }
__device__ __forceinline__ const float* xin_row(const float* xp, const float* xs, int m) { return m < SEQ_P ? xp + (size_t)m * DM : xs + (size_t)(m - SEQ_P) * DM; }

struct TrItem { const GAS float* src; int ldw; bf16* dst; int ldo; };
__device__ __forceinline__ void tr_load(float (&t)[32], const TrItem& I, int lane) {
    const GAS float* src = I.src + (size_t)(lane >> 5) * I.ldw + (lane & 31);
#pragma unroll
    for (int i = 0; i < 32; ++i) t[i] = __builtin_nontemporal_load(src + (size_t)(2 * i) * I.ldw);
}
__device__ __forceinline__ void tr_store(const float (&t)[32], const TrItem& I, LAS float* scr, int lane) {
#pragma unroll
    for (int i = 0; i < 32; ++i) scr[(2 * i + (lane >> 5)) * 33 + (lane & 31)] = t[i];
    LDS_WAIT(); asm volatile("" ::: "memory");
    const int c = lane & 7;
#pragma unroll
    for (int j = 0; j < 4; ++j) { const int n = (lane >> 3) + 8 * j; const LAS float* s = scr + (8 * c) * 33 + n;
        v4u o; o.x = pkbf(s[0 * 33], s[1 * 33]); o.y = pkbf(s[2 * 33], s[3 * 33]); o.z = pkbf(s[4 * 33], s[5 * 33]); o.w = pkbf(s[6 * 33], s[7 * 33]);
        if (TR_NT_STORE) __builtin_nontemporal_store(o, (GAS v4u*)(I.dst + (size_t)n * I.ldo + 8 * c)); else *(GAS v4u*)(I.dst + (size_t)n * I.ldo + 8 * c) = o; }
    LDS_WAIT(); asm volatile("" ::: "memory");
}
__device__ __forceinline__ void fold_item(const float* pool_w, const float* pscale, const float* Wout, bf16* WT, int item, int lane) {
    const int nblk = item & 63, cblk = (item >> 6) & 15, g = item >> 10;
    const int n = nblk * 64 + lane, c0 = cblk * 16;
    const float* pw = pool_w + (size_t)g * 65536 + (size_t)c0 * 256;
    const float* sc = pscale + g * 256;
    const GAS float* wo = (const GAS float*)Wout + (size_t)(MX_P + g * 256) * DM + n;
    float acc[16];
#pragma unroll
    for (int cc = 0; cc < 16; ++cc) acc[cc] = 0.f;
    for (int d0 = 0; d0 < 256; d0 += 64) {
        float wv[64];
#pragma unroll
        for (int dd = 0; dd < 64; ++dd) wv[dd] = wo[(size_t)(d0 + dd) * DM];
#pragma unroll
        for (int dd = 0; dd < 64; ++dd) { const float w = wv[dd] * sc[d0 + dd];
#pragma unroll
            for (int cc = 0; cc < 16; ++cc) acc[cc] = fmaf(pw[cc * 256 + d0 + dd], w, acc[cc]); }
    }
    v4u o; o.x = pkbf(acc[0], acc[1]); o.y = pkbf(acc[2], acc[3]); o.z = pkbf(acc[4], acc[5]); o.w = pkbf(acc[6], acc[7]);
    v4u o2; o2.x = pkbf(acc[8], acc[9]); o2.y = pkbf(acc[10], acc[11]); o2.z = pkbf(acc[12], acc[13]); o2.w = pkbf(acc[14], acc[15]);
    GAS v4u* dst = (GAS v4u*)(WT + (size_t)n * DM + MX_P + g * 256 + c0); dst[0] = o; dst[1] = o2;
}
struct LayerW { bf16 *win, *wout, *wgu, *wdn; };
__device__ __forceinline__ LayerW layer_w(unsigned char* ws, int l) { LayerW w; unsigned char* b = ws + WS_W0 + (size_t)l * SZ_WLAYER;
    w.win = (bf16*)b; w.wout = (bf16*)(b + SZ_WIN); w.wgu = (bf16*)(b + SZ_WIN + SZ_WOUT); w.wdn = (bf16*)(b + SZ_WIN + SZ_WOUT + SZ_WGU); return w; }

constexpr int I_IN = (DM / 64) * (NIN / 32), I_OUT = (MX_P / 64) * (DM / 32), I_G = (DM / 64) * (DFF / 32), I_D = (DFF / 64) * (DM / 32), I_FOLD = 4 * 16 * 64;
constexpr int I_TR_LAYER = I_IN + I_OUT + 2 * I_G + I_D;

__device__ __forceinline__ void prenorm_phase(Frame& F, const float* xp, const float* xs, const float* g, bf16* H) {
    LAS f32x4* G1 = (LAS f32x4*)(F.lds + RING_OFF);
    for (int i = F.tid; i < DM / 4; i += NWAVES * 64) G1[i] = ((const GAS f32x4*)g)[i];
    __syncthreads();
    const int gw = F.vcu * NWAVES + F.wave, NGW = F.G * NWAVES;
    for (int m0_ = gw; m0_ < M_TOK * ((PROBE_DUP & 128) ? 2 : 1); m0_ += NGW) { const int m = m0_ % M_TOK;
        const GAS f32x4* xr = (const GAS f32x4*)xin_row(xp, xs, m) + F.lane;
        f32x4 v[16]; float s = 0.f;
#pragma unroll
        for (int j = 0; j < 16; ++j) v[j] = __builtin_nontemporal_load(xr + 64 * j);
#pragma unroll
        for (int j = 0; j < 16; ++j) s += (v[j].x * v[j].x + v[j].y * v[j].y) + (v[j].z * v[j].z + v[j].w * v[j].w);
        const float rstd = 1.0f / sqrtf(wave_sum(s) * (1.f / DM) + RMS_EPS);
        GAS v2u* o8 = (GAS v2u*)(H + (size_t)m * DM) + F.lane;
#pragma unroll
        for (int j = 0; j < 16; ++j) { const f32x4 gg = G1[F.lane + 64 * j]; v2u o; o.x = pkbf(v[j].x * rstd * gg.x, v[j].y * rstd * gg.y); o.y = pkbf(v[j].z * rstd * gg.z, v[j].w * rstd * gg.w); o8[64 * j] = o; }
    }
    __syncthreads();
}
template <int XIN, int XOUT>
__device__ __forceinline__ void resnorm_phase(Frame& F, const float* xp, const float* xs, const bf16* xin16, float* out, bf16* xout16, const bf16* PRE, const float* g1, const float* g2, bf16* H) {
    LAS f32x4* G1 = (LAS f32x4*)(F.lds + RING_OFF); LAS f32x4* G2 = G1 + DM / 4;
    for (int i = F.tid; i < DM / 4; i += NWAVES * 64) { G1[i] = ((const GAS f32x4*)g1)[i]; if (g2) G2[i] = ((const GAS f32x4*)g2)[i]; }
    __syncthreads();
    const int gw = F.vcu * NWAVES + F.wave, NGW = F.G * NWAVES;
    for (int m = gw; m < M_TOK; m += NGW) {
        const GAS v2u* pr = (const GAS v2u*)(PRE + (size_t)m * DM) + F.lane;
        f32x4 v[16]; v2u p[16]; float s = 0.f;
        if (XIN == 0) { const GAS f32x4* xr = (const GAS f32x4*)xin_row(xp, xs, m) + F.lane;
#pragma unroll
            for (int j = 0; j < 16; ++j) { v[j] = xr[64 * j]; p[j] = pr[64 * j]; } }
        else { const GAS v2u* xr = (const GAS v2u*)(xin16 + (size_t)m * DM) + F.lane; v2u xb[16];
#pragma unroll
            for (int j = 0; j < 16; ++j) { xb[j] = xr[64 * j]; p[j] = pr[64 * j]; }
#pragma unroll
            for (int j = 0; j < 16; ++j) { v[j].x = bf_lo(xb[j].x); v[j].y = bf_hi(xb[j].x); v[j].z = bf_lo(xb[j].y); v[j].w = bf_hi(xb[j].y); } }
#pragma unroll
        for (int j = 0; j < 16; ++j) { const float a = bf_lo(p[j].x), b = bf_hi(p[j].x), c = bf_lo(p[j].y), d = bf_hi(p[j].y); s += (a * a + b * b) + (c * c + d * d); }
        const float rstd1 = 1.0f / sqrtf(wave_sum(s) * (1.f / DM) + RMS_EPS);
        GAS f32x4* xo = (GAS f32x4*)(out + (size_t)m * DM) + F.lane;
        GAS v2u* xo16 = (GAS v2u*)(xout16 + (size_t)m * DM) + F.lane;
        float s2 = 0.f;
#pragma unroll
        for (int j = 0; j < 16; ++j) { asm volatile("" ::: "memory"); const f32x4 gg = G1[F.lane + 64 * j];
            v[j].x += bf_lo(p[j].x) * rstd1 * gg.x; v[j].y += bf_hi(p[j].x) * rstd1 * gg.y; v[j].z += bf_lo(p[j].y) * rstd1 * gg.z; v[j].w += bf_hi(p[j].y) * rstd1 * gg.w;
            if (XOUT == 0) xo[64 * j] = v[j];
            else { v2u o; o.x = pkbf(v[j].x, v[j].y); o.y = pkbf(v[j].z, v[j].w); xo16[64 * j] = o;
                   v[j].x = bf_lo(o.x); v[j].y = bf_hi(o.x); v[j].z = bf_lo(o.y); v[j].w = bf_hi(o.y); }
            s2 += (v[j].x * v[j].x + v[j].y * v[j].y) + (v[j].z * v[j].z + v[j].w * v[j].w); }
        if (g2) {
            const float rstd2 = 1.0f / sqrtf(wave_sum(s2) * (1.f / DM) + RMS_EPS);
            GAS v2u* o8 = (GAS v2u*)(H + (size_t)m * DM) + F.lane;
#pragma unroll
            for (int j = 0; j < 16; ++j) { asm volatile("" ::: "memory"); const f32x4 gg = G2[F.lane + 64 * j]; v2u o; o.x = pkbf(v[j].x * rstd2 * gg.x, v[j].y * rstd2 * gg.y); o.y = pkbf(v[j].z * rstd2 * gg.z, v[j].w * rstd2 * gg.w); o8[64 * j] = o; }
        }
    }
    __syncthreads();
}

__device__ __forceinline__ void unpack8(const v4u w, float (&x)[8]) { x[0] = bf_lo(w.x); x[1] = bf_hi(w.x); x[2] = bf_lo(w.y); x[3] = bf_hi(w.y); x[4] = bf_lo(w.z); x[5] = bf_hi(w.z); x[6] = bf_lo(w.w); x[7] = bf_hi(w.w); }
__device__ __forceinline__ v4u pack8(const float (&x)[8]) { v4u o; o.x = pkbf(x[0], x[1]); o.y = pkbf(x[2], x[3]); o.z = pkbf(x[4], x[5]); o.w = pkbf(x[6], x[7]); return o; }
template <int HW> __device__ __forceinline__ void pool_item(const bf16* col, bf16* dst, int m0, int s0, int s1) {
    v2u raw[8 + 2 * HW];
#pragma unroll
    for (int j = 0; j < 8 + 2 * HW; ++j) { const int mm = m0 - HW + j; const bool ok = (mm >= s0) && (mm < s1); raw[j] = *(const GAS v2u*)(col + (size_t)(ok ? mm : m0) * NIN); if (!ok) raw[j] = (v2u){0u, 0u}; }
    float S[4] = {0.f, 0.f, 0.f, 0.f};
#pragma unroll
    for (int j = 0; j < 2 * HW; ++j) { S[0] += bf_lo(raw[j].x); S[1] += bf_hi(raw[j].x); S[2] += bf_lo(raw[j].y); S[3] += bf_hi(raw[j].y); }
#pragma unroll
    for (int i = 0; i < 8; ++i) { const int m = m0 + i;
        const int lo = (m - HW > s0) ? m - HW : s0, hi = (m + HW < s1) ? m + HW : s1;
        const float rc = 1.0f / (float)(hi - lo);
        const v2u c = raw[i + HW];
        v2u o; o.x = pkbf(S[0] * rc - bf_lo(c.x), S[1] * rc - bf_hi(c.x)); o.y = pkbf(S[2] * rc - bf_lo(c.y), S[3] * rc - bf_hi(c.y));
        *(GAS v2u*)(dst + (size_t)m * DM) = o;
        if (i < 7) { const v2u a = raw[i + 2 * HW], b = raw[i];
            S[0] += bf_lo(a.x) - bf_lo(b.x); S[1] += bf_hi(a.x) - bf_hi(b.x); S[2] += bf_lo(a.y) - bf_lo(b.y); S[3] += bf_hi(a.y) - bf_hi(b.y); } }
}
__device__ __forceinline__ void mixer_elem_phase(Frame& F, bf16* PROJ, bf16* MIX, bf16* KC, bf16* VC, const float* qg, const float* kg, const float* conv_w, const int part) {
    const int lane = F.lane;
    const int gw = (part == 1) ? ((int)blockIdx.x - 128) * NWAVES + F.wave : F.vcu * NWAVES + F.wave, NGW = (part == 1) ? 128 * NWAVES : F.G * NWAVES;
    constexpr int NA = M_TOK, NA2 = 4 * (M_TOK / 64), NB = (M_TOK / 8) * 2;
    const int a0 = (part == 2) ? NA * 5 / 8 : 0, a1 = (part == 1) ? NA * 5 / 8 : NA;
    const int a20 = (part == 2) ? NA2 * 5 / 8 : 0, a21 = (part == 1) ? NA2 * 5 / 8 : NA2;
    const int b0 = (part == 2) ? NB * 5 / 8 : 0, b1 = (part == 1) ? NB * 5 / 8 : NB;
    {
        const int s = lane & 15;
        float qgv[8], kgv[8], invf[8];
#pragma unroll
        for (int e = 0; e < 8; ++e) { qgv[e] = qg[8 * s + e]; kgv[e] = kg[8 * s + e]; invf[e] = __builtin_amdgcn_exp2f(-(float)(8 * (s & 3) + e) * (13.287712379549449f / 32.0f)); }
        const float sgn = (s & 4) ? 1.f : -1.f;
        for (int m = a0 + gw; m < a1; m += NGW) {
            int s0, slen; seq_of(m, s0, slen); const int t = m - s0;
            const float pos = (s < 8) ? (float)(t >> 6) : (float)(t & 63);
            float cs[8], sn[8];
#pragma unroll
            for (int e = 0; e < 8; ++e) { float rev = (pos * invf[e]) * 0.15915494309189535f; rev -= floorf(rev); cs[e] = __builtin_amdgcn_cosf(rev); sn[e] = __builtin_amdgcn_sinf(rev); }
            GAS v4u* rowp = (GAS v4u*)(PROJ + (size_t)m * NIN) + lane;
            v4u w[6];
#pragma unroll
            for (int ps = 0; ps < 6; ++ps) w[ps] = rowp[64 * ps];
            const size_t kvoff = ((size_t)(lane >> 4) * M_TOK + m) * HD + 8 * s;
#pragma unroll
            for (int ps = 0; ps < 5; ++ps) {
                float x[8]; unpack8(w[ps], x);
                float ss = 0.f;
#pragma unroll
                for (int e = 0; e < 8; ++e) ss += x[e] * x[e];
                ss += __shfl_xor(ss, 1); ss += __shfl_xor(ss, 2); ss += __shfl_xor(ss, 4); ss += __shfl_xor(ss, 8);
                const float rstd = 1.0f / sqrtf(ss * (1.f / HD) + RMS_EPS);
                float y[8], o[8];
#pragma unroll
                for (int e = 0; e < 8; ++e) y[e] = x[e] * rstd * (ps < 4 ? qgv[e] : kgv[e]);
#pragma unroll
                for (int e = 0; e < 8; ++e) { const float pe = __shfl_xor(y[e], 4); o[e] = y[e] * cs[e] + sgn * pe * sn[e]; if (Q_PRESCALE && ps < 4) o[e] *= 0.088388347648318440f * 1.4426950408889634f; }
                if (ps < 4) rowp[64 * ps] = pack8(o); else *(GAS v4u*)(KC + kvoff) = pack8(o);
            }
            if (!(PP_VT && ATTN_DMA >= 3)) *(GAS v4u*)(VC + kvoff) = w[5];
        }
    }
    if (PP_VT && ATTN_DMA >= 3) {
        for (int it = a20 + gw; it < a21; it += NGW) {
            const int h = it / (M_TOK / 64), tile = it - h * (M_TOK / 64);
            const GAS unsigned short* src = (const GAS unsigned short*)(PROJ + (size_t)(tile * 64) * NIN + C_V + h * HD);
            GAS v4u* dst = (GAS v4u*)(VC + ((size_t)h * M_TOK + tile * 64) * HD);
#pragma unroll 4
            for (int cc = 0; cc < 16; ++cc) {
                const int d = lane + 64 * (cc & 1), cp = cc >> 1, chunk = cp ^ ((d >> 1) & 7), j = chunk >> 2, g = chunk & 3;
                unsigned v[8];
#pragma unroll
                for (int i = 0; i < 8; ++i) { const int key = (ATTN_DMA == 4) ? 32 * (chunk >> 2) + 16 * ((chunk >> 1) & 1) + 8 * (i >> 2) + 4 * (chunk & 1) + (i & 3)
                                                                  : 32 * j + 16 * (i >> 2) + 4 * g + (i & 3); v[i] = src[(size_t)key * NIN + d]; }
                v4u o; o.x = v[0] | (v[1] << 16); o.y = v[2] | (v[3] << 16); o.z = v[4] | (v[5] << 16); o.w = v[6] | (v[7] << 16);
                dst[d * 8 + cp] = o;
            }
        }
    }
    for (int rep_ = 0; rep_ < ((PROBE_DUP & 16) ? 2 : 1); ++rep_) {
    for (int it = b0 + gw; it < b1; it += NGW) {
        const int m0 = (it >> 1) * 8, c0 = (it & 1) * 512 + lane * 8;
        int s0, slen; seq_of(m0, s0, slen); const int s1 = s0 + slen;
        v4u hraw[10], craw[10], braw[8];
#pragma unroll
        for (int j = 0; j < 10; ++j) { const int mm = m0 - 1 + j; const bool ok = (mm >= s0) && (mm < s1); const bf16* r_ = PROJ + (size_t)(ok ? mm : m0) * NIN + c0;
            hraw[j] = *(const GAS v4u*)(r_ + C_CH); craw[j] = *(const GAS v4u*)(r_ + C_CC); if (!ok) { hraw[j] = (v4u){0u, 0u, 0u, 0u}; } }
#pragma unroll
        for (int i = 0; i < 8; ++i) braw[i] = *(const GAS v4u*)(PROJ + (size_t)(m0 + i) * NIN + C_CB + c0);
        float w0[8], w1[8], w2[8];
#pragma unroll
        for (int e = 0; e < 8; ++e) { w0[e] = conv_w[c0 + e]; w1[e] = conv_w[1024 + c0 + e]; w2[e] = conv_w[2048 + c0 + e]; }
        float up[8], uc[8], un[8];
#define MK_U(dst, j) do { float a_[8], b_[8]; unpack8(hraw[j], a_); unpack8(craw[j], b_); _Pragma("unroll") for (int e = 0; e < 8; ++e) dst[e] = a_[e] * b_[e]; } while (0)
        MK_U(up, 0); MK_U(uc, 1);
#pragma unroll
        for (int i = 0; i < 8; ++i) {
            MK_U(un, i + 2);
            float gb[8], o[8]; unpack8(braw[i], gb);
#pragma unroll
            for (int e = 0; e < 8; ++e) { o[e] = gb[e] * (up[e] * w0[e] + uc[e] * w1[e] + un[e] * w2[e]); up[e] = uc[e]; uc[e] = un[e]; }
            *(GAS v4u*)(MIX + (size_t)(m0 + i) * DM + MX_C + c0) = pack8(o); }
#undef MK_U
    }
    if (part != 1) for (int it = gw; it < (M_TOK / 8) * 4; it += NGW) {
        const int m0 = (it >> 2) * 8, g = it & 3;
        int s0, slen; seq_of(m0, s0, slen);
        const bf16* col = PROJ + C_PU + g * 256 + lane * 4; bf16* dst = MIX + MX_P + g * 256 + lane * 4;
        if (g == 0) pool_item<1>(col, dst, m0, s0, s0 + slen); else if (g == 1) pool_item<2>(col, dst, m0, s0, s0 + slen); else if (g == 2) pool_item<4>(col, dst, m0, s0, s0 + slen); else pool_item<8>(col, dst, m0, s0, s0 + slen);
    }
    }
}

__device__ __forceinline__ void attn_phase(Frame& F, const bf16* PROJ, const bf16* KC, const bf16* VC, bf16* MIX, int qbase, const float* qg, const float* kg) {
    bool sumvote;
    { float mq = fmaxf(fabsf(qg[F.lane]), fabsf(qg[F.lane + 64])), mk = fmaxf(fabsf(kg[F.lane]), fabsf(kg[F.lane + 64]));
#pragma unroll
      for (int o = 1; o < 64; o <<= 1) { mq = fmaxf(mq, __shfl_xor(mq, o)); mk = fmaxf(mk, __shfl_xor(mk, o)); }
      sumvote = __builtin_amdgcn_readfirstlane((mq * mk < 3.5f) ? 1 : 0) != 0; }
    const int x = F.vcu >> 5; const bool queued = false;
    volatile LAS int* slot = (volatile LAS int*)(F.lds + RING_OFF + (int)attn128::SHM_ATTN_DMA);
    for (int it = 0;; ++it) {
        int u;
        if (queued) {
            if (F.tid == 0) slot[0] = (int)__hip_atomic_fetch_add(F.ctl + qbase + 64 * x, 1u, RLX_AGENT);
            __syncthreads(); const int k = slot[0]; __syncthreads();
            if (k >= 192) break;
            u = (k >> 5) * 256 + 32 * x + (k & 31);
        } else if (ATT_LASTQ && F.G == 256 && it >= 5) {
            if (F.tid == 0) slot[0] = (int)__hip_atomic_fetch_add(F.ctl + qbase + 64 * x, 1u, RLX_AGENT);
            __syncthreads(); const int k = slot[0]; __syncthreads();
            if (k >= 32) break;
            u = 5 * 256 + 32 * x + k;
        } else if (PROBE_HALF == 2) { if (F.vcu & 1) break; u = (F.vcu >> 1) + it * 128; if (u >= 1536) break; }
        else if (PROBE_HALF == 4) { if (F.vcu & 3) break; u = (F.vcu >> 2) + it * 64; if (u >= 1536) break; }
        else { u = F.vcu + it * F.G; if (u >= 1536) break; }
        int seq, kvh, head, qb;
        if (u < 1024) { const int i = u >> 8, v = u & 255, xx = v >> 5, j = v & 31; seq = 0; kvh = i; qb = 8 * xx + (j & 7); head = kvh * 4 + (j >> 3); }
        else { const int u2 = u - 1024, i = u2 >> 8, v = u2 & 255, xx = v >> 5, j = v & 31, e = i * 8 + xx, sk = e >> 1; seq = 1 + (sk >> 2); kvh = sk & 3; qb = 8 * (e & 1) + (j & 7); head = kvh * 4 + (j >> 3); }
        const int row0 = seq == 0 ? 0 : SEQ_P + (seq - 1) * SEQ_S, slen = seq == 0 ? SEQ_P : SEQ_S;
        const attn128::bf16* Qb = (const attn128::bf16*)(PROJ + (size_t)(row0 + qb * 256) * NIN + C_Q + head * HD);
        const attn128::bf16* Kh = (const attn128::bf16*)(KC + ((size_t)kvh * M_TOK + row0) * HD);
        const attn128::bf16* Vh = (const attn128::bf16*)(VC + ((size_t)kvh * M_TOK + row0) * HD);
        attn128::bf16* Ob = (attn128::bf16*)(MIX + (size_t)(row0 + qb * 256) * DM + MX_A + head * HD);
        #if ATTN_DMA == 2
#if PROBE_CLK == 4 || PROBE_CLK == 5
        if (blockIdx.x == 0 && it == 0 && F.tid == 0) { const unsigned long long c_ = __builtin_amdgcn_s_memtime(), w_ = __builtin_amdgcn_s_memrealtime(); F.MISC[20] = (unsigned)c_; F.MISC[21] = (unsigned)(c_ >> 32); F.MISC[22] = (unsigned)w_; F.MISC[23] = (unsigned)(w_ >> 32); }
#endif
        attn128::attn_pp_body(Qb, Kh, Vh, Ob, slen, F.lds + RING_OFF);
#if PROBE_CLK == 4 || PROBE_CLK == 5
        if (blockIdx.x == 0 && it == 0 && F.tid == 0) { const unsigned long long c_ = __builtin_amdgcn_s_memtime(), w_ = __builtin_amdgcn_s_memrealtime();
            const unsigned long long c0_ = ((unsigned long long)F.MISC[21] << 32) | F.MISC[20], w0_ = ((unsigned long long)F.MISC[23] << 32) | F.MISC[22];
            F.MISC[16] += (PROBE_CLK == 4) ? (unsigned)((c_ - c0_) / 256 / 10)
                                           : (unsigned)((w_ - w0_) * 10 / 256); }
#endif
#elif ATTN_DMA == 4
        attn128::attn_pp32_body(Qb, Kh, Vh, Ob, slen, F.lds + RING_OFF);
#elif ATTN_DMA == 3
        if (PP_SUMVOTE == 2) attn128::attn_pp16_body<true>(Qb, Kh, Vh, Ob, slen, F.lds + RING_OFF); else if (PP_SUMVOTE && sumvote) attn128::attn_pp16_body<true>(Qb, Kh, Vh, Ob, slen, F.lds + RING_OFF); else attn128::attn_pp16_body<false>(Qb, Kh, Vh, Ob, slen, F.lds + RING_OFF);
#elif ATTN_DMA
        attn128::attn_dma_body(Qb, Kh, Vh, Ob, slen, F.lds + RING_OFF);
#else
        attn128::attn_dense_body<attn128::bf16>(Qb, Kh, Vh, Ob, slen, (char*)F.lds + RING_OFF);
#endif
        __syncthreads();
    }
}

struct Args { const float* in[16]; float* out; unsigned char* ws; int ph_lo, ph_hi; };
typedef const __attribute__((address_space(4))) Args* KArgs;
__device__ __forceinline__ KArgs kargs() { KArgs p = (KArgs)__builtin_amdgcn_kernarg_segment_ptr(); asm volatile("" : "+s"(p)); return p; }
enum { I_XP = 0, I_XS, I_LN_MIX_PRE, I_LN_MIX_POST, I_LN_FFN_PRE, I_LN_FFN_POST, I_QN, I_KN, I_WIN, I_CONVW, I_POOLW, I_PSCALE, I_WOUT, I_WGATE, I_WUP, I_WDOWN };
__device__ __forceinline__ Frame make_frame(unsigned char* ws) {
    extern __shared__ __attribute__((aligned(16))) unsigned char lds[];
    Frame F; int t = threadIdx.x; asm volatile("" : "+v"(t));
    F.lds = (LAS unsigned char*)lds; F.MISC = (volatile LAS unsigned*)(F.lds + MISC_OFF); F.ctl = (gu32*)(ws + WS_CTL);
    F.tid = t; F.lane = t & 63; F.wave = __builtin_amdgcn_readfirstlane(t >> 6);
    F.G = gridDim.x; { const int bx = blockIdx.x; F.vcu = (F.G % 8 == 0) ? (bx % 8) * (F.G / 8) + bx / 8 : bx; }
    return F;
}

__device__ __forceinline__ void convert_rest(Frame& F, KArgs ka, unsigned char* ws) {
    LAS float* scr = (LAS float*)(F.lds + RING_OFF + F.wave * 16384);
    const int gw = F.vcu * NWAVES + F.wave, NGW = F.G * NWAVES;
    for (int it = I_IN + gw; it < NLAYER * I_TR_LAYER; it += NGW) {
        const int l = it / I_TR_LAYER; int r = it % I_TR_LAYER; const LayerW W = layer_w(ws, l); TrItem I;
        if (r < I_IN) { const int kb = r / (NIN / 32), nb = r % (NIN / 32); I.src = (const GAS float*)ka->in[I_WIN] + (size_t)l * DM * NIN + (size_t)(64 * kb) * NIN + 32 * nb; I.ldw = NIN; I.dst = W.win + (size_t)(32 * nb) * DM + 64 * kb; I.ldo = DM; }
        else if ((r -= I_IN) < I_OUT) { const int kb = r / (DM / 32), nb = r % (DM / 32); I.src = (const GAS float*)ka->in[I_WOUT] + (size_t)l * DM * DM + (size_t)(64 * kb) * DM + 32 * nb; I.ldw = DM; I.dst = W.wout + (size_t)(32 * nb) * DM + 64 * kb; I.ldo = DM; }
        else if ((r -= I_OUT) < 2 * I_G) { const int up = r >= I_G; if (up) r -= I_G; const int kb = r / (DFF / 32), nb = r % (DFF / 32), n0 = 32 * nb;
            I.src = (const GAS float*)(up ? ka->in[I_WUP] : ka->in[I_WGATE]) + (size_t)l * DM * DFF + (size_t)(64 * kb) * DFF + n0; I.ldw = DFF; I.dst = W.wgu + (size_t)((n0 >> 7) * 256 + (n0 & 127) + (up ? 128 : 0)) * DM + 64 * kb; I.ldo = DM; }
        else { r -= 2 * I_G; const int kb = r / (DM / 32), nb = r % (DM / 32); I.src = (const GAS float*)ka->in[I_WDOWN] + (size_t)l * DFF * DM + (size_t)(64 * kb) * DM + 32 * nb; I.ldw = DM; I.dst = W.wdn + (size_t)(32 * nb) * DFF + 64 * kb; I.ldo = DFF; }
        float t[32]; tr_load(t, I, F.lane); tr_store(t, I, scr, F.lane);
    }
}

#if MK_FUSED
#define GRID_BAR() xcd_barrier(bar)
#else
#define GRID_BAR() do { } while (0)
#endif
#define IN(k) (lo <= (k) && (k) < hi)
#define SEAM(k) do { if (IN((k) + 1)) { GRID_BAR(); if (PROBE_DUP & 32) GRID_BAR(); } } while (0)
#if PROBE_SET || PROBE_STAT || PROBE_CLK >= 4
#define PH_T0() const unsigned long long pt0_ = wall_clock64()
#define PH_T1(type) do { if ((PROBE_SET >> (type)) & 1) { if (F.tid == 0) F.MISC[16] += (unsigned)(wall_clock64() - pt0_); } } while (0)
#else
#define PH_T0() do { } while (0)
#define PH_T1(type) do { } while (0)
#endif
#define PHASE_ENTER() KArgs ka = kargs(); unsigned char* ws = ka->ws; Frame F = make_frame(ws); PH_T0()
template <int L> __device__ __forceinline__ void layer_phases(const int lo, const int hi, const XcdBarrier bar) {
    constexpr int l = L; constexpr int pb = 1 + 8 * l;
    if (IN(pb + 0)) {
        if ((L == 0) && CONV_SPLIT) { if (((blockIdx.x >> 3) & 1) != 0) { KArgs ka1_ = kargs(); unsigned char* ws1_ = ka1_->ws; Frame F1_ = make_frame(ws1_); convert_rest(F1_, ka1_, ws1_); __syncthreads(); } }
        PHASE_ENTER(); const LayerW W = layer_w(ws, l);
#if PROBE_IDLE
        if (l == 1) { const unsigned long long t0_ = wall_clock64(); while (wall_clock64() - t0_ < (unsigned long long)PROBE_IDLE * 10000ull) __builtin_amdgcn_s_sleep(64); __syncthreads(); }
#endif
        pg8::Gemm g{(bf16*)(ws + WS_H), W.win, M_TOK, NIN, DM}; pg8::StaticOrder S; S.init(M_TOK, NIN, F.G, (int)blockIdx.x);
        pg8::EpiBf16 E{(bf16*)(ws + WS_PROJ), NIN};
        if (TAIL_OVL && MK_FUSED && IN(pb + 1) && gridDim.x == 256) {
            { pg8::RangeOrder<0, 10> R; R.S = S;
              pg8::gemm_phase<pg8::EpiBf16, pg8::RangeOrder<0, 10>, GEMM_ALIGN, GEMM_SP2>(F.lds + RING_OFF, g, R, E); }
            GRID_BAR();
            { KArgs kb_ = kargs(); unsigned char* wsb_ = kb_->ws; Frame Fb = make_frame(wsb_);
              if (blockIdx.x < 128) { const LayerW Wb = layer_w(wsb_, l); pg8::Gemm gb{(bf16*)(wsb_ + WS_H), Wb.win, M_TOK, NIN, DM}; pg8::RangeOrder<10, 11> Rb; Rb.S.init(M_TOK, NIN, Fb.G, (int)blockIdx.x);
                  pg8::EpiBf16 Eb{(bf16*)(wsb_ + WS_PROJ), NIN};
                  pg8::gemm_phase<pg8::EpiBf16, pg8::RangeOrder<10, 11>, GEMM_ALIGN, GEMM_SP2>(Fb.lds + RING_OFF, gb, Rb, Eb); }
              else { __syncthreads(); mixer_elem_phase(Fb, (bf16*)(wsb_ + WS_PROJ), (bf16*)(wsb_ + WS_MIX), (bf16*)(wsb_ + WS_KC), (bf16*)(wsb_ + WS_VC), kb_->in[I_QN] + l * HD, kb_->in[I_KN] + l * HD, kb_->in[I_CONVW] + l * 3 * 1024, 1); } }
        } else
        pg8::gemm_phase<pg8::EpiBf16, pg8::StaticOrder, GEMM_ALIGN, GEMM_SP2>(F.lds + RING_OFF, g, S, E);
        if ((L == 0) && CONV_SPLIT) { if (((blockIdx.x >> 3) & 1) == 0) { __syncthreads(); KArgs ka2_ = kargs(); unsigned char* ws2_ = ka2_->ws; Frame F2_ = make_frame(ws2_); convert_rest(F2_, ka2_, ws2_); } }
        if (PROBE_DUP & 1) { __syncthreads(); pg8::gemm_phase<pg8::EpiBf16, pg8::StaticOrder, GEMM_ALIGN, GEMM_SP2>(F.lds + RING_OFF, g, S, E); }
        SEAM(pb + 0); PH_T1(1);
    }
    if (IN(pb + 1)) { PHASE_ENTER();
        mixer_elem_phase(F, (bf16*)(ws + WS_PROJ), (bf16*)(ws + WS_MIX), (bf16*)(ws + WS_KC), (bf16*)(ws + WS_VC), ka->in[I_QN] + l * HD, ka->in[I_KN] + l * HD, ka->in[I_CONVW] + l * 3 * 1024, (TAIL_OVL && MK_FUSED && IN(pb + 0) && gridDim.x == 256) ? 2 : 0); SEAM(pb + 1); PH_T1(2); }
    if (IN(pb + 2)) { PHASE_ENTER();
#if PROBE_CLK == 3
        long long c0_ = 0, w0_ = 0; if (l == 0 && blockIdx.x == 0) { c0_ = clock64(); w0_ = wall_clock64(); }
#endif
        attn_phase(F, (bf16*)(ws + WS_PROJ), (bf16*)(ws + WS_KC), (bf16*)(ws + WS_VC), (bf16*)(ws + WS_MIX), CW_ATTQ + l * 1024, ka->in[I_QN] + l * HD, ka->in[I_KN] + l * HD);
#if PROBE_CLK == 3
        if (l == 0 && blockIdx.x == 0) { const long long dc = clock64() - c0_, dw = wall_clock64() - w0_; const long long ticks = dc * 10000 / dw;
            const long long t0_ = wall_clock64(); while (wall_clock64() - t0_ < ticks) __builtin_amdgcn_s_sleep(32); }
#endif
#if PROBE_STAT
        if (l == 0 && F.tid == 0) __hip_atomic_store(F.ctl + 32768 + blockIdx.x, (unsigned)(wall_clock64() - pt0_), RLX_AGENT);
#endif
        SEAM(pb + 2); PH_T1(3);
#if PROBE_STAT
        if (l == 0 && F.tid == 0 && blockIdx.x == 0) { unsigned mn = 0xffffffffu, mx = 0u; unsigned long long sm = 0ull;
            for (int b = 0; b < (int)gridDim.x; ++b) { const unsigned v = __hip_atomic_load(F.ctl + 32768 + b, RLX_AGENT); mn = v < mn ? v : mn; mx = v > mx ? v : mx; sm += v; }
            F.MISC[16] += (PROBE_STAT == 1) ? (unsigned)(sm / gridDim.x) : (PROBE_STAT == 2) ? mn : mx; }
#endif
    }
    if (IN(pb + 3)) {
        PHASE_ENTER(); const LayerW W = layer_w(ws, l);
        pg8::Gemm g{(bf16*)(ws + WS_MIX), W.wout, M_TOK, DM, DM}; pg8::StaticOrder S; S.init(M_TOK, DM, F.G, (int)blockIdx.x);
        pg8::EpiBf16 E{(bf16*)(ws + WS_PRE), DM};
        pg8::gemm_phase<pg8::EpiBf16, pg8::StaticOrder, GEMM_ALIGN, GEMM_SP2>(F.lds + RING_OFF, g, S, E);
        if (PROBE_DUP & 1) { __syncthreads(); pg8::gemm_phase<pg8::EpiBf16, pg8::StaticOrder, GEMM_ALIGN, GEMM_SP2>(F.lds + RING_OFF, g, S, E); }
        SEAM(pb + 3); PH_T1(4);
    }
    if (IN(pb + 4)) { PHASE_ENTER();
        if (l == 0) resnorm_phase<0, 1>(F, ka->in[I_XP], ka->in[I_XS], nullptr, nullptr, (bf16*)ka->out, (bf16*)(ws + WS_PRE), ka->in[I_LN_MIX_POST] + l * DM, ka->in[I_LN_FFN_PRE] + l * DM, (bf16*)(ws + WS_H));
        else resnorm_phase<1, 1>(F, nullptr, nullptr, (const bf16*)ka->out, nullptr, (bf16*)(ws + WS_W0), (bf16*)(ws + WS_PRE), ka->in[I_LN_MIX_POST] + l * DM, ka->in[I_LN_FFN_PRE] + l * DM, (bf16*)(ws + WS_H)); SEAM(pb + 4); PH_T1(5); }
    if (IN(pb + 5)) {
        PHASE_ENTER(); const LayerW W = layer_w(ws, l);
#if GU_CHUNKED
        pg8::Gemm g{(bf16*)(ws + WS_H), W.wgu, M_TOK, NGU, DM}; pg8::ChunkOrder S; S.init(NGU, (int)blockIdx.x);
#define GU_ORDER pg8::ChunkOrder
#else
        pg8::Gemm g{(bf16*)(ws + WS_H), W.wgu, M_TOK, NGU, DM}; pg8::StaticOrder S; S.init(M_TOK, NGU, PROBE_HALF ? 128 : F.G, (PROBE_HALF && blockIdx.x >= 128) ? (1 << 28) : (int)blockIdx.x);
#define GU_ORDER pg8::StaticOrder
#endif
        pg8::EpiSwiGLU E{(bf16*)(ws + WS_HID), DFF};
#if PROBE_CLK == 1 || PROBE_CLK == 2
        long long c0_ = 0, w0_ = 0; if (l == 0 && blockIdx.x == 0) { c0_ = clock64(); w0_ = wall_clock64(); }
#endif
        pg8::gemm_phase<pg8::EpiSwiGLU, GU_ORDER, GEMM_ALIGN, GEMM_SP2>(F.lds + RING_OFF, g, S, E);
#if PROBE_CLK == 1 || PROBE_CLK == 2
        if (l == 0 && blockIdx.x == 0) { const long long dc = clock64() - c0_, dw = wall_clock64() - w0_;
            const long long ticks = (PROBE_CLK == 1) ? dc * 10000 / dw   : dc * 100 / (33 * 64)  ;
            const long long t0_ = wall_clock64(); while (wall_clock64() - t0_ < ticks) __builtin_amdgcn_s_sleep(32); }
#endif
        if (PROBE_DUP & 1) { __syncthreads(); pg8::gemm_phase<pg8::EpiSwiGLU, GU_ORDER, GEMM_ALIGN, GEMM_SP2>(F.lds + RING_OFF, g, S, E); }
        SEAM(pb + 5); PH_T1(6);
    }
    if (IN(pb + 6)) {
        PHASE_ENTER(); const LayerW W = layer_w(ws, l);
        pg8::Gemm g{(bf16*)(ws + WS_HID), W.wdn, M_TOK, DM, DFF}; pg8::StaticOrder S; S.init(M_TOK, DM, F.G, (int)blockIdx.x);
        pg8::EpiBf16 E{(bf16*)(ws + WS_PRE), DM};
        pg8::gemm_phase<pg8::EpiBf16, pg8::StaticOrder, GEMM_ALIGN, GEMM_SP2>(F.lds + RING_OFF, g, S, E);
        if (PROBE_DUP & 1) { __syncthreads(); pg8::gemm_phase<pg8::EpiBf16, pg8::StaticOrder, GEMM_ALIGN, GEMM_SP2>(F.lds + RING_OFF, g, S, E); }
        SEAM(pb + 6); PH_T1(7);
    }
    if (IN(pb + 7)) { PHASE_ENTER();
        if (l + 1 < NLAYER) resnorm_phase<1, 1>(F, nullptr, nullptr, (const bf16*)ka->out, nullptr, (bf16*)ka->out, (bf16*)(ws + WS_PRE), ka->in[I_LN_FFN_POST] + l * DM, ka->in[I_LN_MIX_PRE] + (l + 1) * DM, (bf16*)(ws + WS_H));
        else resnorm_phase<1, 0>(F, nullptr, nullptr, (const bf16*)(ws + WS_W0), ka->out, nullptr, (bf16*)(ws + WS_PRE), ka->in[I_LN_FFN_POST] + l * DM, nullptr, (bf16*)(ws + WS_H)); SEAM(pb + 7); PH_T1(8); }
}

__global__ void __launch_bounds__(NWAVES * 64, 2) enc_fwd(Args args_unused) {
    int lo, hi;
    XcdBarrier bar;
    { KArgs ka = kargs(); lo = ka->ph_lo; hi = ka->ph_hi; Frame F = make_frame(ka->ws);
      for (int u = F.tid; u < (LDS_BYTES - LDSCTL_OFF) / 4; u += NWAVES * 64) ((LAS unsigned*)(F.lds + LDSCTL_OFF))[u] = 0u;
      __syncthreads();
#if MK_FUSED
      bar = xcd_barrier_post((unsigned*)(F.ctl + CW_BAR), F.MISC + 8);
#else
      bar.bar = nullptr; bar.x = 0; bar.st = nullptr;
#endif
    }

    if (IN(0)) {
        PHASE_ENTER();
        const float *w_in = ka->in[I_WIN], *w_out = ka->in[I_WOUT], *w_gate = ka->in[I_WGATE], *w_up = ka->in[I_WUP], *w_down = ka->in[I_WDOWN];
        LAS float* scr = (LAS float*)(F.lds + RING_OFF + F.wave * 16384);
        const int gw = F.vcu * NWAVES + F.wave, NGW = F.G * NWAVES;
        auto decode = [&](int it) -> TrItem {
            const int l = it / I_TR_LAYER; int r = it % I_TR_LAYER; const LayerW W = layer_w(ws, l); TrItem I;
            if (r < I_IN) { const int kb = r / (NIN / 32), nb = r % (NIN / 32); I.src = (const GAS float*)w_in + (size_t)l * DM * NIN + (size_t)(64 * kb) * NIN + 32 * nb; I.ldw = NIN; I.dst = W.win + (size_t)(32 * nb) * DM + 64 * kb; I.ldo = DM; return I; } r -= I_IN;
            if (r < I_OUT) { const int kb = r / (DM / 32), nb = r % (DM / 32); I.src = (const GAS float*)w_out + (size_t)l * DM * DM + (size_t)(64 * kb) * DM + 32 * nb; I.ldw = DM; I.dst = W.wout + (size_t)(32 * nb) * DM + 64 * kb; I.ldo = DM; return I; } r -= I_OUT;
            if (r < 2 * I_G) { const int up = r >= I_G; if (up) r -= I_G; const int kb = r / (DFF / 32), nb = r % (DFF / 32), n0 = 32 * nb;
                I.src = (const GAS float*)(up ? w_up : w_gate) + (size_t)l * DM * DFF + (size_t)(64 * kb) * DFF + n0; I.ldw = DFF; I.dst = W.wgu + (size_t)((n0 >> 7) * 256 + (n0 & 127) + (up ? 128 : 0)) * DM + 64 * kb; I.ldo = DM; return I; } r -= 2 * I_G;
            { const int kb = r / (DM / 32), nb = r % (DM / 32); I.src = (const GAS float*)w_down + (size_t)l * DFF * DM + (size_t)(64 * kb) * DM + 32 * nb; I.ldw = DM; I.dst = W.wdn + (size_t)(32 * nb) * DFF + 64 * kb; I.ldo = DFF; return I; }
        };
        { constexpr int NTR = CONV_SPLIT ? I_IN : NLAYER * I_TR_LAYER; float tA[32], tB[32]; TrItem a{}, b{};
          if (gw < NTR) { a = decode(gw); tr_load(tA, a, F.lane); }
          for (int it = gw; it < NTR; it += 2 * NGW) {
              const int itb = it + NGW; const bool hb = itb < NTR;
              if (hb) { b = decode(itb); tr_load(tB, b, F.lane); }
              tr_store(tA, a, scr, F.lane);
              const int ita = it + 2 * NGW;
              if (ita < NTR) { a = decode(ita); tr_load(tA, a, F.lane); }
              if (hb) tr_store(tB, b, scr, F.lane);
          } }
        { const float *pool_w = ka->in[I_POOLW], *pool_scale = ka->in[I_PSCALE];
        for (int it0 = gw; it0 < NLAYER * I_FOLD * ((PROBE_DUP & 64) ? 2 : 1); it0 += NGW) { const int it = it0 % (NLAYER * I_FOLD); const int l = it / I_FOLD, r = it % I_FOLD; const LayerW W = layer_w(ws, l);
            fold_item(pool_w + (size_t)l * 4 * 65536, pool_scale + l * 1024, w_out + (size_t)l * DM * DM, W.wout, r, F.lane); } }
        __syncthreads();
        prenorm_phase(F, ka->in[I_XP], ka->in[I_XS], ka->in[I_LN_MIX_PRE], (bf16*)(ws + WS_H));
        SEAM(0); PH_T1(0);
    }
    layer_phases<0>(lo, hi, bar);
    layer_phases<1>(lo, hi, bar);
#if PROBE_SET || PROBE_STAT || PROBE_CLK >= 4 || PROBE_SENS >= 6
    if (blockIdx.x == 0 && threadIdx.x == 0) { extern __shared__ __attribute__((aligned(16))) unsigned char lds_[]; const unsigned long long ticks = (unsigned long long)((volatile LAS unsigned*)((LAS unsigned char*)lds_ + MISC_OFF))[16] * PROBE_MULT;
        const unsigned long long t0_ = wall_clock64(); while (wall_clock64() - t0_ < ticks) __builtin_amdgcn_s_sleep(32); }
#endif
}
#undef IN
#undef SEAM

extern "C" void kernel_launch(void* const* d_in, const int* in_sizes, int n_in, void* d_out, int out_size, void* d_ws, size_t ws_size, hipStream_t stream) {
    static int grid = 0;
    if (grid == 0) {
        if (n_in != 16 || in_sizes[0] != SEQ_P * DM || in_sizes[1] != 2 * SEQ_S * DM || out_size != M_TOK * DM || ws_size < WS_END) {
            fprintf(stderr, "kernel_launch: shape mismatch (n_in %d, in0 %d, out %d, ws %zu, need ws >= %zu); nothing launched\n", n_in, n_in > 0 ? in_sizes[0] : -1, out_size, ws_size, (size_t)WS_END); grid = -1; return; }
        int dev = 0, cus = 0, per_cu = 0;
        if (hipGetDevice(&dev) != hipSuccess || hipDeviceGetAttribute(&cus, hipDeviceAttributeMultiprocessorCount, dev) != hipSuccess) { fprintf(stderr, "kernel_launch: device query failed\n"); grid = -1; return; }
        if (hipFuncSetAttribute((const void*)enc_fwd, hipFuncAttributeMaxDynamicSharedMemorySize, LDS_BYTES) != hipSuccess) { fprintf(stderr, "kernel_launch: hipFuncSetAttribute failed\n"); grid = -1; return; }
        if (hipOccupancyMaxActiveBlocksPerMultiprocessor(&per_cu, (const void*)enc_fwd, NWAVES * 64, LDS_BYTES) != hipSuccess || per_cu < 1) {
            fprintf(stderr, "kernel_launch: occupancy query reports %d workgroups per CU; nothing launched\n", per_cu); (void)hipGetLastError(); grid = -1; return; }
        grid = cus;
    }
    if (grid < 0) return;
    if (hipMemsetAsync((char*)d_ws + WS_CTL, 0, CTL_ZERO_BYTES, stream) != hipSuccess) { fprintf(stderr, "kernel_launch: hipMemsetAsync failed\n"); return; }
    Args a{};
    for (int i = 0; i < 16; ++i) a.in[i] = (const float*)d_in[i];
    a.out = (float*)d_out; a.ws = (unsigned char*)d_ws;
#if MK_FUSED
    a.ph_lo = 0; a.ph_hi = N_PHASES;
    hipLaunchKernelGGL(enc_fwd, dim3(grid), dim3(NWAVES * 64), LDS_BYTES, stream, a);
#else
    for (int p = 0; p < N_PHASES; ++p) { a.ph_lo = p; a.ph_hi = p + 1; hipLaunchKernelGGL(enc_fwd, dim3(grid), dim3(NWAVES * 64), LDS_BYTES, stream, a); }
#endif
    const hipError_t le = hipPeekAtLastError();
    if (le != hipSuccess) fprintf(stderr, "kernel_launch: launch failed: %s (grid %d)\n", hipGetErrorName(le), grid);
}
```

```cpp
#include <hip/hip_runtime.h>
#include <hip/hip_bf16.h>
#include <cstdio>
#include <cstdint>

#ifndef MK_FUSED
#define MK_FUSED 1
#endif

#ifndef ATTN_DMA
#define ATTN_DMA 3
#endif
#define ATTN_PIN 0
#define PP_ONEBAR 0
#define PP_V2AHEAD 0
#define PP_RING 4
#define PP_LMFMA 0
#define PP_PREF16 1
#define PP_VT 1
#define PP_VDMA_M 1
#define PP_ONEBAR16 0
#define PP_SUMVOTE 0
#define PP_CVIS 0
#define PP_PRIO 2
#define KSW 15
#define PP_LATEWAIT 0
#define PP_DMALATE 0
#define PP_ALIGN 0
#define PP_NEGM 1
#define Q_PRESCALE (ATTN_DMA >= 2 && PP_NEGM)
#define PP_PREF false
#define TR_NT_STORE 0
#define ATT_LASTQ 0
#define RN_NT 0
#define CONV_SPLIT 0
#define GU_CHUNKED 0
#define TAIL_OVL 0
#define FOLD_MIX 0
#define FOLD_SPLIT 0
#define GEMM_ALIGN false
#define GEMM_SP2 true
#define PROBE_HALF 0
#define PROBE_SENS 0
#ifndef PROBE_DUP
#define PROBE_DUP 0
#endif

#ifndef PROBE_CLK
#define PROBE_CLK 0
#endif

#ifndef PROBE_SET
#define PROBE_SET 0
#endif
#ifndef PROBE_IDLE
#define PROBE_IDLE 0
#endif
#ifndef PROBE_STAT
#define PROBE_STAT 0
#endif
#define PROBE_MULT 2

constexpr int DM = 4096, M_TOK = 24576, SEQ_P = 16384, SEQ_S = 4096, NLAYER = 2;
constexpr int NIN = 7168, DFF = 11008, NGU = 2 * DFF;
constexpr int HD = 128, NQH = 16, NKVH = 4;
constexpr int C_Q = 0, C_K = 2048, C_V = 2560, C_CH = 3072, C_CB = 4096, C_CC = 5120, C_PU = 6144;
constexpr int MX_A = 0, MX_C = 2048, MX_P = 3072;
constexpr float RMS_EPS = 1e-6f;
namespace pg8 {
#define PG8_LAS __attribute__((address_space(3)))
typedef unsigned short bf16_t;
typedef short bf16x8 __attribute__((ext_vector_type(8)));
typedef float f32x4 __attribute__((ext_vector_type(4)));
typedef unsigned u32x4 __attribute__((ext_vector_type(4)));
constexpr int BM = 256, BK = 64, HALF = 128, HTB = HALF * BK * 2  , STAGE_BYTES = 8 * HTB, NXCD = 8, WGM = 4;

__host__ __device__ __forceinline__ int lds_byte(int r, int c) { const int st = (r >> 4) * 2 + (c >> 5), rr = r & 15, cc = c & 31, ob = rr * 64 + cc * 2; return st * 1024 + (ob ^ (((ob >> 9) & 1) << 5)); }
__host__ __device__ __forceinline__ void stage_rc(int b, int& R, int& C) { const int st = b / 1024, sb = b % 1024, swz = sb ^ (((sb >> 9) & 1) << 5); R = (st >> 1) * 16 + swz / 64; C = (st & 1) * 32 + (swz % 64) / 2; }
__host__ __device__ __forceinline__ int perm32(int rho) { const int n = rho >> 4, i = rho & 15; return 8 * (i >> 2) + 4 * n + (i & 3); }

struct Unit { int pm, pn; };
struct Gemm { const bf16_t* A; const bf16_t* Bt; int M, N, K; };

struct StaticOrder {
    int nM, nN, nwg, G, c;
    __host__ __device__ void init(int M, int N, int G_, int c_) { nM = M / BM; nN = N / BM; nwg = nM * nN; G = G_; c = c_; }
    __host__ __device__ bool next(int i, Unit& u) const {
        const long L = (long)i * G + c; if (L >= nwg) return false;
        int wgid = (int)L; { const int q = nwg / NXCD, r = nwg % NXCD, xcd = wgid % NXCD, off = wgid / NXCD; wgid = (xcd < r ? xcd * (q + 1) : r * (q + 1) + (xcd - r) * q) + off; }
        const int nig = WGM * nN, gid = wgid / nig, fm = gid * WGM, gsz = (nM - fm) < WGM ? (nM - fm) : WGM;
        u.pm = fm + ((wgid % nig) % gsz); u.pn = (wgid % nig) / gsz; return true;
    }
    __device__ __forceinline__ void a_ready(const Unit&) const {}
    __device__ __forceinline__ void done(const Unit&) const {}
};

template <int I0, int I1> struct RangeOrder {
    StaticOrder S;
    __host__ __device__ bool next(int i, Unit& u) const { return (i + I0 < I1) && S.next(i + I0, u); }
    __device__ __forceinline__ void a_ready(const Unit&) const {}
    __device__ __forceinline__ void done(const Unit&) const {}
};

__device__ __forceinline__ unsigned cvt_pk_bf16(float lo, float hi) { unsigned r; asm volatile("v_cvt_pk_bf16_f32 %0, %1, %2" : "=v"(r) : "v"(lo), "v"(hi)); return r; }
typedef float f32x2 __attribute__((ext_vector_type(2)));
template <bool NT_STORE> struct EpiBf16T {
    static constexpr bool PERM = true, AFTER_DRAIN = false;
    bf16_t* O; int ldc;
    __device__ __forceinline__ void operator()(const f32x4 (&acc)[2][2][4][2], const Unit& u, int wr, int wc, int fr, int fq) const {
        const int row0 = u.pm * BM + wr * 64 + fr; const int col0 = u.pn * BM + wc * 32 + 8 * fq;
#pragma unroll
        for (int ai = 0; ai < 2; ++ai)
#pragma unroll
            for (int m = 0; m < 4; ++m) { bf16_t* rowp = O + (size_t)(row0 + ai * HALF + m * 16) * ldc + col0;
#pragma unroll
                for (int bj = 0; bj < 2; ++bj) { const f32x4 v0 = acc[ai][bj][m][0], v1 = acc[ai][bj][m][1];
                    u32x4 w; w.x = cvt_pk_bf16(v0[0], v0[1]); w.y = cvt_pk_bf16(v0[2], v0[3]); w.z = cvt_pk_bf16(v1[0], v1[1]); w.w = cvt_pk_bf16(v1[2], v1[3]);
                    if (NT_STORE) __builtin_nontemporal_store(w, (u32x4*)(rowp + bj * HALF)); else *(u32x4*)(rowp + bj * HALF) = w; } }
    }
};
typedef EpiBf16T<false> EpiBf16; typedef EpiBf16T<true> EpiBf16NT;
__device__ __forceinline__ float silu_mul(float g, float u) { const float e = __builtin_amdgcn_exp2f(g * -1.4426950408889634f); return g * __builtin_amdgcn_rcpf(1.0f + e) * u; }
struct EpiSwiGLU {
    static constexpr bool PERM = true, AFTER_DRAIN = false;
    bf16_t* O; int ldc;
    __device__ __forceinline__ void operator()(const f32x4 (&acc)[2][2][4][2], const Unit& u, int wr, int wc, int fr, int fq) const {
        const int row0 = u.pm * BM + wr * 64 + fr; const int col0 = u.pn * HALF + wc * 32 + 8 * fq;
#pragma unroll
        for (int ai = 0; ai < 2; ++ai)
#pragma unroll
            for (int m = 0; m < 4; ++m) { bf16_t* rowp = O + (size_t)(row0 + ai * HALF + m * 16) * ldc + col0;
                const f32x4 g0 = acc[ai][0][m][0], g1 = acc[ai][0][m][1], u0 = acc[ai][1][m][0], u1 = acc[ai][1][m][1];
                u32x4 w; w.x = cvt_pk_bf16(silu_mul(g0[0], u0[0]), silu_mul(g0[1], u0[1])); w.y = cvt_pk_bf16(silu_mul(g0[2], u0[2]), silu_mul(g0[3], u0[3]));
                w.z = cvt_pk_bf16(silu_mul(g1[0], u1[0]), silu_mul(g1[1], u1[1])); w.w = cvt_pk_bf16(silu_mul(g1[2], u1[2]), silu_mul(g1[3], u1[3]));
                *(u32x4*)rowp = w; }
    }
};

struct ChunkOrder {
    int nN, x, r, vr;
    __host__ __device__ void init(int N, int c) { nN = N / BM; x = c & 7; r = c >> 3; vr = (nN - (r >> 2) + 7) / 8; }
    __host__ __device__ bool next(int i, Unit& u) const { const int chunk = i / vr, ri = i - chunk * vr; if (chunk >= 3) return false; u.pm = 32 * chunk + 4 * x + (r & 3); u.pn = 8 * ri + (r >> 2); return true; }
    __device__ __forceinline__ void a_ready(const Unit&) const {}
    __device__ __forceinline__ void done(const Unit&) const {}
};
template <class Epi, class Sched, bool ALIGN_EPI = false, bool SP2 = false>
__device__ __forceinline__ void gemm_phase(PG8_LAS unsigned char* lds, const Gemm g, const Sched& S, const Epi& E) {
    const int tid = threadIdx.x, wid = __builtin_amdgcn_readfirstlane(tid >> 6), lane = tid & 63, wr = wid >> 2, wc = wid & 3, fr = lane & 15, fq = lane >> 4;
    const int K = g.K, nt = K / BK;
    unsigned voffA[2], voffB[2];
#pragma unroll
    for (int i = 0; i < 2; ++i) { int R, C; stage_rc(tid * 16 + i * 8192, R, C); const int Rb = Epi::PERM ? ((R & ~31) + perm32(R & 31)) : R;
        voffA[i] = (unsigned)(R * K + C) * 2u; voffB[i] = (unsigned)(Rb * K + C) * 2u; }
    const size_t kstep = (size_t)(BK * 2);
    const size_t hstep = (size_t)HALF * K * 2;
    const size_t tstep = 2 * hstep;
    const unsigned ldsw = (unsigned)wid * 1024u;
    const int aoff = lds_byte(wr * 64 + fr, fq * 8), boff = lds_byte(wc * 32 + fr, fq * 8);
#define PG8_SA(b, h) (((b) * 2 + (h)) * HTB)
#define PG8_SB(b, h) ((4 + (b) * 2 + (h)) * HTB)
#define PG8_STAGE(bufoff, gbase, voff) do { _Pragma("unroll") for (int _i = 0; _i < 2; ++_i) \
        __builtin_amdgcn_global_load_lds((const unsigned*)((const char*)(gbase) + (voff)[_i]), (PG8_LAS unsigned*)(lds + (bufoff) + ldsw + _i * 8192), 16, 0, 0); } while (0)
#define PG8_LDA(dst, b, h) do { _Pragma("unroll") for (int m = 0; m < 4; ++m) _Pragma("unroll") for (int k = 0; k < 2; ++k) dst[m][k] = *(const PG8_LAS bf16x8*)(lds + PG8_SA(b, h) + aoff + m * 2048 + k * 1024); } while (0)
#define PG8_LDB(dst, b, h) do { _Pragma("unroll") for (int n = 0; n < 2; ++n) _Pragma("unroll") for (int k = 0; k < 2; ++k) dst[n][k] = *(const PG8_LAS bf16x8*)(lds + PG8_SB(b, h) + boff + n * 2048 + k * 1024); } while (0)
#define PG8_MMA(ai, bj, At, Bt) do { __builtin_amdgcn_s_setprio(1); _Pragma("unroll") for (int m = 0; m < 4; ++m) _Pragma("unroll") for (int n = 0; n < 2; ++n) _Pragma("unroll") for (int k = 0; k < 2; ++k) \
        acc[ai][bj][m][n] = __builtin_amdgcn_mfma_f32_16x16x32_bf16(Bt[n][k], At[m][k], acc[ai][bj][m][n], 0, 0, 0); __builtin_amdgcn_s_setprio(0); } while (0)
#define PG8_WAIT_V(n) asm volatile("s_waitcnt vmcnt(" #n ")" ::: "memory")
#define PG8_WAIT_L(n) asm volatile("s_waitcnt lgkmcnt(" #n ")" ::: "memory")
#define PG8_BAR __builtin_amdgcn_s_barrier()
#define PG8_SCHED __builtin_amdgcn_sched_barrier(0)
    Unit cur, nxt; int ui = 0;
    if (!S.next(0, cur)) return;
    f32x4 acc[2][2][4][2];
#pragma unroll
    for (int a = 0; a < 2; ++a)
#pragma unroll
        for (int b = 0; b < 2; ++b)
#pragma unroll
            for (int m = 0; m < 4; ++m)
#pragma unroll
                for (int n = 0; n < 2; ++n) acc[a][b][m][n] = (f32x4){0.f, 0.f, 0.f, 0.f};
    bf16x8 At[4][2], B0[2][2], B1[2][2];
    const char* cA = (const char*)g.A + (size_t)cur.pm * tstep; const char* cB = (const char*)g.Bt + (size_t)cur.pn * tstep;
    S.a_ready(cur);
    if constexpr (SP2) {
        PG8_STAGE(PG8_SB(0, 0), cB, voffB); PG8_STAGE(PG8_SB(0, 1), cB + hstep, voffB); PG8_STAGE(PG8_SA(0, 0), cA, voffA); PG8_STAGE(PG8_SA(0, 1), cA + hstep, voffA);
        if (wr == 1) PG8_BAR;
        PG8_WAIT_V(2); PG8_BAR;
        PG8_STAGE(PG8_SB(1, 0), cB + kstep, voffB); PG8_STAGE(PG8_SA(1, 0), cA + kstep, voffA); PG8_STAGE(PG8_SB(1, 1), cB + hstep + kstep, voffB);
        PG8_WAIT_V(6); PG8_BAR;
    } else {
        PG8_STAGE(PG8_SB(0, 0), cB, voffB); PG8_STAGE(PG8_SA(0, 0), cA, voffA); PG8_STAGE(PG8_SB(0, 1), cB + hstep, voffB); PG8_STAGE(PG8_SA(0, 1), cA + hstep, voffA);
        if (wr == 1) PG8_BAR;
        PG8_WAIT_V(4); PG8_BAR;
        PG8_STAGE(PG8_SB(1, 0), cB + kstep, voffB); PG8_STAGE(PG8_SA(1, 0), cA + kstep, voffA); PG8_STAGE(PG8_SB(1, 1), cB + hstep + kstep, voffB);
        PG8_WAIT_V(6); PG8_BAR;
    }
    for (;;) {
        const bool has_next = S.next(ui + 1, nxt);
        const char* nA = has_next ? (const char*)g.A + (size_t)nxt.pm * tstep : cA; const char* nB = has_next ? (const char*)g.Bt + (size_t)nxt.pn * tstep : cB;
        for (int t = 0; t < nt; t += 2) {
            const bool last = (t == nt - 2);
            const char* a1 = cA + (size_t)(t + 1) * kstep;
            const char* a2 = last ? nA : cA + (size_t)(t + 2) * kstep; const char* b2 = last ? nB : cB + (size_t)(t + 2) * kstep;
            const char* a3 = a2 + kstep; const char* b3 = b2 + kstep;
            if (last && has_next) S.a_ready(nxt);
            if constexpr (SP2) {
            PG8_LDB(B0, 0, 0); PG8_LDB(B1, 0, 1); PG8_SCHED; PG8_LDA(At, 0, 0); PG8_STAGE(PG8_SA(1, 1), a1 + hstep, voffA);
            PG8_WAIT_V(8); PG8_WAIT_L(0); PG8_BAR; PG8_MMA(0, 0, At, B0); PG8_MMA(0, 1, At, B1); PG8_BAR; PG8_SCHED;
            PG8_LDA(At, 0, 1); PG8_STAGE(PG8_SB(0, 0), b2, voffB); PG8_STAGE(PG8_SB(0, 1), b2 + hstep, voffB); PG8_STAGE(PG8_SA(0, 0), a2, voffA);
            PG8_WAIT_V(8); PG8_WAIT_L(0); PG8_BAR; PG8_MMA(1, 0, At, B0); PG8_MMA(1, 1, At, B1); PG8_BAR; PG8_SCHED;
            PG8_LDB(B0, 1, 0); PG8_LDB(B1, 1, 1); PG8_SCHED; PG8_LDA(At, 1, 0); PG8_STAGE(PG8_SA(0, 1), a2 + hstep, voffA);
            PG8_WAIT_V(8); PG8_WAIT_L(0); PG8_BAR; PG8_MMA(0, 0, At, B0); PG8_MMA(0, 1, At, B1); PG8_BAR; PG8_SCHED;
            PG8_LDA(At, 1, 1); PG8_STAGE(PG8_SB(1, 0), b3, voffB); PG8_STAGE(PG8_SB(1, 1), b3 + hstep, voffB); PG8_STAGE(PG8_SA(1, 0), a3, voffA);
            PG8_WAIT_V(8); PG8_WAIT_L(0); PG8_BAR; PG8_MMA(1, 0, At, B0); PG8_MMA(1, 1, At, B1); PG8_BAR; PG8_SCHED;
            } else {
            PG8_LDB(B0, 0, 0); PG8_SCHED; PG8_LDA(At, 0, 0); PG8_STAGE(PG8_SA(1, 1), a1 + hstep, voffA);
            PG8_WAIT_L(8); PG8_BAR; PG8_WAIT_L(0); PG8_MMA(0, 0, At, B0); PG8_BAR; PG8_SCHED;
            PG8_LDB(B1, 0, 1); PG8_STAGE(PG8_SB(0, 0), b2, voffB);
            PG8_BAR; PG8_WAIT_L(0); PG8_MMA(0, 1, At, B1); PG8_BAR;
            PG8_LDA(At, 0, 1); PG8_STAGE(PG8_SA(0, 0), a2, voffA);
            PG8_BAR; PG8_WAIT_L(0); PG8_MMA(1, 0, At, B0); PG8_BAR; PG8_SCHED;
            PG8_STAGE(PG8_SB(0, 1), b2 + hstep, voffB);
            PG8_WAIT_V(6); PG8_BAR; PG8_MMA(1, 1, At, B1); PG8_BAR;
            PG8_LDB(B0, 1, 0); PG8_SCHED; PG8_LDA(At, 1, 0); PG8_STAGE(PG8_SA(0, 1), a2 + hstep, voffA);
            PG8_WAIT_L(8); PG8_BAR; PG8_WAIT_L(0); PG8_MMA(0, 0, At, B0); PG8_BAR; PG8_SCHED;
            PG8_LDB(B1, 1, 1); PG8_STAGE(PG8_SB(1, 0), b3, voffB);
            PG8_BAR; PG8_WAIT_L(0); PG8_MMA(0, 1, At, B1); PG8_BAR;
            PG8_LDA(At, 1, 1); PG8_STAGE(PG8_SA(1, 0), a3, voffA);
            PG8_BAR; PG8_WAIT_L(0); PG8_MMA(1, 0, At, B0); PG8_BAR; PG8_SCHED;
            PG8_STAGE(PG8_SB(1, 1), b3 + hstep, voffB);
            PG8_WAIT_V(6); PG8_BAR; PG8_MMA(1, 1, At, B1); PG8_BAR;
            }
        }
        if constexpr (ALIGN_EPI) { if (wr == 0) PG8_BAR; }
        if constexpr (!Epi::AFTER_DRAIN) { E(acc, cur, wr, wc, fr, fq); S.done(cur); }
        if (!has_next) break;
#pragma unroll
        for (int a = 0; a < 2; ++a)
#pragma unroll
            for (int b = 0; b < 2; ++b)
#pragma unroll
                for (int m = 0; m < 4; ++m)
#pragma unroll
                    for (int n = 0; n < 2; ++n) acc[a][b][m][n] = (f32x4){0.f, 0.f, 0.f, 0.f};
        cur = nxt; cA = nA; cB = nB; ++ui;
        if constexpr (ALIGN_EPI) { if (wr == 1) PG8_BAR; }
    }
    PG8_WAIT_V(0);
    if constexpr (!ALIGN_EPI) { if (wr == 0) PG8_BAR; }
    PG8_BAR;
    if constexpr (Epi::AFTER_DRAIN) { E.fused(acc, cur, wr, wc, fr, fq, lds, wid, lane); S.done(cur); }
#undef PG8_SA
#undef PG8_SB
#undef PG8_STAGE
#undef PG8_LDA
#undef PG8_LDB
#undef PG8_MMA
#undef PG8_WAIT_V
#undef PG8_WAIT_L
#undef PG8_BAR
#undef PG8_SCHED
}
}
namespace attn128 {
using bf16 = __hip_bfloat16;
constexpr int   D = 128, NW = 8, QBLK = 32, KVBLK = 64;
constexpr float SCALE = 0.088388347648318440f;
constexpr float THR = 8.f;
constexpr int SDEPTH = 2;
constexpr int LDQ = NIN, LDK = D, LDO = DM;
constexpr size_t SHM_V = KVBLK * D * 2, SHM_K = KVBLK * D * 2, SHM_ATTN = 2 * SHM_V + 2 * SHM_K + NW * 64 * 4;
using bf16x8 = __attribute__((ext_vector_type(8))) short;
using s16x4  = __attribute__((ext_vector_type(4))) short;
using f32x16 = __attribute__((ext_vector_type(16))) float;
using f32x8  = __attribute__((ext_vector_type(8))) float;
using u32x4  = __attribute__((ext_vector_type(4))) unsigned;
#define KSWZ(row, colB) ((row) * 256 + ((colB) ^ (((row) & 7) << 4)))
#define SBAR() __builtin_amdgcn_sched_barrier(0)
__device__ __forceinline__ int crow(int r, int hi) { return (r & 3) + 8 * (r >> 2) + 4 * hi; }
__device__ __forceinline__ unsigned cvtpk(float lo, float hi) {
  unsigned r; asm volatile("v_cvt_pk_bf16_f32 %0, %1, %2" : "=v"(r) : "v"(lo), "v"(hi)); return r;
}
template <typename TIn> struct Stage;
template <> struct Stage<bf16>  { using T = bf16x8;
  __device__ static __forceinline__ T ld8(const bf16* p) { return *reinterpret_cast<const bf16x8*>(p); }
  __device__ static __forceinline__ bf16x8 tobf(T x) { return x; } };
template <> struct Stage<float> { using T = f32x8;
  __device__ static __forceinline__ T ld8(const float* p) { return *reinterpret_cast<const f32x8*>(p); }
  __device__ static __forceinline__ bf16x8 tobf(T x) {
    u32x4 w = {cvtpk(x[0], x[1]), cvtpk(x[2], x[3]), cvtpk(x[4], x[5]), cvtpk(x[6], x[7])}; return *reinterpret_cast<bf16x8*>(&w); } };

__device__ __forceinline__ void partialSM(f32x16& p0, f32x16& p1, float& m_reg, float& mn, float& alpha) {
  constexpr float C = SCALE * 1.4426950408889634f;
  float pmax = p0[0]; for (int r = 1; r < 16; ++r) pmax = fmaxf(pmax, p0[r]); for (int r = 0; r < 16; ++r) pmax = fmaxf(pmax, p1[r]);
  { auto rr = __builtin_amdgcn_permlane32_swap(__float_as_uint(pmax), __float_as_uint(pmax), false, false);
    pmax = fmaxf(__uint_as_float(rr[0]), __uint_as_float(rr[1])); }
  if (__builtin_expect(__all(pmax - m_reg <= THR / SCALE), 1)) { mn = m_reg; alpha = 1.f; }
  else { mn = fmaxf(m_reg, pmax); alpha = __builtin_amdgcn_exp2f((m_reg - mn) * C); m_reg = mn; }
  float mnC = -mn * C;
  for (int r = 0; r < 16; ++r) p0[r] = fmaf(p0[r], C, mnC); for (int r = 0; r < 16; ++r) p1[r] = fmaf(p1[r], C, mnC);
  for (int r = 0; r < 16; ++r) p0[r] = __builtin_amdgcn_exp2f(p0[r]);
}
__device__ __forceinline__ void finishSM(f32x16& p0, f32x16& p1, float alpha, float& l_reg, bf16x8& pa0, bf16x8& pa1, bf16x8& pa2, bf16x8& pa3) {
  for (int r = 0; r < 16; ++r) p1[r] = __builtin_amdgcn_exp2f(p1[r]);
  float ps = 0; for (int r = 0; r < 16; ++r) ps += p0[r]; for (int r = 0; r < 16; ++r) ps += p1[r];
  { auto rr = __builtin_amdgcn_permlane32_swap(__float_as_uint(ps), __float_as_uint(ps), false, false);
    ps = __uint_as_float(rr[0]) + __uint_as_float(rr[1]); }
  l_reg = l_reg * alpha + ps;
#define PK4(P, BASE, OUT) do { unsigned a0 = cvtpk(P[BASE + 0], P[BASE + 1]), a1 = cvtpk(P[BASE + 2], P[BASE + 3]);   \
    unsigned b0 = cvtpk(P[BASE + 4], P[BASE + 5]), b1 = cvtpk(P[BASE + 6], P[BASE + 7]);                              \
    auto r0 = __builtin_amdgcn_permlane32_swap(a0, b0, false, false); auto r1 = __builtin_amdgcn_permlane32_swap(a1, b1, false, false); \
    u32x4 w = {r0[0], r1[0], r0[1], r1[1]}; OUT = *reinterpret_cast<bf16x8*>(&w); } while (0)
  PK4(p0, 0, pa0); PK4(p0, 8, pa1); PK4(p1, 0, pa2); PK4(p1, 8, pa3);
#undef PK4
}
__device__ __forceinline__ void qkt(f32x16& p0, f32x16& p1, const bf16* Ks, const bf16x8* qr, int r32, int hi) {
  p0 = f32x16{}; p1 = f32x16{};
  for (int d0 = 0; d0 < 8; ++d0) { int cb = (d0 * 16 + hi * 8) * 2;
    bf16x8 b0 = *reinterpret_cast<const bf16x8*>((const char*)Ks + KSWZ(r32, cb));
    bf16x8 b1 = *reinterpret_cast<const bf16x8*>((const char*)Ks + KSWZ(32 + r32, cb));
    p0 = __builtin_amdgcn_mfma_f32_32x32x16_bf16(b0, qr[d0], p0, 0, 0, 0);
    p1 = __builtin_amdgcn_mfma_f32_32x32x16_bf16(b1, qr[d0], p1, 0, 0, 0); }
}
__device__ __forceinline__ int v_st(int k, int c) { const int kk = (k & ~0xC) | ((k & 4) << 1) | ((k & 8) >> 1); return ((kk >> 3) * 4 + (c >> 5)) * 512 + ((kk & 7) * 32 + (c & 31)) * 2; }
__device__ __forceinline__ int v_rd_base(int lane) { return ((lane & 3) << 3) | (((lane >> 2) & 3) << 6) | (((lane >> 4) & 1) << 5) | (((lane >> 5) & 1) << 8); }
constexpr int v_rd_off(int d0, int ks, int half) { return d0 * 512 + ks * 4096 + half * 2048; }
template <int OFF> __device__ __forceinline__ s16x4 tr_read(int vb) {
  s16x4 r; asm volatile("ds_read_b64_tr_b16 %0, %1 offset:%2" : "=&v"(r) : "v"(vb), "i"(OFF) : "memory"); return r;
}
template <int D0> __device__ __forceinline__ void pv_one(f32x16& od, int vb, bf16x8 pa0, bf16x8 pa1, bf16x8 pa2, bf16x8 pa3) {
  const s16x4 l0 = tr_read<v_rd_off(D0, 0, 0)>(vb), h0 = tr_read<v_rd_off(D0, 0, 1)>(vb), l1 = tr_read<v_rd_off(D0, 1, 0)>(vb), h1 = tr_read<v_rd_off(D0, 1, 1)>(vb);
  const s16x4 l2 = tr_read<v_rd_off(D0, 2, 0)>(vb), h2 = tr_read<v_rd_off(D0, 2, 1)>(vb), l3 = tr_read<v_rd_off(D0, 3, 0)>(vb), h3 = tr_read<v_rd_off(D0, 3, 1)>(vb);
  asm volatile("s_waitcnt lgkmcnt(0)" ::: "memory"); SBAR();
#define PK(L, H) (bf16x8){L[0], L[1], L[2], L[3], H[0], H[1], H[2], H[3]}
  od = __builtin_amdgcn_mfma_f32_32x32x16_bf16(pa0, PK(l0, h0), od, 0, 0, 0);
  od = __builtin_amdgcn_mfma_f32_32x32x16_bf16(pa1, PK(l1, h1), od, 0, 0, 0);
  od = __builtin_amdgcn_mfma_f32_32x32x16_bf16(pa2, PK(l2, h2), od, 0, 0, 0);
  od = __builtin_amdgcn_mfma_f32_32x32x16_bf16(pa3, PK(l3, h3), od, 0, 0, 0);
#undef PK
}
__device__ __forceinline__ void pv_d0(f32x16* o, int vb, bf16x8 pa0, bf16x8 pa1, bf16x8 pa2, bf16x8 pa3) {
  pv_one<0>(o[0], vb, pa0, pa1, pa2, pa3); pv_one<1>(o[1], vb, pa0, pa1, pa2, pa3); pv_one<2>(o[2], vb, pa0, pa1, pa2, pa3); pv_one<3>(o[3], vb, pa0, pa1, pa2, pa3);
}

template <typename TQ>
__device__ __forceinline__ void attn_dense_body(const TQ* __restrict__ Qb, const bf16* __restrict__ Kh, const bf16* __restrict__ Vh,
                                                bf16* __restrict__ Ob, int seq, char* lds) {
  using St = Stage<bf16>; using SQ = Stage<TQ>;
  const int tid = threadIdx.x, wid = tid >> 6, lane = tid & 63, r32 = lane & 31, hi = lane >> 5;
  bf16* V_lds = (bf16*)lds; bf16* K_lds = (bf16*)(lds + 2 * SHM_V);
  float* ws = (float*)(lds + 2 * SHM_V + 2 * SHM_K) + wid * 64; float* li_l = ws; float* al_l = ws + 32;
  float m_reg = -1e30f, l_reg = 0; f32x16 o[4] = {}; bf16x8 qr[8];
  const TQ* Qw = Qb + (long)(wid * QBLK + r32) * LDQ + hi * 8;
#pragma unroll
  for (int d0 = 0; d0 < 8; ++d0) qr[d0] = SQ::tobf(SQ::ld8(Qw + d0 * 16));
  const int sr = tid >> 4, sc = (tid & 15) * 8, vst0 = v_st(sr, sc), vst1 = v_st(32 + sr, sc);
  const int vb0 = (int)(uintptr_t)V_lds + v_rd_base(lane);
  struct { typename St::T vs0, vs1, ks0, ks1; } sr_[SDEPTH];
#define SLOAD(i, k0) do { sr_[i].vs0 = St::ld8(&Vh[(long)((k0) + sr) * LDK + sc]); sr_[i].vs1 = St::ld8(&Vh[(long)((k0) + 32 + sr) * LDK + sc]); \
    sr_[i].ks0 = St::ld8(&Kh[(long)((k0) + sr) * LDK + sc]); sr_[i].ks1 = St::ld8(&Kh[(long)((k0) + 32 + sr) * LDK + sc]); } while (0)
#define SWRITE(b, i) do { *(bf16x8*)((char*)V_lds + (b) * SHM_V + vst0) = St::tobf(sr_[i].vs0);          \
    *(bf16x8*)((char*)V_lds + (b) * SHM_V + vst1) = St::tobf(sr_[i].vs1); int kc = sc * 2;               \
    *(bf16x8*)((char*)K_lds + (b) * SHM_K + KSWZ(sr, kc)) = St::tobf(sr_[i].ks0);                       \
    *(bf16x8*)((char*)K_lds + (b) * SHM_K + KSWZ(32 + sr, kc)) = St::tobf(sr_[i].ks1); } while (0)
#define SWAIT() do { if constexpr (SDEPTH == 2) asm volatile("s_waitcnt vmcnt(4)" ::: "memory"); else asm volatile("s_waitcnt vmcnt(0)" ::: "memory"); } while (0)
#define RESC(a) do { if (__any((a) < 1.f)) { if (hi == 0) al_l[r32] = (a); asm volatile("s_waitcnt lgkmcnt(0)" ::: "memory"); \
    for (int d = 0; d < 4; ++d) for (int r = 0; r < 16; ++r) o[d][r] *= al_l[crow(r, hi)]; } } while (0)
  f32x16 pA0, pA1, pB0, pB1; float mnA, mnB, alA, alB; bf16x8 pa0, pa1, pa2, pa3; const int NT = seq / KVBLK;
  constexpr int SE = 0, SO = SDEPTH - 1;
  SLOAD(SE, 0); asm volatile("s_waitcnt vmcnt(0)" ::: "memory"); SWRITE(0, SE); __syncthreads();
  qkt(pA0, pA1, K_lds, qr, r32, hi); partialSM(pA0, pA1, m_reg, mnA, alA);
  SLOAD(SO, KVBLK); if constexpr (SDEPTH == 2) { if (2 < NT) SLOAD(SE, 2 * KVBLK); }
  SWAIT(); SWRITE(1, SO); __syncthreads();
  for (int j = 1; j + 1 < NT; j += 2) {
    SBAR(); qkt(pB0, pB1, (bf16*)((char*)K_lds + SHM_K), qr, r32, hi);
    finishSM(pA0, pA1, alA, l_reg, pa0, pa1, pa2, pa3); SBAR();
    SLOAD(SO, (j + SDEPTH) * KVBLK); SBAR();
    pv_d0(o, vb0, pa0, pa1, pa2, pa3); partialSM(pB0, pB1, m_reg, mnB, alB);
    __syncthreads(); SWAIT(); SWRITE(0, SE);
    RESC(alB); __syncthreads();
    SBAR(); qkt(pA0, pA1, K_lds, qr, r32, hi);
    finishSM(pB0, pB1, alB, l_reg, pa0, pa1, pa2, pa3); SBAR();
    if (SDEPTH == 1 || j + 3 < NT) SLOAD(SE, (j + 1 + SDEPTH) * KVBLK); SBAR();
    pv_d0(o, vb0 + (int)SHM_V, pa0, pa1, pa2, pa3); partialSM(pA0, pA1, m_reg, mnA, alA);
    __syncthreads(); SWAIT(); SWRITE(1, SO);
    RESC(alA); __syncthreads();
  }
  SBAR(); qkt(pB0, pB1, (bf16*)((char*)K_lds + SHM_K), qr, r32, hi);
  finishSM(pA0, pA1, alA, l_reg, pa0, pa1, pa2, pa3); SBAR();
  pv_d0(o, vb0, pa0, pa1, pa2, pa3); partialSM(pB0, pB1, m_reg, mnB, alB);
  __syncthreads(); RESC(alB);
  finishSM(pB0, pB1, alB, l_reg, pa0, pa1, pa2, pa3); SBAR();
  pv_d0(o, vb0 + (int)SHM_V, pa0, pa1, pa2, pa3);
  if (hi == 0) li_l[r32] = l_reg; asm volatile("s_waitcnt lgkmcnt(0)" ::: "memory");
  float rli[16];
#pragma unroll
  for (int r = 0; r < 16; ++r) rli[r] = __builtin_amdgcn_rcpf(li_l[crow(r, hi)]);
  bf16* Ow = Ob + (long)(wid * QBLK) * LDO;
#pragma unroll
  for (int r = 0; r < 16; ++r) { int orow = crow(r, hi);
    for (int d0 = 0; d0 < 4; ++d0) Ow[(long)orow * LDO + d0 * 32 + r32] = __float2bfloat16(o[d0][r] * rli[r]); }
#undef SLOAD
#undef SWRITE
#undef SWAIT
#undef RESC
}

constexpr size_t SHM_ATTN_DMA = 3 * SHM_V + 3 * SHM_K + NW * 64 * 4;
typedef __attribute__((address_space(3))) unsigned char* lds_ptr;
__device__ __forceinline__ void attn_dma_body(const bf16* __restrict__ Qb, const bf16* __restrict__ Kh, const bf16* __restrict__ Vh, bf16* __restrict__ Ob, int seq, lds_ptr lds3) {
  char* lds = (char*)lds3;
  int tid = threadIdx.x; asm volatile("" : "+v"(tid));
  const int wid = __builtin_amdgcn_readfirstlane(tid >> 6), lane = tid & 63, r32 = lane & 31, hi = lane >> 5;
  char* K_lds = lds; char* V_lds = lds + 3 * SHM_K;
  float* ws = (float*)(lds + 3 * SHM_K + 3 * SHM_V) + wid * 64; float* li_l = ws; float* al_l = ws + 32;
  float m_reg = -1e30f, l_reg = 0; bf16x8 qr[8];
  int koff[2], voff[2];
#pragma unroll
  for (int i = 0; i < 2; ++i) { const int w = 2 * wid + i;
    { const int row = 4 * w + (lane >> 4), ch = (lane & 15) ^ (row & 7); koff[i] = row * LDK + ch * 8; }
    { const int s = 2 * w + (lane >> 5), kk = (s >> 2) * 8 + ((lane & 31) >> 2), k = (kk & ~0xC) | ((kk & 4) << 1) | ((kk & 8) >> 1), c = (s & 3) * 32 + 8 * (lane & 3); voff[i] = k * LDK + c; } }
#define DMA_K(t, slot) do { _Pragma("unroll") for (int i_ = 0; i_ < 2; ++i_) __builtin_amdgcn_global_load_lds((const __attribute__((address_space(1))) unsigned*)(Kh + (long)(t) * (KVBLK * LDK) + koff[i_]), \
      (__attribute__((address_space(3))) unsigned*)(lds3 + (slot) * (int)SHM_K + (2 * wid + i_) * 1024), 16, 0, 0); } while (0)
#define DMA_V(t, slot) do { _Pragma("unroll") for (int i_ = 0; i_ < 2; ++i_) __builtin_amdgcn_global_load_lds((const __attribute__((address_space(1))) unsigned*)(Vh + (long)(t) * (KVBLK * LDK) + voff[i_]), \
      (__attribute__((address_space(3))) unsigned*)(lds3 + 3 * (int)SHM_K + (slot) * (int)SHM_V + (2 * wid + i_) * 1024), 16, 0, 0); } while (0)
  const int NT = seq / KVBLK;
  DMA_K(0, 0); DMA_V(0, 0); DMA_K(1, 1);
  const bf16* Qw = Qb + (long)(wid * QBLK + r32) * LDQ + hi * 8;
#pragma unroll
  for (int d0 = 0; d0 < 8; ++d0) qr[d0] = *reinterpret_cast<const bf16x8*>(Qw + d0 * 16);
  const int vb0 = (int)(uintptr_t)V_lds + v_rd_base(lane);
#define RESC(a) do { if (__any((a) < 1.f)) { if (hi == 0) al_l[r32] = (a); asm volatile("s_waitcnt lgkmcnt(0)" ::: "memory"); \
    for (int d = 0; d < 4; ++d) for (int r = 0; r < 16; ++r) o[d][r] *= al_l[crow(r, hi)]; } } while (0)
  f32x16 pA0, pA1, pB0, pB1; float mnA, mnB, alA, alB; bf16x8 pa0, pa1, pa2, pa3;
  asm volatile("s_waitcnt vmcnt(0)" ::: "memory"); __builtin_amdgcn_s_barrier(); asm volatile("" ::: "memory");
  DMA_K(2, 2); DMA_V(1, 1);
  SBAR(); qkt(pA0, pA1, (const bf16*)K_lds, qr, r32, hi); SBAR(); partialSM(pA0, pA1, m_reg, mnA, alA); SBAR();
  f32x16 o[4] = {};
  int sk = 1, sv = 0;
#define STEP(PC0, PC1, MNC, ALC, PP0, PP1, ALP, t) do { \
    asm volatile("s_waitcnt vmcnt(4) lgkmcnt(0)" ::: "memory"); __builtin_amdgcn_s_barrier(); asm volatile("" ::: "memory"); \
    { const int tk_ = ((t) + 2 < NT) ? (t) + 2 : NT - 1, tv_ = ((t) + 1 < NT) ? (t) + 1 : NT - 1; const int sk2_ = (sk == 0) ? 2 : sk - 1, sv2_ = (sv == 0) ? 2 : sv - 1; \
      DMA_K(tk_, sk2_); DMA_V(tv_, sv2_); }     \
    int kb_ = sk * (int)SHM_K; asm volatile("" : "+v"(kb_));     \
    SBAR(); qkt(PC0, PC1, (const bf16*)(K_lds + kb_), qr, r32, hi); \
    finishSM(PP0, PP1, ALP, l_reg, pa0, pa1, pa2, pa3); if (ATTN_PIN) SBAR(); \
    pv_d0(o, vb0 + sv * (int)SHM_V, pa0, pa1, pa2, pa3); partialSM(PC0, PC1, m_reg, MNC, ALC); \
    RESC(ALC); sk = (sk == 2) ? 0 : sk + 1; sv = (sv == 2) ? 0 : sv + 1; } while (0)
  int t = 1;
  for (; t + 1 < NT; t += 2) {
    STEP(pB0, pB1, mnB, alB, pA0, pA1, alA, t);
    STEP(pA0, pA1, mnA, alA, pB0, pB1, alB, t + 1);
  }
  STEP(pB0, pB1, mnB, alB, pA0, pA1, alA, t);
  finishSM(pB0, pB1, alB, l_reg, pa0, pa1, pa2, pa3);
  asm volatile("s_waitcnt vmcnt(0) lgkmcnt(0)" ::: "memory"); __builtin_amdgcn_s_barrier(); asm volatile("" ::: "memory");
  SBAR(); pv_d0(o, vb0 + sv * (int)SHM_V, pa0, pa1, pa2, pa3);
  if (hi == 0) li_l[r32] = l_reg; asm volatile("s_waitcnt lgkmcnt(0)" ::: "memory");
  float rli[16];
#pragma unroll
  for (int r = 0; r < 16; ++r) rli[r] = __builtin_amdgcn_rcpf(li_l[crow(r, hi)]);
  bf16* Ow = Ob + (long)(wid * QBLK) * LDO;
#pragma unroll
  for (int r = 0; r < 16; ++r) { int orow = crow(r, hi);
    for (int d0 = 0; d0 < 4; ++d0) Ow[(long)orow * LDO + d0 * 32 + r32] = __float2bfloat16(o[d0][r] * rli[r]); }
#undef DMA_K
#undef DMA_V
#undef RESC
#undef STEP
}

__device__ __forceinline__ void softmax_tile(f32x16& p0, f32x16& p1, float& m_reg, float& l_reg, float& alpha, bf16x8& pa0, bf16x8& pa1, bf16x8& pa2, bf16x8& pa3) {
  constexpr float C = SCALE * 1.4426950408889634f;
  float pmax = p0[0]; for (int r = 1; r < 16; ++r) pmax = fmaxf(pmax, p0[r]); for (int r = 0; r < 16; ++r) pmax = fmaxf(pmax, p1[r]);
  { auto rr = __builtin_amdgcn_permlane32_swap(__float_as_uint(pmax), __float_as_uint(pmax), false, false);
    pmax = fmaxf(__uint_as_float(rr[0]), __uint_as_float(rr[1])); }
  float mn;
  if (__builtin_expect(__all(pmax - m_reg <= THR / SCALE), 1)) { mn = m_reg; alpha = 1.f; }
  else { mn = fmaxf(m_reg, pmax); alpha = __builtin_amdgcn_exp2f((m_reg - mn) * C); m_reg = mn; }
  const float mnC = -mn * C;
  for (int r = 0; r < 16; ++r) p0[r] = __builtin_amdgcn_exp2f(fmaf(p0[r], C, mnC));
  for (int r = 0; r < 16; ++r) p1[r] = __builtin_amdgcn_exp2f(fmaf(p1[r], C, mnC));
  float ps = 0; for (int r = 0; r < 16; ++r) ps += p0[r]; for (int r = 0; r < 16; ++r) ps += p1[r];
  { auto rr = __builtin_amdgcn_permlane32_swap(__float_as_uint(ps), __float_as_uint(ps), false, false);
    ps = __uint_as_float(rr[0]) + __uint_as_float(rr[1]); }
  l_reg = l_reg * alpha + ps;
#define PK4(P, BASE, OUT) do { unsigned a0 = cvtpk(P[BASE + 0], P[BASE + 1]), a1 = cvtpk(P[BASE + 2], P[BASE + 3]);   \
    unsigned b0 = cvtpk(P[BASE + 4], P[BASE + 5]), b1 = cvtpk(P[BASE + 6], P[BASE + 7]);                              \
    auto r0 = __builtin_amdgcn_permlane32_swap(a0, b0, false, false); auto r1 = __builtin_amdgcn_permlane32_swap(a1, b1, false, false); \
    u32x4 w = {r0[0], r1[0], r0[1], r1[1]}; OUT = *reinterpret_cast<bf16x8*>(&w); } while (0)
  PK4(p0, 0, pa0); PK4(p0, 8, pa1); PK4(p1, 0, pa2); PK4(p1, 8, pa3);
#undef PK4
}
__device__ __forceinline__ void softmax_tile_neg(f32x16& p0, f32x16& p1, float& mhat, float& l_reg, float& alpha, f32x16& negm, bool first, bf16x8& pa0, bf16x8& pa1, bf16x8& pa2, bf16x8& pa3) {
  constexpr float THR2 = THR * 1.4426950408889634f;
  float pmax = p0[0]; for (int r = 1; r < 16; ++r) pmax = fmaxf(pmax, p0[r]); for (int r = 0; r < 16; ++r) pmax = fmaxf(pmax, p1[r]);
  { auto rr = __builtin_amdgcn_permlane32_swap(__float_as_uint(pmax), __float_as_uint(pmax), false, false);
    pmax = fmaxf(__uint_as_float(rr[0]), __uint_as_float(rr[1])); }
  alpha = 1.f;
  if (__builtin_expect(first || !__all(pmax <= THR2), 0)) {
    const float dl = first ? pmax : fmaxf(pmax, 0.f);
    mhat += dl;
    for (int r = 0; r < 16; ++r) { p0[r] -= dl; p1[r] -= dl; }
    if (!first) alpha = __builtin_amdgcn_exp2f(-dl);
    for (int r = 0; r < 16; ++r) negm[r] = -mhat;
    asm volatile("" : "+v"(negm));
  }
  for (int r = 0; r < 16; ++r) p0[r] = __builtin_amdgcn_exp2f(p0[r]);
  for (int r = 0; r < 16; ++r) p1[r] = __builtin_amdgcn_exp2f(p1[r]);
  float ps = 0; for (int r = 0; r < 16; ++r) ps += p0[r]; for (int r = 0; r < 16; ++r) ps += p1[r];
  { auto rr = __builtin_amdgcn_permlane32_swap(__float_as_uint(ps), __float_as_uint(ps), false, false);
    ps = __uint_as_float(rr[0]) + __uint_as_float(rr[1]); }
  l_reg = l_reg * alpha + ps;
#define PK4(P, BASE, OUT) do { unsigned a0 = cvtpk(P[BASE + 0], P[BASE + 1]), a1 = cvtpk(P[BASE + 2], P[BASE + 3]);   \
    unsigned b0 = cvtpk(P[BASE + 4], P[BASE + 5]), b1 = cvtpk(P[BASE + 6], P[BASE + 7]);                              \
    auto r0 = __builtin_amdgcn_permlane32_swap(a0, b0, false, false); auto r1 = __builtin_amdgcn_permlane32_swap(a1, b1, false, false); \
    u32x4 w = {r0[0], r1[0], r0[1], r1[1]}; OUT = *reinterpret_cast<bf16x8*>(&w); } while (0)
  PK4(p0, 0, pa0); PK4(p0, 8, pa1); PK4(p1, 0, pa2); PK4(p1, 8, pa3);
#undef PK4
}
template <int OFF> __device__ __forceinline__ bf16x8 lds_rd128(int addr) { bf16x8 r; asm volatile("ds_read_b128 %0, %1 offset:%2" : "=&v"(r) : "v"(addr), "i"(OFF) : "memory"); return r; }
#define LGKM_WAIT(n) do { asm volatile("s_waitcnt lgkmcnt(" #n ")" ::: "memory"); SBAR(); } while (0)
#define MF(a, b, c) __builtin_amdgcn_mfma_f32_32x32x16_bf16(a, b, c, 0, 0, 0)
#define PKV(L, H) (bf16x8){L[0], L[1], L[2], L[3], H[0], H[1], H[2], H[3]}
template <int D0> struct VRd { s16x4 l0, h0, l1, h1, l2, h2, l3, h3;
  __device__ __forceinline__ void issue(int vb) { l0 = tr_read<v_rd_off(D0, 0, 0)>(vb); h0 = tr_read<v_rd_off(D0, 0, 1)>(vb); l1 = tr_read<v_rd_off(D0, 1, 0)>(vb); h1 = tr_read<v_rd_off(D0, 1, 1)>(vb);
                                                l2 = tr_read<v_rd_off(D0, 2, 0)>(vb); h2 = tr_read<v_rd_off(D0, 2, 1)>(vb); l3 = tr_read<v_rd_off(D0, 3, 0)>(vb); h3 = tr_read<v_rd_off(D0, 3, 1)>(vb); }
  __device__ __forceinline__ void mma(f32x16& od, bf16x8 pa0, bf16x8 pa1, bf16x8 pa2, bf16x8 pa3) const { od = MF(pa0, PKV(l0, h0), od); od = MF(pa1, PKV(l1, h1), od); od = MF(pa2, PKV(l2, h2), od); od = MF(pa3, PKV(l3, h3), od); } };
template <bool WITH_QK, bool WITH_PV>
__device__ __forceinline__ void mblock(f32x16& p0, f32x16& p1, f32x16 (&o)[4], const int (&kas)[4], int vb, const bf16x8 (&qr)[8], bf16x8 pa0, bf16x8 pa1, bf16x8 pa2, bf16x8 pa3, const f32x16& cinit) {
  bf16x8 ka[8], kb[8];
  VRd<0> v0; VRd<1> v1; VRd<2> v2; VRd<3> v3;
  SBAR();
  if (PP_PRIO == 2) __builtin_amdgcn_s_setprio(1);
  if constexpr (WITH_QK) {
#pragma unroll
    for (int j = 0; j < 4; ++j) { ka[2 * j] = lds_rd128<0>(kas[j]); ka[2 * j + 1] = lds_rd128<8192>(kas[j]); }
#pragma unroll
    for (int j = 0; j < 4; ++j) { const int kh_ = kas[j] ^ 128; kb[2 * j] = lds_rd128<0>(kh_); kb[2 * j + 1] = lds_rd128<8192>(kh_); }
    LGKM_WAIT(12);
    p0 = MF(ka[0], qr[0], cinit); p1 = MF(ka[1], qr[0], cinit); p0 = MF(ka[2], qr[1], p0); p1 = MF(ka[3], qr[1], p1); SBAR();
    LGKM_WAIT(8);
    p0 = MF(ka[4], qr[2], p0); p1 = MF(ka[5], qr[2], p1); p0 = MF(ka[6], qr[3], p0); p1 = MF(ka[7], qr[3], p1); SBAR();
    if constexpr (WITH_PV) { if (PROBE_SENS == 2) { f32x16 d0_ = MF(ka[0], qr[0], cinit), d1_ = MF(ka[1], qr[0], cinit); d0_ = MF(ka[2], qr[1], d0_); d1_ = MF(ka[3], qr[1], d1_); d0_ = MF(ka[4], qr[2], d0_); d1_ = MF(ka[5], qr[2], d1_); d0_ = MF(ka[6], qr[3], d0_); d1_ = MF(ka[7], qr[3], d1_); asm volatile("" :: "v"(d0_), "v"(d1_)); SBAR(); } }
    if constexpr (WITH_PV) { v0.issue(vb); if (PP_V2AHEAD) { v1.issue(vb); LGKM_WAIT(15); } else LGKM_WAIT(8); } else { LGKM_WAIT(0); }
#pragma unroll
    for (int j = 0; j < 4; ++j) { p0 = MF(kb[2 * j], qr[4 + j], p0); p1 = MF(kb[2 * j + 1], qr[4 + j], p1); }
    SBAR();
    if constexpr (WITH_PV) {
      if (!PP_V2AHEAD) v1.issue(vb);
      v2.issue(vb); LGKM_WAIT(15); v0.mma(o[0], pa0, pa1, pa2, pa3); SBAR();
      v3.issue(vb); LGKM_WAIT(15); v1.mma(o[1], pa0, pa1, pa2, pa3); SBAR();
      LGKM_WAIT(8); v2.mma(o[2], pa0, pa1, pa2, pa3); SBAR();
      LGKM_WAIT(0); v3.mma(o[3], pa0, pa1, pa2, pa3); SBAR();
    }
    if (PP_PRIO == 2) __builtin_amdgcn_s_setprio(0);
  } else if constexpr (WITH_PV) {
    v0.issue(vb); v1.issue(vb); LGKM_WAIT(8); v0.mma(o[0], pa0, pa1, pa2, pa3); SBAR();
    v2.issue(vb); LGKM_WAIT(8); v1.mma(o[1], pa0, pa1, pa2, pa3); SBAR();
    v3.issue(vb); LGKM_WAIT(8); v2.mma(o[2], pa0, pa1, pa2, pa3); SBAR();
    LGKM_WAIT(0); v3.mma(o[3], pa0, pa1, pa2, pa3); SBAR();
  }
}
#undef MF
#undef PKV
__device__ __forceinline__ void attn_pp_body(const bf16* __restrict__ Qb, const bf16* __restrict__ Kh, const bf16* __restrict__ Vh, bf16* __restrict__ Ob, int seq, lds_ptr lds3) {
  char* lds = (char*)lds3;
  int tid = threadIdx.x; asm volatile("" : "+v"(tid));
  const int wid = __builtin_amdgcn_readfirstlane(tid >> 6), lane = tid & 63, r32 = lane & 31, hi = lane >> 5;
  const bool trailing = wid >= 4;
  char* V_lds = lds + 3 * SHM_K;
  float* ws = (float*)(lds + 3 * SHM_K + 3 * SHM_V) + wid * 64; float* li_l = ws; float* al_l = ws + 32;
  float m_reg = -1e30f, l_reg = 0; bf16x8 qr[8];
  int koff[2], voff[2];
#pragma unroll
  for (int i = 0; i < 2; ++i) { const int w = 2 * wid + i;
    { const int row = 4 * w + (lane >> 4), ch = (lane & 15) ^ (row & KSW); koff[i] = row * LDK + ch * 8; }
    { const int s = 2 * w + (lane >> 5), kk = (s >> 2) * 8 + ((lane & 31) >> 2), k = (kk & ~0xC) | ((kk & 4) << 1) | ((kk & 8) >> 1), c = (s & 3) * 32 + 8 * (lane & 3); voff[i] = k * LDK + c; } }
#define DMA_K(t, slot) do { _Pragma("unroll") for (int i_ = 0; i_ < 2; ++i_) __builtin_amdgcn_global_load_lds((const __attribute__((address_space(1))) unsigned*)(Kh + (long)(t) * (KVBLK * LDK) + koff[i_]), \
      (__attribute__((address_space(3))) unsigned*)(lds3 + (slot) * (int)SHM_K + (2 * wid + i_) * 1024), 16, 0, 0); } while (0)
#define DMA_V(t, slot) do { _Pragma("unroll") for (int i_ = 0; i_ < 2; ++i_) __builtin_amdgcn_global_load_lds((const __attribute__((address_space(1))) unsigned*)(Vh + (long)(t) * (KVBLK * LDK) + voff[i_]), \
      (__attribute__((address_space(3))) unsigned*)(lds3 + 3 * (int)SHM_K + (slot) * (int)SHM_V + (2 * wid + i_) * 1024), 16, 0, 0); } while (0)
#define STEP_END_L() do { asm volatile("s_waitcnt vmcnt(4) lgkmcnt(0)" ::: "memory"); SBAR(); __builtin_amdgcn_s_barrier(); asm volatile("" ::: "memory"); SBAR(); } while (0)
#define STEP_END_T() do { asm volatile("s_waitcnt vmcnt(0) lgkmcnt(0)" ::: "memory"); SBAR(); __builtin_amdgcn_s_barrier(); asm volatile("" ::: "memory"); SBAR(); } while (0)
#define BLOCK_END_M_() do { if (PP_LATEWAIT && !trailing) asm volatile("s_waitcnt lgkmcnt(0)" ::: "memory"); else asm volatile("s_waitcnt vmcnt(0) lgkmcnt(0)" ::: "memory"); SBAR(); __builtin_amdgcn_s_barrier(); asm volatile("" ::: "memory"); SBAR(); } while (0)
#define BLOCK_END_V_() do { if (PP_LATEWAIT && !trailing) asm volatile("s_waitcnt vmcnt(4) lgkmcnt(0)" ::: "memory"); else asm volatile("s_waitcnt lgkmcnt(0)" ::: "memory");     SBAR(); __builtin_amdgcn_s_barrier(); asm volatile("" ::: "memory"); SBAR(); } while (0)
#define BLOCK_END_M() do { if (PP_ONEBAR) { if (trailing) STEP_END_T(); else SBAR(); } else BLOCK_END_M_(); } while (0)
#define BLOCK_END_V() do { if (PP_ONEBAR) { if (!trailing) STEP_END_L(); else SBAR(); } else BLOCK_END_V_(); } while (0)
#define RESC(a) do { if (__any((a) < 1.f)) { if (hi == 0) al_l[r32] = (a); asm volatile("s_waitcnt lgkmcnt(0)" ::: "memory"); \
    for (int d = 0; d < 4; ++d) for (int r = 0; r < 16; ++r) o[d][r] *= al_l[crow(r, hi)]; } } while (0)
  const int NT = seq / KVBLK;
  DMA_K(0, 0); DMA_V(0, 0); DMA_K(1, 1);
  const bf16* Qw = Qb + (long)(wid * QBLK + r32) * LDQ + hi * 8;
#pragma unroll
  for (int d0 = 0; d0 < 8; ++d0) qr[d0] = *reinterpret_cast<const bf16x8*>(Qw + d0 * 16);
  const int lds0 = (int)(uintptr_t)lds;
  const int vb0 = (int)(uintptr_t)V_lds + v_rd_base(lane);
  int kad[4];
#pragma unroll
  for (int j = 0; j < 4; ++j) kad[j] = lds0 + r32 * 256 + ((32 * j + 16 * hi) ^ ((r32 & KSW) << 4));
  f32x16 p0, p1; float alpha = 1.f; bf16x8 pa0, pa1, pa2, pa3;
  if (PP_NEGM) m_reg = 0.f;
  asm volatile("s_waitcnt vmcnt(0)" ::: "memory"); __builtin_amdgcn_s_barrier(); asm volatile("" ::: "memory");
  if (!PP_ONEBAR && trailing) { __builtin_amdgcn_s_barrier(); asm volatile("" ::: "memory"); if (PP_PRIO == 1) __builtin_amdgcn_s_setprio(1); }
  f32x16 o[4] = {};
  f32x16 negm; { float z_ = 0.f; asm volatile("" : "+v"(z_)); for (int r = 0; r < 16; ++r) negm[r] = z_; asm volatile("" : "+v"(negm)); }
  { int kas[4];
#pragma unroll
    for (int j = 0; j < 4; ++j) kas[j] = kad[j];
    mblock<true, false>(p0, p1, o, kas, vb0, qr, pa0, pa0, pa0, pa0, negm); }
  BLOCK_END_M();
  DMA_K(2, 2); DMA_V(1, 1);
  if (PP_NEGM) softmax_tile_neg(p0, p1, m_reg, l_reg, alpha, negm, true, pa0, pa1, pa2, pa3); else softmax_tile(p0, p1, m_reg, l_reg, alpha, pa0, pa1, pa2, pa3);
  BLOCK_END_V();
  int sk = 1, sv = 0;
#if PP_ALIGN == 1
  asm volatile(".p2align 8");
#elif PP_ALIGN == 2
  asm volatile(".p2align 8\n\ts_nop 0");
#elif PP_ALIGN == 3
  asm volatile("s_nop 0");
#endif
  for (int t = 1; t < NT; ++t) {
    { int kas[4]; const int kbs = sk * (int)SHM_K;
#pragma unroll
      for (int j = 0; j < 4; ++j) kas[j] = kad[j] + kbs;
      f32x16 q0, q1;
      mblock<true, true>(q0, q1, o, kas, vb0 + sv * (int)SHM_V, qr, pa0, pa1, pa2, pa3, negm);
      BLOCK_END_M();
#if PP_DMALATE
      if (PROBE_SENS == 3) { _Pragma("unroll") for (int i_ = 0; i_ < 4; ++i_) __builtin_amdgcn_global_load_lds((const __attribute__((address_space(1))) unsigned*)(Kh + koff[i_ & 1]), (__attribute__((address_space(3))) unsigned*)(lds3 + 102400 + (4 * wid + i_) * 1024), 16, 0, 0); }
      if (PROBE_SENS == 1) { for (int r = 0; r < 16; ++r) { float t0_ = __builtin_amdgcn_exp2f(q0[r]), t1_ = __builtin_amdgcn_exp2f(q1[r]); asm volatile("" :: "v"(t0_), "v"(t1_)); } }
      if (PP_NEGM) softmax_tile_neg(q0, q1, m_reg, l_reg, alpha, negm, false, pa0, pa1, pa2, pa3); else softmax_tile(q0, q1, m_reg, l_reg, alpha, pa0, pa1, pa2, pa3);
      RESC(alpha);
      SBAR();
      { const int tk_ = (t + 2 < NT) ? t + 2 : NT - 1, tv_ = (t + 1 < NT) ? t + 1 : NT - 1; const int sk2_ = (sk == 0) ? 2 : sk - 1, sv2_ = (sv == 0) ? 2 : sv - 1; DMA_K(tk_, sk2_); DMA_V(tv_, sv2_); }
#else
      { const int tk_ = (t + 2 < NT) ? t + 2 : NT - 1, tv_ = (t + 1 < NT) ? t + 1 : NT - 1; const int sk2_ = (sk == 0) ? 2 : sk - 1, sv2_ = (sv == 0) ? 2 : sv - 1; DMA_K(tk_, sk2_); DMA_V(tv_, sv2_); }
      if (PROBE_SENS == 1) { for (int r = 0; r < 16; ++r) { float t0_ = __builtin_amdgcn_exp2f(q0[r]), t1_ = __builtin_amdgcn_exp2f(q1[r]); asm volatile("" :: "v"(t0_), "v"(t1_)); } }
      if (PP_NEGM) softmax_tile_neg(q0, q1, m_reg, l_reg, alpha, negm, false, pa0, pa1, pa2, pa3); else softmax_tile(q0, q1, m_reg, l_reg, alpha, pa0, pa1, pa2, pa3);
      RESC(alpha);
      if (PROBE_SENS == 4) { const int ka_ = lds0 + r32 * 256 + 16 * hi; _Pragma("unroll") for (int j = 0; j < 8; ++j) { bf16x8 d0_, d1_; asm volatile("ds_read_b128 %0, %2 offset:%3\n\tds_read_b128 %1, %2 offset:%4\n\ts_waitcnt lgkmcnt(0)" : "=&v"(d0_), "=&v"(d1_) : "v"(ka_), "i"(j * 32), "i"(j * 32 + 8192) : "memory"); asm volatile("" :: "v"(d0_), "v"(d1_)); } }
#endif
      BLOCK_END_V(); }
    sk = (sk == 2) ? 0 : sk + 1; sv = (sv == 2) ? 0 : sv + 1;
  }
  asm volatile("s_waitcnt vmcnt(0)" ::: "memory");
  { int kas[4] = {0, 0, 0, 0}; mblock<false, true>(p0, p1, o, kas, vb0 + sv * (int)SHM_V, qr, pa0, pa1, pa2, pa3, negm); }
  if (PP_ONEBAR) STEP_END_T(); else BLOCK_END_V();
  if (!PP_ONEBAR) { if (!trailing) { __builtin_amdgcn_s_barrier(); asm volatile("" ::: "memory"); } else if (PP_PRIO == 1) __builtin_amdgcn_s_setprio(0); }
  if (hi == 0) li_l[r32] = l_reg; asm volatile("s_waitcnt lgkmcnt(0)" ::: "memory");
  float rli[16];
#pragma unroll
  for (int r = 0; r < 16; ++r) rli[r] = __builtin_amdgcn_rcpf(li_l[crow(r, hi)]);
  { constexpr int PITCH = 272;
    char* stg = lds + wid * (32 * PITCH);
#pragma unroll
    for (int r = 0; r < 16; ++r) { const int orow = crow(r, hi);
#pragma unroll
      for (int d0 = 0; d0 < 4; ++d0) *(bf16*)(stg + orow * PITCH + (d0 * 32 + r32) * 2) = __float2bfloat16(o[d0][r] * rli[r]); }
    asm volatile("s_waitcnt lgkmcnt(0)" ::: "memory");
    bf16* Ow = Ob + (long)(wid * QBLK) * LDO;
#pragma unroll
    for (int i = 0; i < 8; ++i) { const int row = i * 4 + (lane >> 4), ch = lane & 15;
      const u32x4 v = *(const u32x4*)(stg + row * PITCH + ch * 16);
      *(u32x4*)(Ow + (long)row * LDO + ch * 8) = v; } }
#undef DMA_K
#undef DMA_V
#undef RESC
#undef BLOCK_END_M
#undef BLOCK_END_V
#undef BLOCK_END_M_
#undef BLOCK_END_V_
#undef STEP_END_L
#undef STEP_END_T
#undef LGKM_WAIT
}

using f32x4a = __attribute__((ext_vector_type(4))) float;
constexpr int RD = PP_RING;
#define MF16(a, b, c) __builtin_amdgcn_mfma_f32_16x16x32_bf16(a, b, c, 0, 0, 0)
#define LDSV_B8(p_) (*(const __attribute__((address_space(3))) bf16x8*)(unsigned)(p_))
#define LGKM_WAIT(n) do { asm volatile("s_waitcnt lgkmcnt(" #n ")" ::: "memory"); SBAR(); } while (0)
#define PKV(L, H) (bf16x8){L[0], L[1], L[2], L[3], H[0], H[1], H[2], H[3]}
__device__ __forceinline__ float vmax2(float a, float b) { float r; asm("v_max_f32 %0, %1, %2" : "=v"(r) : "v"(a), "v"(b)); return r; }
__device__ __forceinline__ float vmax3(float a, float b, float c) { float r; asm("v_max3_f32 %0, %1, %2, %3" : "=v"(r) : "v"(a), "v"(b), "v"(c)); return r; }
__device__ __forceinline__ float xg_max(float x) {
  auto s = __builtin_amdgcn_permlane16_swap(__float_as_uint(x), __float_as_uint(x), false, false); x = vmax2(__uint_as_float(s[0]), __uint_as_float(s[1]));
  auto t = __builtin_amdgcn_permlane32_swap(__float_as_uint(x), __float_as_uint(x), false, false); return vmax2(__uint_as_float(t[0]), __uint_as_float(t[1]));
}
__device__ __forceinline__ float xg_sum(float x) {
  auto s = __builtin_amdgcn_permlane16_swap(__float_as_uint(x), __float_as_uint(x), false, false); x = __uint_as_float(s[0]) + __uint_as_float(s[1]);
  auto t = __builtin_amdgcn_permlane32_swap(__float_as_uint(x), __float_as_uint(x), false, false); return __uint_as_float(t[0]) + __uint_as_float(t[1]);
}
__device__ __forceinline__ void softmax16(f32x4a (&s)[4][2], float (&mhat)[2], float (&l)[2], float (&alpha)[2], f32x4a (&negm)[2], bool first, bf16x8 (&pa)[2][2], f32x4a (&oT)[8][2], f32x4a (&lT)[2]) {
  constexpr float THR2 = THR * 1.4426950408889634f;
  float pm[2];
#pragma unroll
  for (int qb = 0; qb < 2; ++qb) {
    const float t0 = vmax3(s[0][qb][0], s[0][qb][1], s[0][qb][2]), t1 = vmax3(s[0][qb][3], s[1][qb][0], s[1][qb][1]), t2 = vmax3(s[1][qb][2], s[1][qb][3], s[2][qb][0]);
    const float t3 = vmax3(s[2][qb][1], s[2][qb][2], s[2][qb][3]), t4 = vmax3(s[3][qb][0], s[3][qb][1], s[3][qb][2]);
    pm[qb] = vmax2(vmax3(t0, t1, t2), vmax3(t3, t4, s[3][qb][3])); }
  alpha[0] = 1.f; alpha[1] = 1.f;
  if (__builtin_expect(first || !__all(vmax2(pm[0], pm[1]) <= THR2), 0)) {
#pragma unroll
    for (int qb = 0; qb < 2; ++qb) { pm[qb] = xg_max(pm[qb]);
      const float dl = first ? pm[qb] : fmaxf(pm[qb], 0.f);
      const float nm = negm[qb][0] - dl;
#pragma unroll
      for (int kb = 0; kb < 4; ++kb)
#pragma unroll
        for (int e = 0; e < 4; ++e) s[kb][qb][e] -= dl;
      if (!first) { alpha[qb] = __builtin_amdgcn_exp2f(-dl);
        if (PP_LMFMA) { const float a_ = alpha[qb];
#pragma unroll
          for (int db = 0; db < 8; ++db)
#pragma unroll
            for (int e = 0; e < 4; ++e) oT[db][qb][e] *= a_;
#pragma unroll
          for (int e = 0; e < 4; ++e) lT[qb][e] *= a_; } }
#pragma unroll
      for (int e = 0; e < 4; ++e) negm[qb][e] = nm;
      asm volatile("" : "+v"(negm[qb])); }
  }
}
template <int qb> __device__ __forceinline__ void softmax16_qb(f32x4a (&s)[4][2], float (&l)[2], const float (&alpha)[2], bf16x8 (&pa)[2][2]) {
#pragma unroll
  for (int kb = 0; kb < 4; ++kb)
#pragma unroll
    for (int e = 0; e < 4; ++e) s[kb][qb][e] = __builtin_amdgcn_exp2f(s[kb][qb][e]);
  if (!PP_LMFMA) { const f32x4a t = (s[0][qb] + s[1][qb]) + (s[2][qb] + s[3][qb]);
    l[qb] = l[qb] * alpha[qb] + ((t[0] + t[1]) + (t[2] + t[3])); }
#pragma unroll
  for (int j = 0; j < 2; ++j) { u32x4 w = {cvtpk(s[2 * j][qb][0], s[2 * j][qb][1]), cvtpk(s[2 * j][qb][2], s[2 * j][qb][3]), cvtpk(s[2 * j + 1][qb][0], s[2 * j + 1][qb][1]), cvtpk(s[2 * j + 1][qb][2], s[2 * j + 1][qb][3])};
    pa[j][qb] = *reinterpret_cast<bf16x8*>(&w); }
}
template <int qb> __device__ __forceinline__ float softmax16_qb_sum(f32x4a (&s)[4][2], bf16x8 (&pa)[2][2]) {
#pragma unroll
  for (int kb = 0; kb < 4; ++kb)
#pragma unroll
    for (int e = 0; e < 4; ++e) s[kb][qb][e] = __builtin_amdgcn_exp2f(s[kb][qb][e]);
  const f32x4a t = (s[0][qb] + s[1][qb]) + (s[2][qb] + s[3][qb]);
#pragma unroll
  for (int j = 0; j < 2; ++j) { u32x4 w = {cvtpk(s[2 * j][qb][0], s[2 * j][qb][1]), cvtpk(s[2 * j][qb][2], s[2 * j][qb][3]), cvtpk(s[2 * j + 1][qb][0], s[2 * j + 1][qb][1]), cvtpk(s[2 * j + 1][qb][2], s[2 * j + 1][qb][3])};
    pa[j][qb] = *reinterpret_cast<bf16x8*>(&w); }
  return (t[0] + t[1]) + (t[2] + t[3]);
}
__device__ __forceinline__ void softmax16_sum_finish(float t0, float t1, float (&l)[2], float (&alpha)[2], f32x4a (&negm)[2], bf16x8 (&pa)[2][2]) {
  constexpr float LIM = 2896.3093757f;
  alpha[0] = 1.f; alpha[1] = 1.f;
  if (__builtin_expect(__all(vmax2(t0, t1) <= LIM), 1)) { l[0] += t0; l[1] += t1; return; }
  const float tt[2] = {t0, t1};
#pragma unroll
  for (int qb = 0; qb < 2; ++qb) {
    const float T = xg_sum(tt[qb]);
    const float dl = (T > 1.f) ? ceilf(__builtin_amdgcn_logf(T)) : 0.f;
    const float a_ = __builtin_amdgcn_exp2f(-dl);
    l[qb] = (l[qb] + tt[qb]) * a_; alpha[qb] = a_;
{ const unsigned di_ = (unsigned)(int)dl, dw_ = (di_ << 23) | (di_ << 7);
#pragma unroll
      for (int j = 0; j < 2; ++j) { u32x4 w = __builtin_bit_cast(u32x4, pa[j][qb]); w -= dw_; pa[j][qb] = __builtin_bit_cast(bf16x8, w); } }
    const float nm = negm[qb][0] - dl;
#pragma unroll
    for (int e = 0; e < 4; ++e) negm[qb][e] = nm;
    asm volatile("" : "+v"(negm[qb])); }
}
template <int GI> struct VRd16 { s16x4 r[2][2][2];
  __device__ __forceinline__ void issue(const int (&vbx)[2][2]) {
    r[0][0][0] = tr_read<512 * GI>(vbx[0][0]); r[0][0][1] = tr_read<512 * GI>(vbx[1][0]); r[0][1][0] = tr_read<8192 + 512 * GI>(vbx[0][0]); r[0][1][1] = tr_read<8192 + 512 * GI>(vbx[1][0]);
    r[1][0][0] = tr_read<512 * GI>(vbx[0][1]); r[1][0][1] = tr_read<512 * GI>(vbx[1][1]); r[1][1][0] = tr_read<8192 + 512 * GI>(vbx[0][1]); r[1][1][1] = tr_read<8192 + 512 * GI>(vbx[1][1]); }
  __device__ __forceinline__ void mma(f32x4a (&oT)[8][2], const bf16x8 (&pa)[2][2]) const {
#pragma unroll
    for (int j = 0; j < 2; ++j)
#pragma unroll
      for (int dd = 0; dd < 2; ++dd)
#pragma unroll
        for (int qb = 0; qb < 2; ++qb) oT[2 * GI + dd][qb] = MF16(PKV(r[dd][j][0], r[dd][j][1]), pa[j][qb], oT[2 * GI + dd][qb]); } };
template <bool WITH_QK, bool WITH_PV, bool PREF>
__device__ __forceinline__ void mblock16(f32x4a (&s)[4][2], f32x4a (&oT)[8][2], f32x4a (&lT)[2], const bf16x8 (&kpf)[4], const int (&kas)[4], const int (&vbx)[2][2], const bf16x8 (&qf)[2][4], const bf16x8 (&pa)[2][2], const f32x4a (&cinit)[2]) {
  bf16x8 kf[4][4];
  VRd16<0> v0; VRd16<1> v1; VRd16<2> v2; VRd16<3> v3;
  SBAR();
  if (PP_PRIO == 2) __builtin_amdgcn_s_setprio(1);
#define QK_STEP(ks) do { _Pragma("unroll") for (int kb = 0; kb < 4; ++kb) { _Pragma("unroll") for (int qb = 0; qb < 2; ++qb) s[kb][qb] = MF16(kf[ks][kb], qf[qb][ks], (ks) == 0 ? cinit[qb] : s[kb][qb]); } SBAR(); } while (0)
#define K_RD(ks) do { kf[ks][0] = lds_rd128<0>(kas[ks]); kf[ks][1] = lds_rd128<4096>(kas[ks]); kf[ks][2] = lds_rd128<8192>(kas[ks]); kf[ks][3] = lds_rd128<12288>(kas[ks]); } while (0)
#define L_MFMA() do { if (PP_LMFMA) { const unsigned o1_ = 0x3F803F80u; const u32x4 ow_ = {o1_, o1_, o1_, o1_}; const bf16x8 ones_ = *reinterpret_cast<const bf16x8*>(&ow_); \
    lT[0] = MF16(ones_, pa[0][0], lT[0]); lT[1] = MF16(ones_, pa[0][1], lT[1]); lT[0] = MF16(ones_, pa[1][0], lT[0]); lT[1] = MF16(ones_, pa[1][1], lT[1]); SBAR(); } } while (0)
  if constexpr (WITH_QK) {
    if constexpr (PREF) {
      K_RD(1); K_RD(2);
#pragma unroll
      for (int kb = 0; kb < 4; ++kb) kf[0][kb] = kpf[kb];
      if constexpr (WITH_PV) L_MFMA();
      QK_STEP(0);
      K_RD(3); LGKM_WAIT(8); QK_STEP(1);
      if constexpr (WITH_PV) { v0.issue(vbx); LGKM_WAIT(12); } else { LGKM_WAIT(4); }
      QK_STEP(2);
      if constexpr (WITH_PV) { LGKM_WAIT(8); } else { LGKM_WAIT(0); }
      QK_STEP(3);
    } else if (PP_LMFMA) {
      K_RD(0); K_RD(1); K_RD(2);
      if constexpr (WITH_PV) L_MFMA();
      LGKM_WAIT(8); QK_STEP(0);
      K_RD(3); LGKM_WAIT(8); QK_STEP(1);
      if constexpr (WITH_PV) { v0.issue(vbx); LGKM_WAIT(12); } else { LGKM_WAIT(4); }
      QK_STEP(2);
      if constexpr (WITH_PV) { LGKM_WAIT(8); } else { LGKM_WAIT(0); }
      QK_STEP(3);
    } else {
    K_RD(0); K_RD(1); K_RD(2); K_RD(3);
    LGKM_WAIT(12); QK_STEP(0);
    LGKM_WAIT(8);  QK_STEP(1);
    if constexpr (WITH_PV) { v0.issue(vbx); LGKM_WAIT(12); } else { LGKM_WAIT(4); }
    QK_STEP(2);
    if constexpr (WITH_PV) { LGKM_WAIT(8); } else { LGKM_WAIT(0); }
    QK_STEP(3);
    }
    if constexpr (WITH_PV) {
      v1.issue(vbx); v2.issue(vbx); LGKM_WAIT(15); v0.mma(oT, pa); SBAR();
      v3.issue(vbx); LGKM_WAIT(15); v1.mma(oT, pa); SBAR();
      LGKM_WAIT(8); v2.mma(oT, pa); SBAR();
      LGKM_WAIT(0); v3.mma(oT, pa); SBAR();
    }
  } else if constexpr (WITH_PV) {
    v0.issue(vbx); v1.issue(vbx); L_MFMA(); LGKM_WAIT(8); v0.mma(oT, pa); SBAR();
    v2.issue(vbx); LGKM_WAIT(8); v1.mma(oT, pa); SBAR();
    v3.issue(vbx); LGKM_WAIT(8); v2.mma(oT, pa); SBAR();
    LGKM_WAIT(0); v3.mma(oT, pa); SBAR();
  }
  if (PP_PRIO == 2) __builtin_amdgcn_s_setprio(0);
#undef QK_STEP
#undef K_RD
#undef L_MFMA
}
template <bool WITH_QK, bool WITH_PV, bool PREF>
__device__ __forceinline__ void mblock16v(f32x4a (&s)[4][2], f32x4a (&oT)[8][2], f32x4a (&lT)[2], const bf16x8 (&kpf)[16], const int (&kas)[4], const int (&vbj)[2], const bf16x8 (&qf)[2][4], const bf16x8 (&pa)[2][2], const f32x4a (&cinit)[2]) {
  bf16x8 kf[4][4];
  bf16x8 vf[4][2][2];
  SBAR();
  if (PP_PRIO == 2) __builtin_amdgcn_s_setprio(1);
#define QK_STEP(ks) do { _Pragma("unroll") for (int kb = 0; kb < 4; ++kb) { _Pragma("unroll") for (int qb = 0; qb < 2; ++qb) s[kb][qb] = MF16(kf[ks][kb], qf[qb][ks], (ks) == 0 ? cinit[qb] : s[kb][qb]); } SBAR(); } while (0)
#define K_RD(ks) do { kf[ks][0] = lds_rd128<0>(kas[ks]); kf[ks][1] = lds_rd128<4096>(kas[ks]); kf[ks][2] = lds_rd128<8192>(kas[ks]); kf[ks][3] = lds_rd128<12288>(kas[ks]); } while (0)
#define V_RD(gi) do { vf[gi][0][0] = lds_rd128<2048 * (2 * (gi))>(vbj[0]); vf[gi][0][1] = lds_rd128<2048 * (2 * (gi))>(vbj[1]); vf[gi][1][0] = lds_rd128<2048 * (2 * (gi) + 1)>(vbj[0]); vf[gi][1][1] = lds_rd128<2048 * (2 * (gi) + 1)>(vbj[1]); } while (0)
#define PV_STEP(gi) do { _Pragma("unroll") for (int j = 0; j < 2; ++j) { _Pragma("unroll") for (int dd = 0; dd < 2; ++dd) { _Pragma("unroll") for (int qb = 0; qb < 2; ++qb) oT[2 * (gi) + dd][qb] = MF16(vf[gi][dd][j], pa[j][qb], oT[2 * (gi) + dd][qb]); } } SBAR(); } while (0)
#define L_MFMA() do { if (PP_LMFMA) { const unsigned o1_ = 0x3F803F80u; const u32x4 ow_ = {o1_, o1_, o1_, o1_}; const bf16x8 ones_ = *reinterpret_cast<const bf16x8*>(&ow_); \
    lT[0] = MF16(ones_, pa[0][0], lT[0]); lT[1] = MF16(ones_, pa[0][1], lT[1]); lT[0] = MF16(ones_, pa[1][0], lT[0]); lT[1] = MF16(ones_, pa[1][1], lT[1]); SBAR(); } } while (0)
  if constexpr (WITH_QK && WITH_PV) {
    if constexpr (PREF && PP_CVIS) {
#define V_RDV(gi) do { vf[gi][0][0] = LDSV_B8(vbj[0] + 2048 * (2 * (gi))); vf[gi][0][1] = LDSV_B8(vbj[1] + 2048 * (2 * (gi))); vf[gi][1][0] = LDSV_B8(vbj[0] + 2048 * (2 * (gi) + 1)); vf[gi][1][1] = LDSV_B8(vbj[1] + 2048 * (2 * (gi) + 1)); SBAR(); } while (0)
#pragma unroll
      for (int ks = 0; ks < (PP_CVIS == 1 ? 4 : 3); ++ks)
#pragma unroll
        for (int kb = 0; kb < 4; ++kb) kf[ks][kb] = kpf[4 * ks + kb];
      if (PP_CVIS == 2) { kf[3][0] = LDSV_B8(kas[3]); kf[3][1] = LDSV_B8(kas[3] + 4096); kf[3][2] = LDSV_B8(kas[3] + 8192); kf[3][3] = LDSV_B8(kas[3] + 12288); SBAR(); }
      QK_STEP(0); L_MFMA();
      V_RDV(0); QK_STEP(1);
      V_RDV(1); QK_STEP(2);
      V_RDV(2); QK_STEP(3);
      V_RDV(3); PV_STEP(0); PV_STEP(1); PV_STEP(2); PV_STEP(3);
#undef V_RDV
    } else if constexpr (PREF) {
#pragma unroll
      for (int kb = 0; kb < 4; ++kb) { kf[0][kb] = kpf[kb]; kf[1][kb] = kpf[4 + kb]; }
      K_RD(2); K_RD(3);
      QK_STEP(0); L_MFMA();
      V_RD(0); QK_STEP(1);
      V_RD(1); LGKM_WAIT(12); QK_STEP(2);
      V_RD(2); LGKM_WAIT(12); QK_STEP(3);
      V_RD(3); LGKM_WAIT(12); PV_STEP(0);
      LGKM_WAIT(8); PV_STEP(1);
      LGKM_WAIT(4); PV_STEP(2);
      LGKM_WAIT(0); PV_STEP(3);
    } else {
      K_RD(0); K_RD(1); K_RD(2); K_RD(3);
      L_MFMA();
      LGKM_WAIT(12); QK_STEP(0);
      V_RD(0); LGKM_WAIT(12); QK_STEP(1);
      V_RD(1); LGKM_WAIT(12); QK_STEP(2);
      V_RD(2); LGKM_WAIT(12); QK_STEP(3);
      V_RD(3); LGKM_WAIT(12); PV_STEP(0);
      LGKM_WAIT(8); PV_STEP(1);
      LGKM_WAIT(4); PV_STEP(2);
      LGKM_WAIT(0); PV_STEP(3);
    }
  } else if constexpr (WITH_QK) {
    K_RD(0); K_RD(1); K_RD(2); K_RD(3);
    LGKM_WAIT(12); QK_STEP(0); LGKM_WAIT(8); QK_STEP(1); LGKM_WAIT(4); QK_STEP(2); LGKM_WAIT(0); QK_STEP(3);
  } else {
    LGKM_WAIT(0);
    V_RD(0); V_RD(1); V_RD(2); V_RD(3); L_MFMA();
    LGKM_WAIT(12); PV_STEP(0); LGKM_WAIT(8); PV_STEP(1); LGKM_WAIT(4); PV_STEP(2); LGKM_WAIT(0); PV_STEP(3);
  }
  if (PP_PRIO == 2) __builtin_amdgcn_s_setprio(0);
#undef QK_STEP
#undef K_RD
#undef V_RD
#undef PV_STEP
#undef L_MFMA
}
template <bool sumvote> __device__ __forceinline__ void attn_pp16_body(const bf16* __restrict__ Qb, const bf16* __restrict__ Kh, const bf16* __restrict__ Vh, bf16* __restrict__ Ob, int seq, lds_ptr lds3) {
  char* lds = (char*)lds3;
  int tid = threadIdx.x; asm volatile("" : "+v"(tid));
  const int wid = __builtin_amdgcn_readfirstlane(tid >> 6), lane = tid & 63, r16 = lane & 15, g = lane >> 4;
  const bool trailing = wid >= 4;
  int koff[2], voff[2];
#pragma unroll
  for (int i = 0; i < 2; ++i) { const int w = 2 * wid + i;
    { const int row = 4 * w + (lane >> 4), ch = (lane & 15) ^ (row & 15); koff[i] = row * LDK + ch * 8; }
    if (PP_VT) voff[i] = 512 * w + 8 * lane;
    else { const int R = 8 * wid + ((lane & 31) >> 2), key = (R & 0x23) | ((R & 0x18) >> 1) | ((R & 4) << 2), ch = 4 * (2 * i + (lane >> 5)) + ((lane & 3) ^ ((R >> 2) & 3)); voff[i] = key * LDK + ch * 8; } }
#define DMA_K(t, slot) do { _Pragma("unroll") for (int i_ = 0; i_ < 2; ++i_) __builtin_amdgcn_global_load_lds((const __attribute__((address_space(1))) unsigned*)(Kh + (long)(t) * (KVBLK * LDK) + (i_ ? (koff[0] ^ 32) + 512 : koff[0])), \
      (__attribute__((address_space(3))) unsigned*)(lds3 + (slot) * (int)SHM_K + (2 * wid + i_) * 1024), 16, 0, 0); } while (0)
#define DMA_V(t, slot) do { _Pragma("unroll") for (int i_ = 0; i_ < 2; ++i_) __builtin_amdgcn_global_load_lds((const __attribute__((address_space(1))) unsigned*)(Vh + (long)(t) * (KVBLK * LDK) + voff[i_]), \
      (__attribute__((address_space(3))) unsigned*)(lds3 + RD * (int)SHM_K + (slot) * (int)SHM_V + (2 * wid + i_) * 1024), 16, 0, 0); } while (0)
#define BLOCK_END_M() do { if (RD == 4 && !PP_PREF16) asm volatile("s_waitcnt vmcnt(4) lgkmcnt(0)" ::: "memory"); else asm volatile("s_waitcnt vmcnt(0) lgkmcnt(0)" ::: "memory"); SBAR(); __builtin_amdgcn_s_barrier(); asm volatile("" ::: "memory"); if (PROBE_SENS == 5) __builtin_amdgcn_s_sleep(5); SBAR(); } while (0)
#define K_PREF23(slot) do { if (PP_CVIS && PP_PREF16 && PP_VT) { SBAR(); const int c_ = (kad0 + (slot) * (int)SHM_K) ^ 128, d_ = c_ ^ 64; \
    kpf[8] = LDSV_B8(c_); kpf[9] = LDSV_B8(c_ + 4096); kpf[10] = LDSV_B8(c_ + 8192); kpf[11] = LDSV_B8(c_ + 12288); if (PP_CVIS == 1) { kpf[12] = LDSV_B8(d_); kpf[13] = LDSV_B8(d_ + 4096); kpf[14] = LDSV_B8(d_ + 8192); kpf[15] = LDSV_B8(d_ + 12288); } SBAR(); } } while (0)
#define BLOCK_END_V() BLOCK_END_V2(-1)
#define BLOCK_END_V2(slot) do { asm volatile("s_waitcnt lgkmcnt(0)" ::: "memory"); if (PP_PREF16) { asm volatile("" :: "v"(kpf[0]), "v"(kpf[1]), "v"(kpf[2]), "v"(kpf[3])); if (PP_VT) asm volatile("" :: "v"(kpf[4]), "v"(kpf[5]), "v"(kpf[6]), "v"(kpf[7])); }     if ((slot) >= 0) K_PREF23(slot); SBAR(); __builtin_amdgcn_s_barrier(); asm volatile("" ::: "memory"); if (PROBE_SENS == 5) __builtin_amdgcn_s_sleep(5); SBAR(); } while (0)
#define KPF_USE() do { if (PP_PREF16) { asm volatile("" :: "v"(kpf[0]), "v"(kpf[1]), "v"(kpf[2]), "v"(kpf[3])); if (PP_VT) asm volatile("" :: "v"(kpf[4]), "v"(kpf[5]), "v"(kpf[6]), "v"(kpf[7])); } } while (0)
#define OB_END_M() do { if (trailing) { asm volatile("s_waitcnt vmcnt(4) lgkmcnt(0)" ::: "memory"); SBAR(); __builtin_amdgcn_s_barrier(); asm volatile("" ::: "memory"); } SBAR(); } while (0)
#define OB_END_V() do { if (!trailing) { asm volatile("s_waitcnt vmcnt(4) lgkmcnt(0)" ::: "memory"); KPF_USE(); SBAR(); __builtin_amdgcn_s_barrier(); asm volatile("" ::: "memory"); } else { asm volatile("s_waitcnt lgkmcnt(0)" ::: "memory"); KPF_USE(); } SBAR(); } while (0)
#define RESC16() do { if (!PP_LMFMA && __any(alpha[0] < 1.f || alpha[1] < 1.f)) { _Pragma("unroll") for (int db = 0; db < 8; ++db) { _Pragma("unroll") for (int qb = 0; qb < 2; ++qb) { _Pragma("unroll") for (int e = 0; e < 4; ++e) oT[db][qb][e] *= alpha[qb]; } } if (PP_LMFMA) { _Pragma("unroll") for (int qb = 0; qb < 2; ++qb) { _Pragma("unroll") for (int e = 0; e < 4; ++e) lT[qb][e] *= alpha[qb]; } } } } while (0)
#if PROBE_SENS >= 6
  unsigned long long tprev_ = 0; unsigned acc_ = 0;
constexpr int PS_BASE = (PROBE_SENS >= 16) ? 16 : 6, PS_COMP = (PROBE_SENS - PS_BASE) & 3, PS_WAVE = (PROBE_SENS >= 30) ? 0 : ((PROBE_SENS - PS_BASE) >> 2) & 1;
#define STAMP(k) do { const unsigned long long c_ = (PROBE_SENS >= 16 && PROBE_SENS != 31) ? __builtin_amdgcn_s_memrealtime() : __builtin_amdgcn_s_memtime(); if ((PS_COMP == (k) || PROBE_SENS >= 30) && (k) >= 0) acc_ += (unsigned)(c_ - tprev_); tprev_ = c_; } while (0)
#else
#define STAMP(k) do { } while (0)
#endif
  const int NT = seq / KVBLK;
  DMA_K(0, 0); DMA_V(0, 0); DMA_K(1, 1); if (RD == 4) { DMA_V(1, 1); DMA_K(2, 2); }
  bf16x8 qf[2][4];
  { const bf16* Qw = Qb + (long)(wid * QBLK + r16) * LDQ + g * 8;
#pragma unroll
    for (int qb = 0; qb < 2; ++qb)
#pragma unroll
      for (int ks = 0; ks < 4; ++ks) qf[qb][ks] = *reinterpret_cast<const bf16x8*>(Qw + (long)(16 * qb) * LDQ + ks * 32); }
  const int lds0 = (int)(uintptr_t)lds;
  const int kad0 = lds0 + r16 * 256 + ((g ^ r16) << 4);
const int vt0c_ = lds0 + RD * (int)SHM_K + 128 * r16 + 16 * (g ^ (r16 >> 1));
#define VT0() (vt0c_)
  const int vt0_unused_ = 0; (void)vt0_unused_;
  const int vb0 = lds0 + RD * (int)SHM_K + 2048 * g + 64 * ((lane & 15) >> 2) + 8 * (lane & 1) + 16 * ((lane >> 1) & 1) + 32 * (g & 1);
  bf16x8 kpf[16];
#define LDS_B8(p_) (*(const __attribute__((address_space(3))) bf16x8*)(unsigned)(p_))
#define K_PREF(slot) do { if (PP_PREF16) { SBAR(); const int a_ = kad0 + (slot) * (int)SHM_K; \
    kpf[0] = LDS_B8(a_); kpf[1] = LDS_B8(a_ + 4096); kpf[2] = LDS_B8(a_ + 8192); kpf[3] = LDS_B8(a_ + 12288); SBAR(); } } while (0)
#define K_PREF1(slot) do { if (PP_PREF16 && PP_VT) { SBAR(); const int b_ = (kad0 + (slot) * (int)SHM_K) ^ 64; \
    kpf[4] = LDS_B8(b_); kpf[5] = LDS_B8(b_ + 4096); kpf[6] = LDS_B8(b_ + 8192); kpf[7] = LDS_B8(b_ + 12288); SBAR(); } } while (0)
  f32x4a s[4][2]; float alpha[2] = {1.f, 1.f}, mhat[2] = {0.f, 0.f}, l[2] = {0.f, 0.f}; bf16x8 pa[2][2];
  asm volatile("s_waitcnt vmcnt(0)" ::: "memory"); __builtin_amdgcn_s_barrier(); asm volatile("" ::: "memory");
  if (!PP_ONEBAR16 && trailing) { __builtin_amdgcn_s_barrier(); asm volatile("" ::: "memory"); }
  f32x4a oT[8][2];
  f32x4a negm[2], lT[2];
  { float z_ = 0.f; asm volatile("" : "+v"(z_));
#pragma unroll
    for (int db = 0; db < 8; ++db)
#pragma unroll
      for (int qb = 0; qb < 2; ++qb) oT[db][qb] = f32x4a{z_, z_, z_, z_};
    negm[0] = f32x4a{z_, z_, z_, z_}; negm[1] = negm[0]; lT[0] = negm[0]; lT[1] = negm[0]; asm volatile("" : "+v"(negm[0]), "+v"(negm[1])); }
  { int kas[4], vbx[2][2];
#pragma unroll
    for (int ks = 0; ks < 4; ++ks) kas[ks] = kad0 ^ (64 * ks);
    vbx[0][0] = vb0; vbx[0][1] = vb0 ^ 32; vbx[1][0] = vb0 ^ 272; vbx[1][1] = vb0 ^ 304;
    pa[0][0] = qf[0][0]; pa[0][1] = qf[0][0]; pa[1][0] = qf[0][0]; pa[1][1] = qf[0][0];
    if (PP_VT) { const int vt0 = VT0(); const int vbj[2] = {vt0, vt0 ^ 64}; mblock16v<true, false, false>(s, oT, lT, kpf, kas, vbj, qf, pa, negm); }
    else { const bf16x8 (&kp4)[4] = *reinterpret_cast<const bf16x8 (*)[4]>(&kpf[0]); mblock16<true, false, false>(s, oT, lT, kp4, kas, vbx, qf, pa, negm); } }
  if (PP_ONEBAR16) { if (trailing) { DMA_K(3, 3); DMA_V(2, 2); } OB_END_M(); } else BLOCK_END_M();
  if (PP_ONEBAR16) { if (!trailing) { DMA_K(3, 3); DMA_V(2, 2); } else { DMA_K(4, 0); } }
  else if (RD == 4) { DMA_K(3, 3); DMA_V(2, 2); } else { DMA_K(2, 2); DMA_V(1, 1); }
  K_PREF(1);
  if constexpr (PP_SUMVOTE && sumvote) { const float t0_ = softmax16_qb_sum<0>(s, pa); K_PREF1(1); const float t1_ = softmax16_qb_sum<1>(s, pa); softmax16_sum_finish(t0_, t1_, l, alpha, negm, pa); }
  else { softmax16(s, mhat, l, alpha, negm, true, pa, oT, lT); softmax16_qb<0>(s, l, alpha, pa); K_PREF1(1); softmax16_qb<1>(s, l, alpha, pa); }
  if (PP_ONEBAR16) OB_END_V(); else BLOCK_END_V2(1);
  int sk = 1, sv = 0;
  STAMP(-1);
  for (int t = 1; t < NT; ++t) {
    { int kas[4], vbx[2][2]; const int kbs = sk * (int)SHM_K; const int vbs = vb0 + sv * (int)SHM_V;
#pragma unroll
      for (int ks = 0; ks < 4; ++ks) kas[ks] = (kad0 + kbs) ^ (64 * ks);
      vbx[0][0] = vbs; vbx[0][1] = vbs ^ 32; vbx[1][0] = vbs ^ 272; vbx[1][1] = vbs ^ 304;
      f32x4a q[4][2];
      if (PP_VT) { const int vts = VT0() + sv * (int)SHM_V; const int vbj[2] = {vts, vts ^ 64}; mblock16v<true, true, PP_PREF16 != 0>(q, oT, lT, kpf, kas, vbj, qf, pa, negm); }
      else { const bf16x8 (&kp4)[4] = *reinterpret_cast<const bf16x8 (*)[4]>(&kpf[0]); mblock16<true, true, PP_PREF16 != 0>(q, oT, lT, kp4, kas, vbx, qf, pa, negm); }
      STAMP(0);
      if (PP_ONEBAR16) { const int tv_ = (t + 2 < NT) ? t + 2 : NT - 1, sv2_ = (sv == 0) ? RD - 1 : sv - 1; DMA_V(tv_, sv2_); OB_END_M(); }
      else if (PP_VDMA_M) { const int tv_ = (t + RD - 2 < NT) ? t + RD - 2 : NT - 1, sv2_ = (sv == 0) ? RD - 1 : sv - 1; DMA_V(tv_, sv2_);
        if (PP_VDMA_M == 2) { const int tk_ = (t + RD - 1 < NT) ? t + RD - 1 : NT - 1, sk2_ = (sk == 0) ? RD - 1 : sk - 1; DMA_K(tk_, sk2_); asm volatile("s_waitcnt vmcnt(4) lgkmcnt(0)" ::: "memory"); }
        else asm volatile("s_waitcnt vmcnt(2) lgkmcnt(0)" ::: "memory");
        SBAR(); __builtin_amdgcn_s_barrier(); asm volatile("" ::: "memory"); SBAR(); }
      else BLOCK_END_M();
      STAMP(1);
      if (PP_PRIO == 3) __builtin_amdgcn_s_setprio(1);
      K_PREF((sk == RD - 1) ? 0 : sk + 1);
      if (PP_ONEBAR16) { const int tq_ = t + 3 + (trailing ? 1 : 0), tk_ = (tq_ < NT) ? tq_ : NT - 1, sk2_ = trailing ? sk : ((sk == 0) ? RD - 1 : sk - 1); DMA_K(tk_, sk2_); }
      else { const int tk_ = (t + RD - 1 < NT) ? t + RD - 1 : NT - 1, tv_ = (t + RD - 2 < NT) ? t + RD - 2 : NT - 1; const int sk2_ = (sk == 0) ? RD - 1 : sk - 1, sv2_ = (sv == 0) ? RD - 1 : sv - 1; if (PP_VDMA_M != 2) DMA_K(tk_, sk2_); if (!PP_VDMA_M) DMA_V(tv_, sv2_); }
      if constexpr (PP_SUMVOTE && sumvote) { const float t0_ = softmax16_qb_sum<0>(q, pa); K_PREF1((sk == RD - 1) ? 0 : sk + 1); const float t1_ = softmax16_qb_sum<1>(q, pa); softmax16_sum_finish(t0_, t1_, l, alpha, negm, pa); }
      else { softmax16(q, mhat, l, alpha, negm, false, pa, oT, lT); softmax16_qb<0>(q, l, alpha, pa); K_PREF1((sk == RD - 1) ? 0 : sk + 1); softmax16_qb<1>(q, l, alpha, pa); }
      RESC16();
      if (PP_PRIO == 3) __builtin_amdgcn_s_setprio(0);
      STAMP(2);
      if (PP_ONEBAR16) OB_END_V(); else BLOCK_END_V2((sk == RD - 1) ? 0 : sk + 1);
      STAMP(3); }
    sk = (sk == RD - 1) ? 0 : sk + 1; sv = (sv == RD - 1) ? 0 : sv + 1;
  }
#if PROBE_SENS >= 6
  if (blockIdx.x == 0 && tid == (PS_WAVE ? 256 : 0)) ((volatile unsigned*)(lds + 131072 + 320))[16] += (PROBE_SENS == 30) ? (acc_ >> 2) : (PROBE_SENS == 31) ? (acc_ >> 9) : (PROBE_SENS >= 16) ? acc_ : (acc_ >> 7);
#endif
  asm volatile("s_waitcnt vmcnt(0)" ::: "memory");
  { int kas[4] = {0, 0, 0, 0}, vbx[2][2]; const int vbs = vb0 + sv * (int)SHM_V;
    vbx[0][0] = vbs; vbx[0][1] = vbs ^ 32; vbx[1][0] = vbs ^ 272; vbx[1][1] = vbs ^ 304;
    if (PP_VT) { const int vts = VT0() + sv * (int)SHM_V; const int vbj[2] = {vts, vts ^ 64}; mblock16v<false, true, false>(s, oT, lT, kpf, kas, vbj, qf, pa, negm); }
    else { const bf16x8 (&kp4)[4] = *reinterpret_cast<const bf16x8 (*)[4]>(&kpf[0]); mblock16<false, true, false>(s, oT, lT, kp4, kas, vbx, qf, pa, negm); } }
  if (PP_ONEBAR16) { asm volatile("s_waitcnt lgkmcnt(0)" ::: "memory"); SBAR(); __builtin_amdgcn_s_barrier(); asm volatile("" ::: "memory"); SBAR(); } else
  BLOCK_END_V();
  if (!PP_ONEBAR16 && !trailing) { __builtin_amdgcn_s_barrier(); asm volatile("" ::: "memory"); }
  float rli[2]; if (PP_LMFMA) { rli[0] = __builtin_amdgcn_rcpf(lT[0][0]); rli[1] = __builtin_amdgcn_rcpf(lT[1][0]); } else { rli[0] = __builtin_amdgcn_rcpf(xg_sum(l[0])); rli[1] = __builtin_amdgcn_rcpf(xg_sum(l[1])); }
  { constexpr int PITCH = 272;
    char* stg = lds + wid * (32 * PITCH);
#pragma unroll
    for (int qb = 0; qb < 2; ++qb)
#pragma unroll
      for (int db = 0; db < 8; ++db) { const unsigned w0 = cvtpk(oT[db][qb][0] * rli[qb], oT[db][qb][1] * rli[qb]), w1 = cvtpk(oT[db][qb][2] * rli[qb], oT[db][qb][3] * rli[qb]);
        uint2 w; w.x = w0; w.y = w1; *(uint2*)(stg + (16 * qb + r16) * PITCH + (16 * db + 4 * g) * 2) = w; }
    asm volatile("s_waitcnt lgkmcnt(0)" ::: "memory");
    bf16* Ow = Ob + (long)(wid * QBLK) * LDO;
#pragma unroll
    for (int i = 0; i < 8; ++i) { const int row = i * 4 + (lane >> 4), ch = lane & 15;
      const u32x4 v = *(const u32x4*)(stg + row * PITCH + ch * 16);
      *(u32x4*)(Ow + (long)row * LDO + ch * 8) = v; } }
#undef DMA_K
#undef DMA_V
#undef RESC16
#undef OB_END_M
#undef OB_END_V
#undef KPF_USE
#undef K_PREF
#undef VT0
#undef K_PREF1
#undef LDS_B8
#undef STAMP
#undef BLOCK_END_M
#undef BLOCK_END_V
#undef BLOCK_END_V2
#undef K_PREF23
#undef LGKM_WAIT
#undef MF16
#undef PKV
}

using f32x16b = __attribute__((ext_vector_type(16))) float;
#define MF32(a, b, c) __builtin_amdgcn_mfma_f32_32x32x16_bf16(a, b, c, 0, 0, 0)
#define LGKM_WAIT(n) do { asm volatile("s_waitcnt lgkmcnt(" #n ")" ::: "memory"); SBAR(); } while (0)
__device__ __forceinline__ void softmax32_head(f32x16b (&p)[2], float& alpha, f32x16b& negm, bool first) {
  constexpr float THR2 = THR * 1.4426950408889634f;
  float m0 = vmax3(p[0][0], p[0][1], p[0][2]), m1 = vmax3(p[1][0], p[1][1], p[1][2]);
#pragma unroll
  for (int i = 3; i < 15; i += 2) { m0 = vmax3(m0, p[0][i], p[0][i + 1]); m1 = vmax3(m1, p[1][i], p[1][i + 1]); }
  float pm = vmax3(m0, m1, vmax2(p[0][15], p[1][15]));
  alpha = 1.f;
  if (__builtin_expect(first || !__all(pm <= THR2), 0)) {
    { auto rr = __builtin_amdgcn_permlane32_swap(__float_as_uint(pm), __float_as_uint(pm), false, false); pm = vmax2(__uint_as_float(rr[0]), __uint_as_float(rr[1])); }
    const float dl = first ? pm : fmaxf(pm, 0.f);
    const float nm = negm[0] - dl;
#pragma unroll
    for (int i = 0; i < 16; ++i) { p[0][i] -= dl; p[1][i] -= dl; }
    if (!first) alpha = __builtin_amdgcn_exp2f(-dl);
#pragma unroll
    for (int i = 0; i < 16; ++i) negm[i] = nm;
    asm volatile("" : "+v"(negm));
  }
}
template <int kb> __device__ __forceinline__ void softmax32_kb(f32x16b (&p)[2], float& lsum, bf16x8 (&pa)[4]) {
#pragma unroll
  for (int i = 0; i < 16; ++i) p[kb][i] = __builtin_amdgcn_exp2f(p[kb][i]);
  { typedef float f8 __attribute__((ext_vector_type(8))); typedef float f4 __attribute__((ext_vector_type(4)));
    const f8 a = __builtin_shufflevector(p[kb], p[kb], 0, 1, 2, 3, 4, 5, 6, 7) + __builtin_shufflevector(p[kb], p[kb], 8, 9, 10, 11, 12, 13, 14, 15);
    const f4 b = __builtin_shufflevector(a, a, 0, 1, 2, 3) + __builtin_shufflevector(a, a, 4, 5, 6, 7);
    lsum += (b[0] + b[1]) + (b[2] + b[3]); }
#pragma unroll
  for (int jj = 0; jj < 2; ++jj) { u32x4 w = {cvtpk(p[kb][8 * jj + 0], p[kb][8 * jj + 1]), cvtpk(p[kb][8 * jj + 2], p[kb][8 * jj + 3]), cvtpk(p[kb][8 * jj + 4], p[kb][8 * jj + 5]), cvtpk(p[kb][8 * jj + 6], p[kb][8 * jj + 7])};
    pa[2 * kb + jj] = *reinterpret_cast<bf16x8*>(&w); }
}
template <bool WITH_QK, bool WITH_PV, bool PREF>
__device__ __forceinline__ void mblock32(f32x16b (&p)[2], f32x16b (&oT)[4], const bf16x8 (&kpf)[8], int kx, int vx, const bf16x8 (&qr)[8], const bf16x8 (&pa)[4], const f32x16b& cinit) {
  bf16x8 kf[4][4];
  bf16x8 vf[4][4];
  SBAR();
  if (PP_PRIO == 2) __builtin_amdgcn_s_setprio(1);
#define K_RD(G) do { const int a0_ = kx ^ (64 * (G)), a1_ = kx ^ (64 * (G) + 32); kf[G][0] = lds_rd128<0>(a0_); kf[G][1] = lds_rd128<8192>(a0_); kf[G][2] = lds_rd128<0>(a1_); kf[G][3] = lds_rd128<8192>(a1_); } while (0)
#define QK_STEP(G) do { p[0] = MF32(kf[G][0], qr[2 * (G)], (G) == 0 ? cinit : p[0]); p[1] = MF32(kf[G][1], qr[2 * (G)], (G) == 0 ? cinit : p[1]); p[0] = MF32(kf[G][2], qr[2 * (G) + 1], p[0]); p[1] = MF32(kf[G][3], qr[2 * (G) + 1], p[1]); SBAR(); } while (0)
#define V_RD(js) do { const int a_ = vx ^ (32 * (js)); vf[js][0] = lds_rd128<0>(a_); vf[js][1] = lds_rd128<4096>(a_); vf[js][2] = lds_rd128<8192>(a_); vf[js][3] = lds_rd128<12288>(a_); } while (0)
#define PV_STEP(js) do { _Pragma("unroll") for (int db = 0; db < 4; ++db) oT[db] = MF32(vf[js][db], pa[js], oT[db]); SBAR(); } while (0)
  if constexpr (WITH_QK && WITH_PV) {
    if constexpr (PREF) {
#pragma unroll
      for (int i = 0; i < 4; ++i) { kf[0][i] = kpf[i]; kf[1][i] = kpf[4 + i]; }
      K_RD(2); K_RD(3);
      QK_STEP(0);
      V_RD(0); QK_STEP(1);
      V_RD(1); LGKM_WAIT(12); QK_STEP(2);
      V_RD(2); LGKM_WAIT(12); QK_STEP(3);
      V_RD(3); LGKM_WAIT(12); PV_STEP(0);
      LGKM_WAIT(8); PV_STEP(1);
      LGKM_WAIT(4); PV_STEP(2);
      LGKM_WAIT(0); PV_STEP(3);
    } else {
      K_RD(0); K_RD(1); K_RD(2); K_RD(3);
      LGKM_WAIT(12); QK_STEP(0);
      V_RD(0); LGKM_WAIT(12); QK_STEP(1);
      V_RD(1); LGKM_WAIT(12); QK_STEP(2);
      V_RD(2); LGKM_WAIT(12); QK_STEP(3);
      V_RD(3); LGKM_WAIT(12); PV_STEP(0);
      LGKM_WAIT(8); PV_STEP(1);
      LGKM_WAIT(4); PV_STEP(2);
      LGKM_WAIT(0); PV_STEP(3);
    }
  } else if constexpr (WITH_QK) {
    K_RD(0); K_RD(1); K_RD(2); K_RD(3);
    LGKM_WAIT(12); QK_STEP(0); LGKM_WAIT(8); QK_STEP(1); LGKM_WAIT(4); QK_STEP(2); LGKM_WAIT(0); QK_STEP(3);
  } else {
    LGKM_WAIT(0);
    V_RD(0); V_RD(1); V_RD(2); V_RD(3);
    LGKM_WAIT(12); PV_STEP(0); LGKM_WAIT(8); PV_STEP(1); LGKM_WAIT(4); PV_STEP(2); LGKM_WAIT(0); PV_STEP(3);
  }
  if (PP_PRIO == 2) __builtin_amdgcn_s_setprio(0);
#undef K_RD
#undef QK_STEP
#undef V_RD
#undef PV_STEP
}
__device__ __forceinline__ void attn_pp32_body(const bf16* __restrict__ Qb, const bf16* __restrict__ Kh, const bf16* __restrict__ Vh, bf16* __restrict__ Ob, int seq, lds_ptr lds3) {
  char* lds = (char*)lds3;
  int tid = threadIdx.x; asm volatile("" : "+v"(tid));
  const int wid = __builtin_amdgcn_readfirstlane(tid >> 6), lane = tid & 63, r32 = lane & 31, hi = lane >> 5;
  const bool trailing = wid >= 4;
  constexpr int RDS = 4;
  int koff0, voff0;
  { const int row = 8 * wid + (lane >> 4), ch = (lane & 15) ^ (row & 15); koff0 = row * LDK + ch * 8; voff0 = 1024 * wid + 8 * lane; }
#define DMA_K(t, slot) do { _Pragma("unroll") for (int i_ = 0; i_ < 2; ++i_) __builtin_amdgcn_global_load_lds((const __attribute__((address_space(1))) unsigned*)(Kh + (long)(t) * (KVBLK * LDK) + (i_ ? (koff0 ^ 32) + 512 : koff0)), \
      (__attribute__((address_space(3))) unsigned*)(lds3 + (slot) * (int)SHM_K + (2 * wid + i_) * 1024), 16, 0, 0); } while (0)
#define DMA_V(t, slot) do { _Pragma("unroll") for (int i_ = 0; i_ < 2; ++i_) __builtin_amdgcn_global_load_lds((const __attribute__((address_space(1))) unsigned*)(Vh + (long)(t) * (KVBLK * LDK) + voff0 + 512 * i_), \
      (__attribute__((address_space(3))) unsigned*)(lds3 + RDS * (int)SHM_K + (slot) * (int)SHM_V + (2 * wid + i_) * 1024), 16, 0, 0); } while (0)
#define BLOCK_END_M() do { asm volatile("s_waitcnt vmcnt(0) lgkmcnt(0)" ::: "memory"); SBAR(); __builtin_amdgcn_s_barrier(); asm volatile("" ::: "memory"); SBAR(); } while (0)
#define BLOCK_END_V() do { asm volatile("s_waitcnt lgkmcnt(0)" ::: "memory"); asm volatile("" :: "v"(kpf[0]), "v"(kpf[1]), "v"(kpf[2]), "v"(kpf[3])); asm volatile("" :: "v"(kpf[4]), "v"(kpf[5]), "v"(kpf[6]), "v"(kpf[7]));     SBAR(); __builtin_amdgcn_s_barrier(); asm volatile("" ::: "memory"); SBAR(); } while (0)
#define RESC32() do { if (__any(alpha < 1.f)) { _Pragma("unroll") for (int db = 0; db < 4; ++db) { _Pragma("unroll") for (int i = 0; i < 16; ++i) oT[db][i] *= alpha; } } } while (0)
  const int NT = seq / KVBLK;
  DMA_K(0, 0); DMA_V(0, 0); DMA_K(1, 1); DMA_V(1, 1); DMA_K(2, 2);
  bf16x8 qr[8];
  { const bf16* Qw = Qb + (long)(wid * QBLK + r32) * LDQ + hi * 8;
#pragma unroll
    for (int ks = 0; ks < 8; ++ks) qr[ks] = *reinterpret_cast<const bf16x8*>(Qw + ks * 16); }
  const int lds0 = (int)(uintptr_t)lds;
  const int kad0 = lds0 + r32 * 256 + ((hi ^ (r32 & 15)) << 4);
  const int vad0 = lds0 + RDS * (int)SHM_K + r32 * 128 + ((hi ^ ((r32 >> 1) & 7)) << 4);
  bf16x8 kpf[8];
#define LDS_B8(p_) (*(const __attribute__((address_space(3))) bf16x8*)(unsigned)(p_))
#define K_PREF(slot) do { SBAR(); const int a_ = kad0 + (slot) * (int)SHM_K; kpf[0] = LDS_B8(a_); kpf[1] = LDS_B8(a_ + 8192); kpf[2] = LDS_B8(a_ ^ 32); kpf[3] = LDS_B8((a_ ^ 32) + 8192); SBAR(); } while (0)
#define K_PREF1(slot) do { SBAR(); const int b_ = (kad0 + (slot) * (int)SHM_K) ^ 64; kpf[4] = LDS_B8(b_); kpf[5] = LDS_B8(b_ + 8192); kpf[6] = LDS_B8(b_ ^ 32); kpf[7] = LDS_B8((b_ ^ 32) + 8192); SBAR(); } while (0)
  f32x16b s[2]; float alpha = 1.f, lsum = 0.f; bf16x8 pa[4];
  asm volatile("s_waitcnt vmcnt(0)" ::: "memory"); __builtin_amdgcn_s_barrier(); asm volatile("" ::: "memory");
  if (trailing) { __builtin_amdgcn_s_barrier(); asm volatile("" ::: "memory"); }
  f32x16b oT[4];
  f32x16b negm;
  { float z_ = 0.f; asm volatile("" : "+v"(z_));
#pragma unroll
    for (int i = 0; i < 16; ++i) negm[i] = z_;
#pragma unroll
    for (int db = 0; db < 4; ++db) oT[db] = negm;
    asm volatile("" : "+v"(negm)); }
  pa[0] = qr[0]; pa[1] = qr[0]; pa[2] = qr[0]; pa[3] = qr[0];
  mblock32<true, false, false>(s, oT, kpf, kad0, vad0, qr, pa, negm);
  BLOCK_END_M();
  DMA_K(3, 3); DMA_V(2, 2);
  K_PREF(1);
  softmax32_head(s, alpha, negm, true); softmax32_kb<0>(s, lsum, pa); K_PREF1(1); softmax32_kb<1>(s, lsum, pa);
  BLOCK_END_V();
  int sk = 1, sv = 0;
  for (int t = 1; t < NT; ++t) {
    { f32x16b q[2];
      mblock32<true, true, true>(q, oT, kpf, kad0 + sk * (int)SHM_K, vad0 + sv * (int)SHM_V, qr, pa, negm);
      BLOCK_END_M();
      const int skn = (sk == RDS - 1) ? 0 : sk + 1;
      K_PREF(skn);
      { const int tk_ = (t + 3 < NT) ? t + 3 : NT - 1, tv_ = (t + 2 < NT) ? t + 2 : NT - 1; const int sk2_ = (sk == 0) ? RDS - 1 : sk - 1, sv2_ = (sv == 0) ? RDS - 1 : sv - 1; DMA_K(tk_, sk2_); DMA_V(tv_, sv2_); }
      softmax32_head(q, alpha, negm, false); lsum *= alpha; softmax32_kb<0>(q, lsum, pa); K_PREF1(skn); softmax32_kb<1>(q, lsum, pa);
      RESC32();
      BLOCK_END_V(); }
    sk = (sk == RDS - 1) ? 0 : sk + 1; sv = (sv == RDS - 1) ? 0 : sv + 1;
  }
  asm volatile("s_waitcnt vmcnt(0)" ::: "memory");
  mblock32<false, true, false>(s, oT, kpf, kad0, vad0 + sv * (int)SHM_V, qr, pa, negm);
  BLOCK_END_V();
  if (!trailing) { __builtin_amdgcn_s_barrier(); asm volatile("" ::: "memory"); }
  { auto rr = __builtin_amdgcn_permlane32_swap(__float_as_uint(lsum), __float_as_uint(lsum), false, false); lsum = __uint_as_float(rr[0]) + __uint_as_float(rr[1]); }
  const float rli = __builtin_amdgcn_rcpf(lsum);
  { constexpr int PITCH = 272;
    char* stg = lds + wid * (32 * PITCH);
#pragma unroll
    for (int db = 0; db < 4; ++db)
#pragma unroll
      for (int i4 = 0; i4 < 4; ++i4) { const unsigned w0 = cvtpk(oT[db][4 * i4 + 0] * rli, oT[db][4 * i4 + 1] * rli), w1 = cvtpk(oT[db][4 * i4 + 2] * rli, oT[db][4 * i4 + 3] * rli);
        uint2 w; w.x = w0; w.y = w1; *(uint2*)(stg + r32 * PITCH + (32 * db + 8 * i4 + 4 * hi) * 2) = w; }
    asm volatile("s_waitcnt lgkmcnt(0)" ::: "memory");
    bf16* Ow = Ob + (long)(wid * QBLK) * LDO;
#pragma unroll
    for (int i = 0; i < 8; ++i) { const int row = i * 4 + (lane >> 4), ch = lane & 15;
      const u32x4 v = *(const u32x4*)(stg + row * PITCH + ch * 16);
      *(u32x4*)(Ow + (long)row * LDO + ch * 8) = v; } }
#undef DMA_K
#undef DMA_V
#undef RESC32
#undef K_PREF
#undef K_PREF1
#undef LDS_B8
#undef BLOCK_END_M
#undef BLOCK_END_V
#undef LGKM_WAIT
#undef MF32
}
}

constexpr int NWAVES = 8;
constexpr int N_PHASES = 1 + 8 * NLAYER;

constexpr size_t MiB = 1u << 20;
constexpr size_t WS_CTL = 0, CTL_ZERO_BYTES = 1 * MiB;
constexpr size_t SZ_WIN = (size_t)NIN * DM * 2, SZ_WOUT = (size_t)DM * DM * 2, SZ_WGU = (size_t)NGU * DM * 2, SZ_WDN = (size_t)DM * DFF * 2;
constexpr size_t SZ_WLAYER = SZ_WIN + SZ_WOUT + SZ_WGU + SZ_WDN;
constexpr size_t WS_W0 = 2 * MiB;
constexpr size_t WS_H = WS_W0 + NLAYER * SZ_WLAYER;
constexpr size_t SZ_ACT = (size_t)M_TOK * DM * 2;
constexpr size_t WS_PRE = WS_H + SZ_ACT;
constexpr size_t WS_PROJ = WS_PRE + SZ_ACT;
constexpr size_t WS_MIX = WS_PROJ + (size_t)M_TOK * NIN * 2;
constexpr size_t WS_HID = WS_PROJ;
constexpr size_t WS_KC = WS_MIX + SZ_ACT, SZ_KV = (size_t)NKVH * M_TOK * HD * 2;
constexpr size_t WS_VC = WS_KC + SZ_KV;
constexpr size_t WS_END = WS_VC + SZ_KV;
static_assert(WS_HID + (size_t)M_TOK * DFF * 2 <= WS_KC, "hidden overlay fits proj|mix");
static_assert(SZ_WIN % MiB == 0 && SZ_WOUT % MiB == 0 && SZ_WGU % MiB == 0 && SZ_WDN % MiB == 0, "weight copies MiB-aligned");
constexpr int CW_TMO = 0, CW_CODE = 1;
constexpr int CW_ATTQ = 16384;
constexpr int CW_BAR = 4096;

constexpr int RING_OFF = 0, RING_BYTES = 131072;
constexpr int LDSCTL_OFF = RING_BYTES, MISC_OFF = LDSCTL_OFF + 320;
constexpr int LDS_BYTES = 147456;
static_assert(MISC_OFF + 128 <= LDS_BYTES, "LDS map");

#define GAS __attribute__((address_space(1)))
#define LAS __attribute__((address_space(3)))
typedef unsigned short bf16;
typedef unsigned v4u __attribute__((ext_vector_type(4)));
typedef float f32x4 __attribute__((ext_vector_type(4)));
typedef short bf16x8 __attribute__((ext_vector_type(8)));
typedef GAS unsigned gu32;
typedef GAS unsigned long long gu64;
#define RLX_AGENT __ATOMIC_RELAXED, __HIP_MEMORY_SCOPE_AGENT
#define LDS_WAIT() asm volatile("s_waitcnt lgkmcnt(0)" ::: "memory")
#define VM_WAIT() asm volatile("s_waitcnt vmcnt(0)" ::: "memory")
__device__ __forceinline__ unsigned long long rt() { return __builtin_amdgcn_s_memrealtime(); }
__device__ __forceinline__ unsigned f2bf(float f) { unsigned u = __builtin_bit_cast(unsigned, f); return (u + 0x7fffu + ((u >> 16) & 1u)) >> 16; }
__device__ __forceinline__ unsigned pk2(float lo, float hi) { return f2bf(lo) | (f2bf(hi) << 16); }
#define XB_TMO      128
#define XB_XCNT(j)  (256  + 64 * (j))
#define XB_XSUB(j)  (1280 + 64 * (j))
#define XB_XGEN(j)  (2304 + 64 * (j))
#define XB_TOP      3328
#define XB_TOPGEN   3392
#define XCD_BAR_WORDS 3456
#define XB_SPIN_CAP (1u << 18)

__device__ __forceinline__ unsigned xb_ld(unsigned* p)              { return __hip_atomic_load(p, __ATOMIC_RELAXED, __HIP_MEMORY_SCOPE_AGENT); }
__device__ __forceinline__ unsigned xb_add(unsigned* p, unsigned v) { return __hip_atomic_fetch_add(p, v, __ATOMIC_RELAXED, __HIP_MEMORY_SCOPE_AGENT); }
__device__ __forceinline__ unsigned xb_xcc_id() { return (unsigned)__builtin_amdgcn_s_getreg((3 << 11) | 20) & 0xFu; }
#define XB_SPIN(cond, bar) do { unsigned _sp = 0; while (cond) { __builtin_amdgcn_s_sleep(1); \
    if ((++_sp & 255u) == 0u) { if (xb_ld(&(bar)[XB_TMO])) break; if (_sp > XB_SPIN_CAP) { atomicAdd(&(bar)[XB_TMO], 1u); break; } } } } while (0)

struct XcdBarrier {
    unsigned* bar; unsigned x;
    volatile LAS unsigned* st;
};

__device__ __forceinline__ XcdBarrier xcd_barrier_post(unsigned* bar, volatile LAS unsigned* st) {
    XcdBarrier b; b.bar = bar; b.x = xb_xcc_id(); b.st = st;
    if (threadIdx.x == 0) (void)xb_add(&bar[XB_XCNT(b.x)], 1u);
    return b;
}
__device__ __forceinline__ void xcd_barrier_complete(unsigned* bar, unsigned x, unsigned& nloc, unsigned& nx) {
    const unsigned G = gridDim.x * gridDim.y * gridDim.z;
    unsigned sum, cnt, mine, sp = 0u;
    for (;;) {
        sum = 0u; cnt = 0u; mine = 0u;
#pragma unroll
        for (unsigned j = 0; j < 16; ++j) { const unsigned c = xb_ld(&bar[XB_XCNT(j)]); sum += c; cnt += (c > 0u) ? 1u : 0u; mine = (j == x) ? c : mine; }
        if (sum == G) break;
        __builtin_amdgcn_s_sleep(1);
        if ((++sp & 255u) == 0u) { if (xb_ld(&bar[XB_TMO])) break; if (sp > XB_SPIN_CAP) { atomicAdd(&bar[XB_TMO], 1u); break; } }
    }
    nloc = mine > 0u ? mine : 1u; nx = cnt > 0u ? cnt : 1u;
}

__device__ __forceinline__ void xcd_barrier(const XcdBarrier& b) {
    asm volatile("s_waitcnt vmcnt(0)" ::: "memory");
    __syncthreads();
    if (threadIdx.x == 0) {
        unsigned* bar = b.bar;
        __builtin_amdgcn_s_waitcnt(0);
        unsigned nloc = b.st[0], nx = b.st[1];
        if (nloc == 0u) { xcd_barrier_complete(bar, b.x, nloc, nx); b.st[0] = nloc; b.st[1] = nx; }
        const unsigned old = xb_add(&bar[XB_XSUB(b.x)], 1u);
        const unsigned gen = old / nloc;
        if (old + 1u == (gen + 1u) * nloc) {
            __builtin_amdgcn_fence(__ATOMIC_RELEASE, "agent");
            asm volatile("s_waitcnt vmcnt(0)" ::: "memory");
            const unsigned og = xb_add(&bar[XB_TOP], 1u);
            const unsigned tg = og / nx;
            if (og + 1u == (tg + 1u) * nx) xb_add(&bar[XB_TOPGEN], 1u);
            else XB_SPIN(xb_ld(&bar[XB_TOPGEN]) == tg, bar);
            __builtin_amdgcn_fence(__ATOMIC_ACQUIRE, "agent");
            xb_add(&bar[XB_XGEN(b.x)], 1u);
            asm volatile("s_waitcnt vmcnt(0)" ::: "memory");
        } else {
            XB_SPIN(xb_ld(&bar[XB_XGEN(b.x)]) == gen, bar);
            __builtin_amdgcn_fence(__ATOMIC_ACQUIRE, "agent");
            asm volatile("s_waitcnt vmcnt(0)" ::: "memory");
        }
    }
    __syncthreads();
}

struct Frame {
    LAS unsigned char* lds;
    volatile LAS unsigned* MISC;
    gu32* ctl;
    int tid, lane, wave;
    int vcu, G;
};
typedef unsigned v2u __attribute__((ext_vector_type(2)));

__device__ __forceinline__ float wave_sum(float v) {
#pragma unroll
    for (int o = 1; o < 64; o <<= 1) v += __shfl_xor(v, o);
    return v;
}
__device__ __forceinline__ float bf_lo(unsigned w) { return __uint_as_float(w << 16); }
__device__ __forceinline__ float bf_hi(unsigned w) { return __uint_as_float(w & 0xffff0000u); }
__device__ __forceinline__ unsigned pkbf(float lo, float hi) { return pg8::cvt_pk_bf16(lo, hi); }
__device__ __forceinline__ void seq_of(int m, int& s0, int& slen) { if (m < SEQ_P) { s0 = 0; slen = SEQ_P; } else { s0 = SEQ_P + ((m - SEQ_P) / SEQ_S) * SEQ_S; slen = SEQ_S; } }
__device__ __forceinline__ const float* xin_row(const float* xp, const float* xs, int m) { return m < SEQ_P ? xp + (size_t)m * DM : xs + (size_t)(m - SEQ_P) * DM; }

struct TrItem { const GAS float* src; int ldw; bf16* dst; int ldo; };
__device__ __forceinline__ void tr_load(float (&t)[32], const TrItem& I, int lane) {
    const GAS float* src = I.src + (size_t)(lane >> 5) * I.ldw + (lane & 31);
#pragma unroll
    for (int i = 0; i < 32; ++i) t[i] = __builtin_nontemporal_load(src + (size_t)(2 * i) * I.ldw);
}
__device__ __forceinline__ void tr_store(const float (&t)[32], const TrItem& I, LAS float* scr, int lane) {
#pragma unroll
    for (int i = 0; i < 32; ++i) scr[(2 * i + (lane >> 5)) * 33 + (lane & 31)] = t[i];
    LDS_WAIT(); asm volatile("" ::: "memory");
    const int c = lane & 7;
#pragma unroll
    for (int j = 0; j < 4; ++j) { const int n = (lane >> 3) + 8 * j; const LAS float* s = scr + (8 * c) * 33 + n;
        v4u o; o.x = pkbf(s[0 * 33], s[1 * 33]); o.y = pkbf(s[2 * 33], s[3 * 33]); o.z = pkbf(s[4 * 33], s[5 * 33]); o.w = pkbf(s[6 * 33], s[7 * 33]);
        if (TR_NT_STORE) __builtin_nontemporal_store(o, (GAS v4u*)(I.dst + (size_t)n * I.ldo + 8 * c)); else *(GAS v4u*)(I.dst + (size_t)n * I.ldo + 8 * c) = o; }
    LDS_WAIT(); asm volatile("" ::: "memory");
}
__device__ __forceinline__ void fold_item(const float* pool_w, const float* pscale, const float* Wout, bf16* WT, int item, int lane, LAS float* scr) {
    const int nblk = item & 63, cblk = (item >> 6) & 15, g = item >> 10;
    const int n = nblk * 64 + lane, c0 = cblk * 16;
    { const GAS float* pw = (const GAS float*)pool_w + (size_t)g * 65536 + (size_t)c0 * 256; const GAS float* sc = (const GAS float*)pscale + g * 256;
      float scv[4];
#pragma unroll
      for (int q = 0; q < 4; ++q) scv[q] = sc[64 * q + lane];
      float pv_[64];
#pragma unroll
      for (int i = 0; i < 64; ++i) pv_[i] = pw[64 * i + lane];
#pragma unroll
      for (int i = 0; i < 64; ++i) scr[64 * i + lane] = pv_[i] * scv[i & 3];
      LDS_WAIT(); asm volatile("" ::: "memory"); }
    const GAS float* wo = (const GAS float*)Wout + (size_t)(MX_P + g * 256) * DM + n;
    float acc[16];
#pragma unroll
    for (int cc = 0; cc < 16; ++cc) acc[cc] = 0.f;
    for (int d0 = 0; d0 < 256; d0 += 64) {
        float wv[64];
#pragma unroll
        for (int dd = 0; dd < 64; ++dd) wv[dd] = wo[(size_t)(d0 + dd) * DM];
#pragma unroll
        for (int d4 = 0; d4 < 16; ++d4) { f32x4 pv[16];
#pragma unroll
            for (int cc = 0; cc < 16; ++cc) pv[cc] = *(const LAS f32x4*)(scr + cc * 256 + d0 + 4 * d4);
#pragma unroll
            for (int cc = 0; cc < 16; ++cc) { acc[cc] = fmaf(pv[cc].x, wv[4 * d4 + 0], acc[cc]); acc[cc] = fmaf(pv[cc].y, wv[4 * d4 + 1], acc[cc]); acc[cc] = fmaf(pv[cc].z, wv[4 * d4 + 2], acc[cc]); acc[cc] = fmaf(pv[cc].w, wv[4 * d4 + 3], acc[cc]); } }
    }
    LDS_WAIT(); asm volatile("" ::: "memory");
    v4u o; o.x = pkbf(acc[0], acc[1]); o.y = pkbf(acc[2], acc[3]); o.z = pkbf(acc[4], acc[5]); o.w = pkbf(acc[6], acc[7]);
    v4u o2; o2.x = pkbf(acc[8], acc[9]); o2.y = pkbf(acc[10], acc[11]); o2.z = pkbf(acc[12], acc[13]); o2.w = pkbf(acc[14], acc[15]);
    GAS v4u* dst = (GAS v4u*)(WT + (size_t)n * DM + MX_P + g * 256 + c0); dst[0] = o; dst[1] = o2;
}
struct LayerW { bf16 *win, *wout, *wgu, *wdn; };
__device__ __forceinline__ LayerW layer_w(unsigned char* ws, int l) { LayerW w; unsigned char* b = ws + WS_W0 + (size_t)l * SZ_WLAYER;
    w.win = (bf16*)b; w.wout = (bf16*)(b + SZ_WIN); w.wgu = (bf16*)(b + SZ_WIN + SZ_WOUT); w.wdn = (bf16*)(b + SZ_WIN + SZ_WOUT + SZ_WGU); return w; }

constexpr int I_IN = (DM / 64) * (NIN / 32), I_OUT = (MX_P / 64) * (DM / 32), I_G = (DM / 64) * (DFF / 32), I_D = (DFF / 64) * (DM / 32), I_FOLD = 4 * 16 * 64;
constexpr int I_TR_LAYER = I_IN + I_OUT + 2 * I_G + I_D;

__device__ __forceinline__ void prenorm_phase(Frame& F, const float* xp, const float* xs, const float* g, bf16* H) {
    LAS f32x4* G1 = (LAS f32x4*)(F.lds + RING_OFF);
    for (int i = F.tid; i < DM / 4; i += NWAVES * 64) G1[i] = ((const GAS f32x4*)g)[i];
    __syncthreads();
    const int gw = F.vcu * NWAVES + F.wave, NGW = F.G * NWAVES;
    for (int m0_ = gw; m0_ < M_TOK * ((PROBE_DUP & 128) ? 2 : 1); m0_ += NGW) { const int m = m0_ % M_TOK;
        const GAS f32x4* xr = (const GAS f32x4*)xin_row(xp, xs, m) + F.lane;
        f32x4 v[16]; float s = 0.f;
#pragma unroll
        for (int j = 0; j < 16; ++j) v[j] = __builtin_nontemporal_load(xr + 64 * j);
#pragma unroll
        for (int j = 0; j < 16; ++j) s += (v[j].x * v[j].x + v[j].y * v[j].y) + (v[j].z * v[j].z + v[j].w * v[j].w);
        const float rstd = 1.0f / sqrtf(wave_sum(s) * (1.f / DM) + RMS_EPS);
        GAS v2u* o8 = (GAS v2u*)(H + (size_t)m * DM) + F.lane;
#pragma unroll
        for (int j = 0; j < 16; ++j) { const f32x4 gg = G1[F.lane + 64 * j]; v2u o; o.x = pkbf(v[j].x * rstd * gg.x, v[j].y * rstd * gg.y); o.y = pkbf(v[j].z * rstd * gg.z, v[j].w * rstd * gg.w); o8[64 * j] = o; }
    }
    __syncthreads();
}
template <int XIN, int XOUT>
__device__ __forceinline__ void resnorm_phase(Frame& F, const float* xp, const float* xs, const bf16* xin16, float* out, bf16* xout16, const bf16* PRE, const float* g1, const float* g2, bf16* H) {
    LAS f32x4* G1 = (LAS f32x4*)(F.lds + RING_OFF); LAS f32x4* G2 = G1 + DM / 4;
    for (int i = F.tid; i < DM / 4; i += NWAVES * 64) { G1[i] = ((const GAS f32x4*)g1)[i]; if (g2) G2[i] = ((const GAS f32x4*)g2)[i]; }
    __syncthreads();
    const int gw = F.vcu * NWAVES + F.wave, NGW = F.G * NWAVES;
    for (int m = gw; m < M_TOK; m += NGW) {
        const GAS v2u* pr = (const GAS v2u*)(PRE + (size_t)m * DM) + F.lane;
        f32x4 v[16]; v2u p[16]; float s = 0.f;
        if (XIN == 0) { const GAS f32x4* xr = (const GAS f32x4*)xin_row(xp, xs, m) + F.lane;
#pragma unroll
            for (int j = 0; j < 16; ++j) { v[j] = xr[64 * j]; p[j] = pr[64 * j]; } }
        else { const GAS v2u* xr = (const GAS v2u*)(xin16 + (size_t)m * DM) + F.lane; v2u xb[16];
#pragma unroll
            for (int j = 0; j < 16; ++j) { xb[j] = xr[64 * j]; p[j] = pr[64 * j]; }
#pragma unroll
            for (int j = 0; j < 16; ++j) { v[j].x = bf_lo(xb[j].x); v[j].y = bf_hi(xb[j].x); v[j].z = bf_lo(xb[j].y); v[j].w = bf_hi(xb[j].y); } }
#pragma unroll
        for (int j = 0; j < 16; ++j) { const float a = bf_lo(p[j].x), b = bf_hi(p[j].x), c = bf_lo(p[j].y), d = bf_hi(p[j].y); s += (a * a + b * b) + (c * c + d * d); }
        const float rstd1 = 1.0f / sqrtf(wave_sum(s) * (1.f / DM) + RMS_EPS);
        GAS f32x4* xo = (GAS f32x4*)(out + (size_t)m * DM) + F.lane;
        GAS v2u* xo16 = (GAS v2u*)(xout16 + (size_t)m * DM) + F.lane;
        float s2 = 0.f;
#pragma unroll
        for (int j = 0; j < 16; ++j) { asm volatile("" ::: "memory"); const f32x4 gg = G1[F.lane + 64 * j];
            v[j].x += bf_lo(p[j].x) * rstd1 * gg.x; v[j].y += bf_hi(p[j].x) * rstd1 * gg.y; v[j].z += bf_lo(p[j].y) * rstd1 * gg.z; v[j].w += bf_hi(p[j].y) * rstd1 * gg.w;
            if (XOUT == 0) xo[64 * j] = v[j];
            else { v2u o; o.x = pkbf(v[j].x, v[j].y); o.y = pkbf(v[j].z, v[j].w); xo16[64 * j] = o;
                   v[j].x = bf_lo(o.x); v[j].y = bf_hi(o.x); v[j].z = bf_lo(o.y); v[j].w = bf_hi(o.y); }
            s2 += (v[j].x * v[j].x + v[j].y * v[j].y) + (v[j].z * v[j].z + v[j].w * v[j].w); }
        if (g2) {
            const float rstd2 = 1.0f / sqrtf(wave_sum(s2) * (1.f / DM) + RMS_EPS);
            GAS v2u* o8 = (GAS v2u*)(H + (size_t)m * DM) + F.lane;
#pragma unroll
            for (int j = 0; j < 16; ++j) { asm volatile("" ::: "memory"); const f32x4 gg = G2[F.lane + 64 * j]; v2u o; o.x = pkbf(v[j].x * rstd2 * gg.x, v[j].y * rstd2 * gg.y); o.y = pkbf(v[j].z * rstd2 * gg.z, v[j].w * rstd2 * gg.w); o8[64 * j] = o; }
        }
    }
    __syncthreads();
}

__device__ __forceinline__ void unpack8(const v4u w, float (&x)[8]) { x[0] = bf_lo(w.x); x[1] = bf_hi(w.x); x[2] = bf_lo(w.y); x[3] = bf_hi(w.y); x[4] = bf_lo(w.z); x[5] = bf_hi(w.z); x[6] = bf_lo(w.w); x[7] = bf_hi(w.w); }
__device__ __forceinline__ v4u pack8(const float (&x)[8]) { v4u o; o.x = pkbf(x[0], x[1]); o.y = pkbf(x[2], x[3]); o.z = pkbf(x[4], x[5]); o.w = pkbf(x[6], x[7]); return o; }
template <int HW> __device__ __forceinline__ void pool_item(const bf16* col, bf16* dst, int m0, int s0, int s1) {
    v2u raw[8 + 2 * HW];
#pragma unroll
    for (int j = 0; j < 8 + 2 * HW; ++j) { const int mm = m0 - HW + j; const bool ok = (mm >= s0) && (mm < s1); raw[j] = *(const GAS v2u*)(col + (size_t)(ok ? mm : m0) * NIN); if (!ok) raw[j] = (v2u){0u, 0u}; }
    float S[4] = {0.f, 0.f, 0.f, 0.f};
#pragma unroll
    for (int j = 0; j < 2 * HW; ++j) { S[0] += bf_lo(raw[j].x); S[1] += bf_hi(raw[j].x); S[2] += bf_lo(raw[j].y); S[3] += bf_hi(raw[j].y); }
#pragma unroll
    for (int i = 0; i < 8; ++i) { const int m = m0 + i;
        const int lo = (m - HW > s0) ? m - HW : s0, hi = (m + HW < s1) ? m + HW : s1;
        const float rc = 1.0f / (float)(hi - lo);
        const v2u c = raw[i + HW];
        v2u o; o.x = pkbf(S[0] * rc - bf_lo(c.x), S[1] * rc - bf_hi(c.x)); o.y = pkbf(S[2] * rc - bf_lo(c.y), S[3] * rc - bf_hi(c.y));
        *(GAS v2u*)(dst + (size_t)m * DM) = o;
        if (i < 7) { const v2u a = raw[i + 2 * HW], b = raw[i];
            S[0] += bf_lo(a.x) - bf_lo(b.x); S[1] += bf_hi(a.x) - bf_hi(b.x); S[2] += bf_lo(a.y) - bf_lo(b.y); S[3] += bf_hi(a.y) - bf_hi(b.y); } }
}
__device__ __forceinline__ void mixer_elem_phase(Frame& F, bf16* PROJ, bf16* MIX, bf16* KC, bf16* VC, const float* qg, const float* kg, const float* conv_w, const int part) {
    const int lane = F.lane;
    const int gw = (part == 1) ? ((int)blockIdx.x - 128) * NWAVES + F.wave : F.vcu * NWAVES + F.wave, NGW = (part == 1) ? 128 * NWAVES : F.G * NWAVES;
    constexpr int NA = M_TOK, NA2 = 4 * (M_TOK / 64), NB = (M_TOK / 8) * 2;
    const int a0 = (part == 2) ? NA * 5 / 8 : 0, a1 = (part == 1) ? NA * 5 / 8 : NA;
    const int a20 = (part == 2) ? NA2 * 5 / 8 : 0, a21 = (part == 1) ? NA2 * 5 / 8 : NA2;
    const int b0 = (part == 2) ? NB * 5 / 8 : 0, b1 = (part == 1) ? NB * 5 / 8 : NB;
    {
        const int s = lane & 15;
        float qgv[8], kgv[8], invf[8];
#pragma unroll
        for (int e = 0; e < 8; ++e) { qgv[e] = qg[8 * s + e]; kgv[e] = kg[8 * s + e]; invf[e] = __builtin_amdgcn_exp2f(-(float)(8 * (s & 3) + e) * (13.287712379549449f / 32.0f)); }
        const float sgn = (s & 4) ? 1.f : -1.f;
        for (int m = a0 + gw; m < a1; m += NGW) {
            int s0, slen; seq_of(m, s0, slen); const int t = m - s0;
            const float pos = (s < 8) ? (float)(t >> 6) : (float)(t & 63);
            float cs[8], sn[8];
#pragma unroll
            for (int e = 0; e < 8; ++e) { float rev = (pos * invf[e]) * 0.15915494309189535f; rev -= floorf(rev); cs[e] = __builtin_amdgcn_cosf(rev); sn[e] = __builtin_amdgcn_sinf(rev); }
            GAS v4u* rowp = (GAS v4u*)(PROJ + (size_t)m * NIN) + lane;
            v4u w[6];
#pragma unroll
            for (int ps = 0; ps < 6; ++ps) w[ps] = rowp[64 * ps];
            const size_t kvoff = ((size_t)(lane >> 4) * M_TOK + m) * HD + 8 * s;
#pragma unroll
            for (int ps = 0; ps < 5; ++ps) {
                float x[8]; unpack8(w[ps], x);
                float ss = 0.f;
#pragma unroll
                for (int e = 0; e < 8; ++e) ss += x[e] * x[e];
                ss += __shfl_xor(ss, 1); ss += __shfl_xor(ss, 2); ss += __shfl_xor(ss, 4); ss += __shfl_xor(ss, 8);
                const float rstd = 1.0f / sqrtf(ss * (1.f / HD) + RMS_EPS);
                float y[8], o[8];
#pragma unroll
                for (int e = 0; e < 8; ++e) y[e] = x[e] * rstd * (ps < 4 ? qgv[e] : kgv[e]);
#pragma unroll
                for (int e = 0; e < 8; ++e) { const float pe = __shfl_xor(y[e], 4); o[e] = y[e] * cs[e] + sgn * pe * sn[e]; if (Q_PRESCALE && ps < 4) o[e] *= 0.088388347648318440f * 1.4426950408889634f; }
                if (ps < 4) rowp[64 * ps] = pack8(o); else *(GAS v4u*)(KC + kvoff) = pack8(o);
            }
            if (!(PP_VT && ATTN_DMA >= 3)) *(GAS v4u*)(VC + kvoff) = w[5];
        }
    }
    if (PP_VT && ATTN_DMA >= 3) {
        for (int it = a20 + gw; it < a21; it += NGW) {
            const int h = it / (M_TOK / 64), tile = it - h * (M_TOK / 64);
            const GAS unsigned short* src = (const GAS unsigned short*)(PROJ + (size_t)(tile * 64) * NIN + C_V + h * HD);
            GAS v4u* dst = (GAS v4u*)(VC + ((size_t)h * M_TOK + tile * 64) * HD);
#pragma unroll 4
            for (int cc = 0; cc < 16; ++cc) {
                const int d = lane + 64 * (cc & 1), cp = cc >> 1, chunk = cp ^ ((d >> 1) & 7), j = chunk >> 2, g = chunk & 3;
                unsigned v[8];
#pragma unroll
                for (int i = 0; i < 8; ++i) { const int key = (ATTN_DMA == 4) ? 32 * (chunk >> 2) + 16 * ((chunk >> 1) & 1) + 8 * (i >> 2) + 4 * (chunk & 1) + (i & 3)
                                                                  : 32 * j + 16 * (i >> 2) + 4 * g + (i & 3); v[i] = src[(size_t)key * NIN + d]; }
                v4u o; o.x = v[0] | (v[1] << 16); o.y = v[2] | (v[3] << 16); o.z = v[4] | (v[5] << 16); o.w = v[6] | (v[7] << 16);
                dst[d * 8 + cp] = o;
            }
        }
    }
    for (int rep_ = 0; rep_ < ((PROBE_DUP & 16) ? 2 : 1); ++rep_) {
    for (int it = b0 + gw; it < b1; it += NGW) {
        const int m0 = (it >> 1) * 8, c0 = (it & 1) * 512 + lane * 8;
        int s0, slen; seq_of(m0, s0, slen); const int s1 = s0 + slen;
        v4u hraw[10], craw[10], braw[8];
#pragma unroll
        for (int j = 0; j < 10; ++j) { const int mm = m0 - 1 + j; const bool ok = (mm >= s0) && (mm < s1); const bf16* r_ = PROJ + (size_t)(ok ? mm : m0) * NIN + c0;
            hraw[j] = *(const GAS v4u*)(r_ + C_CH); craw[j] = *(const GAS v4u*)(r_ + C_CC); if (!ok) { hraw[j] = (v4u){0u, 0u, 0u, 0u}; } }
#pragma unroll
        for (int i = 0; i < 8; ++i) braw[i] = *(const GAS v4u*)(PROJ + (size_t)(m0 + i) * NIN + C_CB + c0);
        float w0[8], w1[8], w2[8];
#pragma unroll
        for (int e = 0; e < 8; ++e) { w0[e] = conv_w[c0 + e]; w1[e] = conv_w[1024 + c0 + e]; w2[e] = conv_w[2048 + c0 + e]; }
        float up[8], uc[8], un[8];
#define MK_U(dst, j) do { float a_[8], b_[8]; unpack8(hraw[j], a_); unpack8(craw[j], b_); _Pragma("unroll") for (int e = 0; e < 8; ++e) dst[e] = a_[e] * b_[e]; } while (0)
        MK_U(up, 0); MK_U(uc, 1);
#pragma unroll
        for (int i = 0; i < 8; ++i) {
            MK_U(un, i + 2);
            float gb[8], o[8]; unpack8(braw[i], gb);
#pragma unroll
            for (int e = 0; e < 8; ++e) { o[e] = gb[e] * (up[e] * w0[e] + uc[e] * w1[e] + un[e] * w2[e]); up[e] = uc[e]; uc[e] = un[e]; }
            *(GAS v4u*)(MIX + (size_t)(m0 + i) * DM + MX_C + c0) = pack8(o); }
#undef MK_U
    }
    if (part != 1) for (int it = gw; it < (M_TOK / 8) * 4; it += NGW) {
        const int m0 = (it >> 2) * 8, g = it & 3;
        int s0, slen; seq_of(m0, s0, slen);
        const bf16* col = PROJ + C_PU + g * 256 + lane * 4; bf16* dst = MIX + MX_P + g * 256 + lane * 4;
        if (g == 0) pool_item<1>(col, dst, m0, s0, s0 + slen); else if (g == 1) pool_item<2>(col, dst, m0, s0, s0 + slen); else if (g == 2) pool_item<4>(col, dst, m0, s0, s0 + slen); else pool_item<8>(col, dst, m0, s0, s0 + slen);
    }
    }
}

__device__ __forceinline__ void attn_phase(Frame& F, const bf16* PROJ, const bf16* KC, const bf16* VC, bf16* MIX, int qbase, const float* qg, const float* kg) {
    bool sumvote;
    { float mq = fmaxf(fabsf(qg[F.lane]), fabsf(qg[F.lane + 64])), mk = fmaxf(fabsf(kg[F.lane]), fabsf(kg[F.lane + 64]));
#pragma unroll
      for (int o = 1; o < 64; o <<= 1) { mq = fmaxf(mq, __shfl_xor(mq, o)); mk = fmaxf(mk, __shfl_xor(mk, o)); }
      sumvote = __builtin_amdgcn_readfirstlane((mq * mk < 3.5f) ? 1 : 0) != 0; }
    const int x = F.vcu >> 5; const bool queued = false;
    volatile LAS int* slot = (volatile LAS int*)(F.lds + RING_OFF + (int)attn128::SHM_ATTN_DMA);
    for (int it = 0;; ++it) {
        int u;
        if (queued) {
            if (F.tid == 0) slot[0] = (int)__hip_atomic_fetch_add(F.ctl + qbase + 64 * x, 1u, RLX_AGENT);
            __syncthreads(); const int k = slot[0]; __syncthreads();
            if (k >= 192) break;
            u = (k >> 5) * 256 + 32 * x + (k & 31);
        } else if (ATT_LASTQ && F.G == 256 && it >= 5) {
            if (F.tid == 0) slot[0] = (int)__hip_atomic_fetch_add(F.ctl + qbase + 64 * x, 1u, RLX_AGENT);
            __syncthreads(); const int k = slot[0]; __syncthreads();
            if (k >= 32) break;
            u = 5 * 256 + 32 * x + k;
        } else if (PROBE_HALF == 2) { if (F.vcu & 1) break; u = (F.vcu >> 1) + it * 128; if (u >= 1536) break; }
        else if (PROBE_HALF == 4) { if (F.vcu & 3) break; u = (F.vcu >> 2) + it * 64; if (u >= 1536) break; }
        else { u = F.vcu + it * F.G; if (u >= 1536) break; }
        int seq, kvh, head, qb;
        if (u < 1024) { const int i = u >> 8, v = u & 255, xx = v >> 5, j = v & 31; seq = 0; kvh = i; qb = 8 * xx + (j & 7); head = kvh * 4 + (j >> 3); }
        else { const int u2 = u - 1024, i = u2 >> 8, v = u2 & 255, xx = v >> 5, j = v & 31, e = i * 8 + xx, sk = e >> 1; seq = 1 + (sk >> 2); kvh = sk & 3; qb = 8 * (e & 1) + (j & 7); head = kvh * 4 + (j >> 3); }
        const int row0 = seq == 0 ? 0 : SEQ_P + (seq - 1) * SEQ_S, slen = seq == 0 ? SEQ_P : SEQ_S;
        const attn128::bf16* Qb = (const attn128::bf16*)(PROJ + (size_t)(row0 + qb * 256) * NIN + C_Q + head * HD);
        const attn128::bf16* Kh = (const attn128::bf16*)(KC + ((size_t)kvh * M_TOK + row0) * HD);
        const attn128::bf16* Vh = (const attn128::bf16*)(VC + ((size_t)kvh * M_TOK + row0) * HD);
        attn128::bf16* Ob = (attn128::bf16*)(MIX + (size_t)(row0 + qb * 256) * DM + MX_A + head * HD);
        #if ATTN_DMA == 2
#if PROBE_CLK == 4 || PROBE_CLK == 5
        if (blockIdx.x == 0 && it == 0 && F.tid == 0) { const unsigned long long c_ = __builtin_amdgcn_s_memtime(), w_ = __builtin_amdgcn_s_memrealtime(); F.MISC[20] = (unsigned)c_; F.MISC[21] = (unsigned)(c_ >> 32); F.MISC[22] = (unsigned)w_; F.MISC[23] = (unsigned)(w_ >> 32); }
#endif
        attn128::attn_pp_body(Qb, Kh, Vh, Ob, slen, F.lds + RING_OFF);
#if PROBE_CLK == 4 || PROBE_CLK == 5
        if (blockIdx.x == 0 && it == 0 && F.tid == 0) { const unsigned long long c_ = __builtin_amdgcn_s_memtime(), w_ = __builtin_amdgcn_s_memrealtime();
            const unsigned long long c0_ = ((unsigned long long)F.MISC[21] << 32) | F.MISC[20], w0_ = ((unsigned long long)F.MISC[23] << 32) | F.MISC[22];
            F.MISC[16] += (PROBE_CLK == 4) ? (unsigned)((c_ - c0_) / 256 / 10)
                                           : (unsigned)((w_ - w0_) * 10 / 256); }
#endif
#elif ATTN_DMA == 4
        attn128::attn_pp32_body(Qb, Kh, Vh, Ob, slen, F.lds + RING_OFF);
#elif ATTN_DMA == 3
        if (PP_SUMVOTE == 2) attn128::attn_pp16_body<true>(Qb, Kh, Vh, Ob, slen, F.lds + RING_OFF); else if (PP_SUMVOTE && sumvote) attn128::attn_pp16_body<true>(Qb, Kh, Vh, Ob, slen, F.lds + RING_OFF); else attn128::attn_pp16_body<false>(Qb, Kh, Vh, Ob, slen, F.lds + RING_OFF);
#elif ATTN_DMA
        attn128::attn_dma_body(Qb, Kh, Vh, Ob, slen, F.lds + RING_OFF);
#else
        attn128::attn_dense_body<attn128::bf16>(Qb, Kh, Vh, Ob, slen, (char*)F.lds + RING_OFF);
#endif
        __syncthreads();
    }
}

struct Args { const float* in[16]; float* out; unsigned char* ws; int ph_lo, ph_hi; };
typedef const __attribute__((address_space(4))) Args* KArgs;
__device__ __forceinline__ KArgs kargs() { KArgs p = (KArgs)__builtin_amdgcn_kernarg_segment_ptr(); asm volatile("" : "+s"(p)); return p; }
enum { I_XP = 0, I_XS, I_LN_MIX_PRE, I_LN_MIX_POST, I_LN_FFN_PRE, I_LN_FFN_POST, I_QN, I_KN, I_WIN, I_CONVW, I_POOLW, I_PSCALE, I_WOUT, I_WGATE, I_WUP, I_WDOWN };
__device__ __forceinline__ Frame make_frame(unsigned char* ws) {
    extern __shared__ __attribute__((aligned(16))) unsigned char lds[];
    Frame F; int t = threadIdx.x; asm volatile("" : "+v"(t));
    F.lds = (LAS unsigned char*)lds; F.MISC = (volatile LAS unsigned*)(F.lds + MISC_OFF); F.ctl = (gu32*)(ws + WS_CTL);
    F.tid = t; F.lane = t & 63; F.wave = __builtin_amdgcn_readfirstlane(t >> 6);
    F.G = gridDim.x; { const int bx = blockIdx.x; F.vcu = (F.G % 8 == 0) ? (bx % 8) * (F.G / 8) + bx / 8 : bx; }
    return F;
}

__device__ __forceinline__ void convert_rest(Frame& F, KArgs ka, unsigned char* ws) {
    LAS float* scr = (LAS float*)(F.lds + RING_OFF + F.wave * 16384);
    const int gw = F.vcu * NWAVES + F.wave, NGW = F.G * NWAVES;
    for (int it = I_IN + gw; it < NLAYER * I_TR_LAYER; it += NGW) {
        const int l = it / I_TR_LAYER; int r = it % I_TR_LAYER; const LayerW W = layer_w(ws, l); TrItem I;
        if (r < I_IN) { const int kb = r / (NIN / 32), nb = r % (NIN / 32); I.src = (const GAS float*)ka->in[I_WIN] + (size_t)l * DM * NIN + (size_t)(64 * kb) * NIN + 32 * nb; I.ldw = NIN; I.dst = W.win + (size_t)(32 * nb) * DM + 64 * kb; I.ldo = DM; }
        else if ((r -= I_IN) < I_OUT) { const int kb = r / (DM / 32), nb = r % (DM / 32); I.src = (const GAS float*)ka->in[I_WOUT] + (size_t)l * DM * DM + (size_t)(64 * kb) * DM + 32 * nb; I.ldw = DM; I.dst = W.wout + (size_t)(32 * nb) * DM + 64 * kb; I.ldo = DM; }
        else if ((r -= I_OUT) < 2 * I_G) { const int up = r >= I_G; if (up) r -= I_G; const int kb = r / (DFF / 32), nb = r % (DFF / 32), n0 = 32 * nb;
            I.src = (const GAS float*)(up ? ka->in[I_WUP] : ka->in[I_WGATE]) + (size_t)l * DM * DFF + (size_t)(64 * kb) * DFF + n0; I.ldw = DFF; I.dst = W.wgu + (size_t)((n0 >> 7) * 256 + (n0 & 127) + (up ? 128 : 0)) * DM + 64 * kb; I.ldo = DM; }
        else { r -= 2 * I_G; const int kb = r / (DM / 32), nb = r % (DM / 32); I.src = (const GAS float*)ka->in[I_WDOWN] + (size_t)l * DFF * DM + (size_t)(64 * kb) * DM + 32 * nb; I.ldw = DM; I.dst = W.wdn + (size_t)(32 * nb) * DFF + 64 * kb; I.ldo = DFF; }
        float t[32]; tr_load(t, I, F.lane); tr_store(t, I, scr, F.lane);
    }
}

#if MK_FUSED
#define GRID_BAR() xcd_barrier(bar)
#else
#define GRID_BAR() do { } while (0)
#endif
#define IN(k) (lo <= (k) && (k) < hi)
#define SEAM(k) do { if (IN((k) + 1)) { GRID_BAR(); if (PROBE_DUP & 32) GRID_BAR(); } } while (0)
#if PROBE_SET || PROBE_STAT || PROBE_CLK >= 4
#define PH_T0() const unsigned long long pt0_ = wall_clock64()
#define PH_T1(type) do { if ((PROBE_SET >> (type)) & 1) { if (F.tid == 0) F.MISC[16] += (unsigned)(wall_clock64() - pt0_); } } while (0)
#else
#define PH_T0() do { } while (0)
#define PH_T1(type) do { } while (0)
#endif
#define PHASE_ENTER() KArgs ka = kargs(); unsigned char* ws = ka->ws; Frame F = make_frame(ws); PH_T0()
template <int L> __device__ __forceinline__ void layer_phases(const int lo, const int hi, const XcdBarrier bar) {
    constexpr int l = L; constexpr int pb = 1 + 8 * l;
    if (IN(pb + 0)) {
        if ((L == 0) && CONV_SPLIT) { if (((blockIdx.x >> 3) & 1) != 0) { KArgs ka1_ = kargs(); unsigned char* ws1_ = ka1_->ws; Frame F1_ = make_frame(ws1_); convert_rest(F1_, ka1_, ws1_); __syncthreads(); } }
        PHASE_ENTER(); const LayerW W = layer_w(ws, l);
#if PROBE_IDLE
        if (l == 1) { const unsigned long long t0_ = wall_clock64(); while (wall_clock64() - t0_ < (unsigned long long)PROBE_IDLE * 10000ull) __builtin_amdgcn_s_sleep(64); __syncthreads(); }
#endif
        pg8::Gemm g{(bf16*)(ws + WS_H), W.win, M_TOK, NIN, DM}; pg8::StaticOrder S; S.init(M_TOK, NIN, F.G, (int)blockIdx.x);
        pg8::EpiBf16 E{(bf16*)(ws + WS_PROJ), NIN};
        if (TAIL_OVL && MK_FUSED && IN(pb + 1) && gridDim.x == 256) {
            { pg8::RangeOrder<0, 10> R; R.S = S;
              pg8::gemm_phase<pg8::EpiBf16, pg8::RangeOrder<0, 10>, GEMM_ALIGN, GEMM_SP2>(F.lds + RING_OFF, g, R, E); }
            GRID_BAR();
            { KArgs kb_ = kargs(); unsigned char* wsb_ = kb_->ws; Frame Fb = make_frame(wsb_);
              if (blockIdx.x < 128) { const LayerW Wb = layer_w(wsb_, l); pg8::Gemm gb{(bf16*)(wsb_ + WS_H), Wb.win, M_TOK, NIN, DM}; pg8::RangeOrder<10, 11> Rb; Rb.S.init(M_TOK, NIN, Fb.G, (int)blockIdx.x);
                  pg8::EpiBf16 Eb{(bf16*)(wsb_ + WS_PROJ), NIN};
                  pg8::gemm_phase<pg8::EpiBf16, pg8::RangeOrder<10, 11>, GEMM_ALIGN, GEMM_SP2>(Fb.lds + RING_OFF, gb, Rb, Eb); }
              else { __syncthreads(); mixer_elem_phase(Fb, (bf16*)(wsb_ + WS_PROJ), (bf16*)(wsb_ + WS_MIX), (bf16*)(wsb_ + WS_KC), (bf16*)(wsb_ + WS_VC), kb_->in[I_QN] + l * HD, kb_->in[I_KN] + l * HD, kb_->in[I_CONVW] + l * 3 * 1024, 1); } }
        } else
        pg8::gemm_phase<pg8::EpiBf16, pg8::StaticOrder, GEMM_ALIGN, GEMM_SP2>(F.lds + RING_OFF, g, S, E);
        if ((L == 0) && CONV_SPLIT) { if (((blockIdx.x >> 3) & 1) == 0) { __syncthreads(); KArgs ka2_ = kargs(); unsigned char* ws2_ = ka2_->ws; Frame F2_ = make_frame(ws2_); convert_rest(F2_, ka2_, ws2_); } }
        if (PROBE_DUP & 1) { __syncthreads(); pg8::gemm_phase<pg8::EpiBf16, pg8::StaticOrder, GEMM_ALIGN, GEMM_SP2>(F.lds + RING_OFF, g, S, E); }
        SEAM(pb + 0); PH_T1(1);
    }
    if (IN(pb + 1)) { PHASE_ENTER();
        mixer_elem_phase(F, (bf16*)(ws + WS_PROJ), (bf16*)(ws + WS_MIX), (bf16*)(ws + WS_KC), (bf16*)(ws + WS_VC), ka->in[I_QN] + l * HD, ka->in[I_KN] + l * HD, ka->in[I_CONVW] + l * 3 * 1024, (TAIL_OVL && MK_FUSED && IN(pb + 0) && gridDim.x == 256) ? 2 : 0); SEAM(pb + 1); PH_T1(2); }
    if (IN(pb + 2)) { PHASE_ENTER();
#if PROBE_CLK == 3
        long long c0_ = 0, w0_ = 0; if (l == 0 && blockIdx.x == 0) { c0_ = clock64(); w0_ = wall_clock64(); }
#endif
        attn_phase(F, (bf16*)(ws + WS_PROJ), (bf16*)(ws + WS_KC), (bf16*)(ws + WS_VC), (bf16*)(ws + WS_MIX), CW_ATTQ + l * 1024, ka->in[I_QN] + l * HD, ka->in[I_KN] + l * HD);
#if PROBE_CLK == 3
        if (l == 0 && blockIdx.x == 0) { const long long dc = clock64() - c0_, dw = wall_clock64() - w0_; const long long ticks = dc * 10000 / dw;
            const long long t0_ = wall_clock64(); while (wall_clock64() - t0_ < ticks) __builtin_amdgcn_s_sleep(32); }
#endif
#if PROBE_STAT
        if (l == 0 && F.tid == 0) __hip_atomic_store(F.ctl + 32768 + blockIdx.x, (unsigned)(wall_clock64() - pt0_), RLX_AGENT);
#endif
        SEAM(pb + 2); PH_T1(3);
#if PROBE_STAT
        if (l == 0 && F.tid == 0 && blockIdx.x == 0) { unsigned mn = 0xffffffffu, mx = 0u; unsigned long long sm = 0ull;
            for (int b = 0; b < (int)gridDim.x; ++b) { const unsigned v = __hip_atomic_load(F.ctl + 32768 + b, RLX_AGENT); mn = v < mn ? v : mn; mx = v > mx ? v : mx; sm += v; }
            F.MISC[16] += (PROBE_STAT == 1) ? (unsigned)(sm / gridDim.x) : (PROBE_STAT == 2) ? mn : mx; }
#endif
    }
    if (IN(pb + 3)) {
        PHASE_ENTER(); const LayerW W = layer_w(ws, l);
        pg8::Gemm g{(bf16*)(ws + WS_MIX), W.wout, M_TOK, DM, DM}; pg8::StaticOrder S; S.init(M_TOK, DM, F.G, (int)blockIdx.x);
        pg8::EpiBf16 E{(bf16*)(ws + WS_PRE), DM};
        pg8::gemm_phase<pg8::EpiBf16, pg8::StaticOrder, GEMM_ALIGN, GEMM_SP2>(F.lds + RING_OFF, g, S, E);
        if (PROBE_DUP & 1) { __syncthreads(); pg8::gemm_phase<pg8::EpiBf16, pg8::StaticOrder, GEMM_ALIGN, GEMM_SP2>(F.lds + RING_OFF, g, S, E); }
        SEAM(pb + 3); PH_T1(4);
    }
    if (IN(pb + 4)) { PHASE_ENTER();
        if (l == 0) resnorm_phase<0, 1>(F, ka->in[I_XP], ka->in[I_XS], nullptr, nullptr, (bf16*)ka->out, (bf16*)(ws + WS_PRE), ka->in[I_LN_MIX_POST] + l * DM, ka->in[I_LN_FFN_PRE] + l * DM, (bf16*)(ws + WS_H));
        else resnorm_phase<1, 1>(F, nullptr, nullptr, (const bf16*)ka->out, nullptr, (bf16*)(ws + WS_W0), (bf16*)(ws + WS_PRE), ka->in[I_LN_MIX_POST] + l * DM, ka->in[I_LN_FFN_PRE] + l * DM, (bf16*)(ws + WS_H)); SEAM(pb + 4); PH_T1(5); }
    if (IN(pb + 5)) {
        PHASE_ENTER(); const LayerW W = layer_w(ws, l);
#if GU_CHUNKED
        pg8::Gemm g{(bf16*)(ws + WS_H), W.wgu, M_TOK, NGU, DM}; pg8::ChunkOrder S; S.init(NGU, (int)blockIdx.x);
#define GU_ORDER pg8::ChunkOrder
#else
        pg8::Gemm g{(bf16*)(ws + WS_H), W.wgu, M_TOK, NGU, DM}; pg8::StaticOrder S; S.init(M_TOK, NGU, PROBE_HALF ? 128 : F.G, (PROBE_HALF && blockIdx.x >= 128) ? (1 << 28) : (int)blockIdx.x);
#define GU_ORDER pg8::StaticOrder
#endif
        pg8::EpiSwiGLU E{(bf16*)(ws + WS_HID), DFF};
#if PROBE_CLK == 1 || PROBE_CLK == 2
        long long c0_ = 0, w0_ = 0; if (l == 0 && blockIdx.x == 0) { c0_ = clock64(); w0_ = wall_clock64(); }
#endif
        pg8::gemm_phase<pg8::EpiSwiGLU, GU_ORDER, GEMM_ALIGN, GEMM_SP2>(F.lds + RING_OFF, g, S, E);
#if PROBE_CLK == 1 || PROBE_CLK == 2
        if (l == 0 && blockIdx.x == 0) { const long long dc = clock64() - c0_, dw = wall_clock64() - w0_;
            const long long ticks = (PROBE_CLK == 1) ? dc * 10000 / dw   : dc * 100 / (33 * 64)  ;
            const long long t0_ = wall_clock64(); while (wall_clock64() - t0_ < ticks) __builtin_amdgcn_s_sleep(32); }
#endif
        if (PROBE_DUP & 1) { __syncthreads(); pg8::gemm_phase<pg8::EpiSwiGLU, GU_ORDER, GEMM_ALIGN, GEMM_SP2>(F.lds + RING_OFF, g, S, E); }
        SEAM(pb + 5); PH_T1(6);
    }
    if (IN(pb + 6)) {
        PHASE_ENTER(); const LayerW W = layer_w(ws, l);
        pg8::Gemm g{(bf16*)(ws + WS_HID), W.wdn, M_TOK, DM, DFF}; pg8::StaticOrder S; S.init(M_TOK, DM, F.G, (int)blockIdx.x);
        pg8::EpiBf16 E{(bf16*)(ws + WS_PRE), DM};
        pg8::gemm_phase<pg8::EpiBf16, pg8::StaticOrder, GEMM_ALIGN, GEMM_SP2>(F.lds + RING_OFF, g, S, E);
        if (PROBE_DUP & 1) { __syncthreads(); pg8::gemm_phase<pg8::EpiBf16, pg8::StaticOrder, GEMM_ALIGN, GEMM_SP2>(F.lds + RING_OFF, g, S, E); }
        SEAM(pb + 6); PH_T1(7);
    }
    if (IN(pb + 7)) { PHASE_ENTER();
        if (l + 1 < NLAYER) resnorm_phase<1, 1>(F, nullptr, nullptr, (const bf16*)ka->out, nullptr, (bf16*)ka->out, (bf16*)(ws + WS_PRE), ka->in[I_LN_FFN_POST] + l * DM, ka->in[I_LN_MIX_PRE] + (l + 1) * DM, (bf16*)(ws + WS_H));
        else resnorm_phase<1, 0>(F, nullptr, nullptr, (const bf16*)(ws + WS_W0), ka->out, nullptr, (bf16*)(ws + WS_PRE), ka->in[I_LN_FFN_POST] + l * DM, nullptr, (bf16*)(ws + WS_H)); SEAM(pb + 7); PH_T1(8); }
}

__global__ void __launch_bounds__(NWAVES * 64, 2) enc_fwd(Args args_unused) {
    int lo, hi;
    XcdBarrier bar;
    { KArgs ka = kargs(); lo = ka->ph_lo; hi = ka->ph_hi; Frame F = make_frame(ka->ws);
      for (int u = F.tid; u < (LDS_BYTES - LDSCTL_OFF) / 4; u += NWAVES * 64) ((LAS unsigned*)(F.lds + LDSCTL_OFF))[u] = 0u;
      __syncthreads();
#if MK_FUSED
      bar = xcd_barrier_post((unsigned*)(F.ctl + CW_BAR), F.MISC + 8);
#else
      bar.bar = nullptr; bar.x = 0; bar.st = nullptr;
#endif
    }

    if (IN(0)) {
        PHASE_ENTER();
        const float *w_in = ka->in[I_WIN], *w_out = ka->in[I_WOUT], *w_gate = ka->in[I_WGATE], *w_up = ka->in[I_WUP], *w_down = ka->in[I_WDOWN];
        LAS float* scr = (LAS float*)(F.lds + RING_OFF + F.wave * 16384);
        const int gw = F.vcu * NWAVES + F.wave, NGW = F.G * NWAVES;
        auto decode = [&](int it) -> TrItem {
            const int l = it / I_TR_LAYER; int r = it % I_TR_LAYER; const LayerW W = layer_w(ws, l); TrItem I;
            if (r < I_IN) { const int kb = r / (NIN / 32), nb = r % (NIN / 32); I.src = (const GAS float*)w_in + (size_t)l * DM * NIN + (size_t)(64 * kb) * NIN + 32 * nb; I.ldw = NIN; I.dst = W.win + (size_t)(32 * nb) * DM + 64 * kb; I.ldo = DM; return I; } r -= I_IN;
            if (r < I_OUT) { const int kb = r / (DM / 32), nb = r % (DM / 32); I.src = (const GAS float*)w_out + (size_t)l * DM * DM + (size_t)(64 * kb) * DM + 32 * nb; I.ldw = DM; I.dst = W.wout + (size_t)(32 * nb) * DM + 64 * kb; I.ldo = DM; return I; } r -= I_OUT;
            if (r < 2 * I_G) { const int up = r >= I_G; if (up) r -= I_G; const int kb = r / (DFF / 32), nb = r % (DFF / 32), n0 = 32 * nb;
                I.src = (const GAS float*)(up ? w_up : w_gate) + (size_t)l * DM * DFF + (size_t)(64 * kb) * DFF + n0; I.ldw = DFF; I.dst = W.wgu + (size_t)((n0 >> 7) * 256 + (n0 & 127) + (up ? 128 : 0)) * DM + 64 * kb; I.ldo = DM; return I; } r -= 2 * I_G;
            { const int kb = r / (DM / 32), nb = r % (DM / 32); I.src = (const GAS float*)w_down + (size_t)l * DFF * DM + (size_t)(64 * kb) * DM + 32 * nb; I.ldw = DM; I.dst = W.wdn + (size_t)(32 * nb) * DFF + 64 * kb; I.ldo = DFF; return I; }
        };
        { constexpr int NTR = CONV_SPLIT ? I_IN : NLAYER * I_TR_LAYER; float tA[32], tB[32]; TrItem a{}, b{};
          if (gw < NTR) { a = decode(gw); tr_load(tA, a, F.lane); }
          for (int it = gw; it < NTR; it += 2 * NGW) {
              const int itb = it + NGW; const bool hb = itb < NTR;
              if (hb) { b = decode(itb); tr_load(tB, b, F.lane); }
              tr_store(tA, a, scr, F.lane);
              const int ita = it + 2 * NGW;
              if (ita < NTR) { a = decode(ita); tr_load(tA, a, F.lane); }
              if (hb) tr_store(tB, b, scr, F.lane);
          } }
        { const float *pool_w = ka->in[I_POOLW], *pool_scale = ka->in[I_PSCALE];
        for (int it0 = gw; it0 < NLAYER * I_FOLD * ((PROBE_DUP & 64) ? 2 : 1); it0 += NGW) { const int it = it0 % (NLAYER * I_FOLD); const int l = it / I_FOLD, r = it % I_FOLD; const LayerW W = layer_w(ws, l);
            fold_item(pool_w + (size_t)l * 4 * 65536, pool_scale + l * 1024, w_out + (size_t)l * DM * DM, W.wout, r, F.lane, scr); } }
        __syncthreads();
        prenorm_phase(F, ka->in[I_XP], ka->in[I_XS], ka->in[I_LN_MIX_PRE], (bf16*)(ws + WS_H));
        SEAM(0); PH_T1(0);
    }
    layer_phases<0>(lo, hi, bar);
    layer_phases<1>(lo, hi, bar);
#if PROBE_SET || PROBE_STAT || PROBE_CLK >= 4 || PROBE_SENS >= 6
    if (blockIdx.x == 0 && threadIdx.x == 0) { extern __shared__ __attribute__((aligned(16))) unsigned char lds_[]; const unsigned long long ticks = (unsigned long long)((volatile LAS unsigned*)((LAS unsigned char*)lds_ + MISC_OFF))[16] * PROBE_MULT;
        const unsigned long long t0_ = wall_clock64(); while (wall_clock64() - t0_ < ticks) __builtin_amdgcn_s_sleep(32); }
#endif
}
#undef IN
#undef SEAM

extern "C" void kernel_launch(void* const* d_in, const int* in_sizes, int n_in, void* d_out, int out_size, void* d_ws, size_t ws_size, hipStream_t stream) {
    static int grid = 0;
    if (grid == 0) {
        if (n_in != 16 || in_sizes[0] != SEQ_P * DM || in_sizes[1] != 2 * SEQ_S * DM || out_size != M_TOK * DM || ws_size < WS_END) {
            fprintf(stderr, "kernel_launch: shape mismatch (n_in %d, in0 %d, out %d, ws %zu, need ws >= %zu); nothing launched\n", n_in, n_in > 0 ? in_sizes[0] : -1, out_size, ws_size, (size_t)WS_END); grid = -1; return; }
        int dev = 0, cus = 0, per_cu = 0;
        if (hipGetDevice(&dev) != hipSuccess || hipDeviceGetAttribute(&cus, hipDeviceAttributeMultiprocessorCount, dev) != hipSuccess) { fprintf(stderr, "kernel_launch: device query failed\n"); grid = -1; return; }
        if (hipFuncSetAttribute((const void*)enc_fwd, hipFuncAttributeMaxDynamicSharedMemorySize, LDS_BYTES) != hipSuccess) { fprintf(stderr, "kernel_launch: hipFuncSetAttribute failed\n"); grid = -1; return; }
        if (hipOccupancyMaxActiveBlocksPerMultiprocessor(&per_cu, (const void*)enc_fwd, NWAVES * 64, LDS_BYTES) != hipSuccess || per_cu < 1) {
            fprintf(stderr, "kernel_launch: occupancy query reports %d workgroups per CU; nothing launched\n", per_cu); (void)hipGetLastError(); grid = -1; return; }
        grid = cus;
    }
    if (grid < 0) return;
    if (hipMemsetAsync((char*)d_ws + WS_CTL, 0, CTL_ZERO_BYTES, stream) != hipSuccess) { fprintf(stderr, "kernel_launch: hipMemsetAsync failed\n"); return; }
    Args a{};
    for (int i = 0; i < 16; ++i) a.in[i] = (const float*)d_in[i];
    a.out = (float*)d_out; a.ws = (unsigned char*)d_ws;
#if MK_FUSED
    a.ph_lo = 0; a.ph_hi = N_PHASES;
    hipLaunchKernelGGL(enc_fwd, dim3(grid), dim3(NWAVES * 64), LDS_BYTES, stream, a);
#else
    for (int p = 0; p < N_PHASES; ++p) { a.ph_lo = p; a.ph_hi = p + 1; hipLaunchKernelGGL(enc_fwd, dim3(grid), dim3(NWAVES * 64), LDS_BYTES, stream, a); }
#endif
    const hipError_t le = hipPeekAtLastError();
    if (le != hipSuccess) fprintf(stderr, "kernel_launch: launch failed: %s (grid %d)\n", hipGetErrorName(le), grid);
}
```
